# Optimizing an MI355X kernel written in HIP

```python
import math
import jax, jax.numpy as jnp
from jax import lax
import numpy as np

D_MODEL = 2048
BATCH = 8
SEQ = 4096
DEPTH = 4
DEC_BATCH = 8
DEC_SEQ = 2048
PAST_LEN = 128

GRID_W = 64
BLOCK = 128
EPS = 1e-6
ROPE_THETA = 10000.0
NEG = -1e30
MLA_HEADS = 8
MLA_NOPE = 128
MLA_ROPE = 64
MLA_QK = MLA_NOPE + MLA_ROPE
MLA_V = 128
Q_LORA = 512
KV_LORA = 256
MLA_W = MLA_HEADS * MLA_V
AX_HEADS = 8
AX_KV = 2
AX_HD = 128
AX_W = AX_HEADS * AX_HD
WIN_HEADS = 8
WIN_KV = 2
WIN_HD = 128
WINDOW = 128
WIN_W = WIN_HEADS * WIN_HD
N_BUCKETS = 32
MAX_DIST = 128
D_IN = (Q_LORA + KV_LORA + MLA_ROPE + MLA_W
        + AX_W + 2 * AX_KV * AX_HD + AX_W
        + WIN_W + 2 * WIN_KV * WIN_HD + WIN_W
        + 3 * D_MODEL)

kernel_name = 'hybrid_gated_mla_axial_window_encoder'


def _split_points():
    sizes = [Q_LORA, KV_LORA, MLA_ROPE, MLA_W,
             AX_W, AX_KV * AX_HD, AX_KV * AX_HD, AX_W,
             WIN_W, WIN_KV * WIN_HD, WIN_KV * WIN_HD, WIN_W,
             D_MODEL, D_MODEL, D_MODEL]
    pts, acc = [], 0
    for s in sizes[:-1]:
        acc += s
        pts.append(acc)
    return pts


def rmsnorm(x, g):
    xf = x.astype(jnp.float32)
    y = xf * lax.rsqrt(jnp.mean(xf * xf, axis=-1, keepdims=True) + EPS)
    return (y * g.astype(jnp.float32)).astype(x.dtype)


def rope(x, pos):
    half = x.shape[-1] // 2
    freqs = ROPE_THETA ** (-jnp.arange(half, dtype=jnp.float32) / half)
    ang = pos[:, None] * freqs[None, :]
    cos = jnp.cos(ang)[None, :, None, :]
    sin = jnp.sin(ang)[None, :, None, :]
    xf = x.astype(jnp.float32)
    x1, x2 = xf[..., :half], xf[..., half:]
    return jnp.concatenate([x1 * cos - x2 * sin, x2 * cos + x1 * sin], axis=-1).astype(x.dtype)


def dense_block_attn(q, k, v, n_kv):
    B, S, H, Dk = q.shape
    G = H // n_kv
    nb = S // BLOCK
    Dv = v.shape[-1]
    scale = Dk ** -0.5
    qb = q.reshape(B, nb, BLOCK, n_kv, G, Dk).transpose(1, 0, 2, 3, 4, 5)

    def one(qblk):
        s = jnp.einsum('bqkgd,bskd->bkgqs', qblk, k).astype(jnp.float32) * scale
        p = jax.nn.softmax(s, axis=-1).astype(v.dtype)
        return jnp.einsum('bkgqs,bskd->bqkgd', p, v)

    o = lax.map(one, qb)
    return o.transpose(1, 0, 2, 3, 4, 5).reshape(B, S, H * Dv)


def t5_bucket(rel):
    half = N_BUCKETS // 2
    max_exact = half // 2
    ret = jnp.where(rel > 0, half, 0)
    n = jnp.abs(rel)
    nf = jnp.maximum(n, 1).astype(jnp.float32)
    large = max_exact + (jnp.log(nf / max_exact) / math.log(MAX_DIST / max_exact)
                         * (half - max_exact)).astype(jnp.int32)
    large = jnp.minimum(large, half - 1)
    return ret + jnp.where(n < max_exact, n, large)


def window_attn(q, k, v, sink, rel_bias):
    B, S, H, D = q.shape
    KV = k.shape[2]
    G = H // KV
    nb = S // BLOCK
    span = BLOCK + 2 * WINDOW
    qb = q.reshape(B, nb, BLOCK, KV, G, D)
    pad = ((0, 0), (WINDOW, WINDOW), (0, 0), (0, 0))
    kp = jnp.pad(k, pad)
    vp = jnp.pad(v, pad)
    idx = (jnp.arange(nb) * BLOCK)[:, None] + jnp.arange(span)[None, :]
    kb = kp[:, idx]
    vb = vp[:, idx]
    s = jnp.einsum('bnqkgd,bnskd->bnkgqs', qb, kb).astype(jnp.float32) * (D ** -0.5)
    rel = jnp.arange(span)[None, :] - WINDOW - jnp.arange(BLOCK)[:, None]
    bias = rel_bias[t5_bucket(rel)].astype(jnp.float32)
    bias = bias.transpose(2, 0, 1).reshape(KV, G, BLOCK, span)
    kpos = idx - WINDOW
    valid = (jnp.abs(rel) <= WINDOW)[None] & ((kpos >= 0) & (kpos < S))[:, None, :]
    s = jnp.where(valid[None, :, None, None], s + bias, NEG)
    sk = jnp.broadcast_to(sink.astype(jnp.float32).reshape(KV, G, 1, 1), (B, nb, KV, G, BLOCK, 1))
    p = jax.nn.softmax(jnp.concatenate([s, sk], axis=-1), axis=-1)[..., :span].astype(v.dtype)
    o = jnp.einsum('bnkgqs,bnskd->bnqkgd', p, vb)
    return o.reshape(B, S, H * D)


def layer(x, c, ln_g, w_ada, b_ada, w_in, q_a_norm, w_q_up, kv_a_norm, w_kv_up,
          mla_qn, mla_kn, ax_qn, ax_kn, win_qn, win_kn, win_sink, rel_bias,
          w_br_mla, w_br_ax, w_br_win, w_out):
    B, S, _ = x.shape
    rows = S // GRID_W
    mod = c @ w_ada + b_ada
    shift = mod[:, None, :D_MODEL]
    scale = mod[:, None, D_MODEL:2 * D_MODEL]
    gate = mod[:, None, 2 * D_MODEL:]
    h = rmsnorm(x, ln_g) * (1.0 + scale) + shift
    proj = h @ w_in
    (cq, ckv, kr, g_mla, aq, ak, av, g_ax, wq, wk, wv, g_win,
     m_mla, m_ax, m_win) = jnp.split(proj, _split_points(), axis=-1)
    pos = jnp.arange(S, dtype=jnp.float32)
    row = jnp.repeat(jnp.arange(rows, dtype=jnp.float32), GRID_W)
    col = jnp.tile(jnp.arange(GRID_W, dtype=jnp.float32), rows)

    q = (rmsnorm(cq, q_a_norm) @ w_q_up).reshape(B, S, MLA_HEADS, MLA_QK)
    kv = (rmsnorm(ckv, kv_a_norm) @ w_kv_up).reshape(B, S, MLA_HEADS, MLA_NOPE + MLA_V)
    k_nope, v_mla = kv[..., :MLA_NOPE], kv[..., MLA_NOPE:]
    k_pe = jnp.broadcast_to(kr[:, :, None, :], (B, S, MLA_HEADS, MLA_ROPE))
    k = jnp.concatenate([k_nope, k_pe], axis=-1)
    q = rmsnorm(q, mla_qn)
    k = rmsnorm(k, mla_kn)
    q = jnp.concatenate([q[..., :MLA_NOPE], rope(q[..., MLA_NOPE:], pos)], axis=-1)
    k = jnp.concatenate([k[..., :MLA_NOPE], rope(k[..., MLA_NOPE:], pos)], axis=-1)
    o_mla = dense_block_attn(q, k, v_mla, MLA_HEADS)

    hd2 = AX_HD // 2
    aq = rmsnorm(aq.reshape(B, S, AX_HEADS, AX_HD), ax_qn)
    ak = rmsnorm(ak.reshape(B, S, AX_KV, AX_HD), ax_kn)
    av = av.reshape(B, S, AX_KV, AX_HD)
    aq = jnp.concatenate([rope(aq[..., :hd2], row), rope(aq[..., hd2:], col)], axis=-1)
    ak = jnp.concatenate([rope(ak[..., :hd2], row), rope(ak[..., hd2:], col)], axis=-1)
    o_ax = dense_block_attn(aq, ak, av, AX_KV)

    wq = rmsnorm(wq.reshape(B, S, WIN_HEADS, WIN_HD), win_qn)
    wk = rmsnorm(wk.reshape(B, S, WIN_KV, WIN_HD), win_kn)
    wv = wv.reshape(B, S, WIN_KV, WIN_HD)
    o_win = window_attn(wq, wk, wv, win_sink, rel_bias)

    y = (jax.nn.sigmoid(m_mla) * ((o_mla * jax.nn.silu(g_mla)) @ w_br_mla)
         + jax.nn.sigmoid(m_ax) * ((o_ax * jax.nn.silu(g_ax)) @ w_br_ax)
         + jax.nn.sigmoid(m_win) * ((o_win * jax.nn.silu(g_win)) @ w_br_win))
    return x + gate * (y @ w_out)


def setup_inputs(seed: int = 0) -> dict:
    key = jax.random.key(seed)
    ks = jax.random.split(key, 24)
    f32 = jnp.float32

    def nrm(k, shape, s):
        return jax.random.normal(k, shape, f32) * s

    def gain(k, shape):
        return 1.0 + 0.02 * jax.random.normal(k, shape, f32)

    return {
        'x_prompt': nrm(ks[0], (BATCH, SEQ, D_MODEL), 1.0),
        'x_sample': nrm(ks[1], (DEC_BATCH, DEC_SEQ, D_MODEL), 1.0),
        'c_prompt': nrm(ks[2], (BATCH, D_MODEL), 1.0),
        'c_sample': nrm(ks[3], (DEC_BATCH, D_MODEL), 1.0),
        'ln_g': gain(ks[4], (DEPTH, D_MODEL)),
        'w_ada': nrm(ks[5], (DEPTH, D_MODEL, 3 * D_MODEL), 0.5 * D_MODEL ** -0.5),
        'b_ada': nrm(ks[6], (DEPTH, 3 * D_MODEL), 0.01),
        'w_in': nrm(ks[7], (DEPTH, D_MODEL, D_IN), D_MODEL ** -0.5),
        'q_a_norm': gain(ks[8], (DEPTH, Q_LORA)),
        'w_q_up': nrm(ks[9], (DEPTH, Q_LORA, MLA_HEADS * MLA_QK), Q_LORA ** -0.5),
        'kv_a_norm': gain(ks[10], (DEPTH, KV_LORA)),
        'w_kv_up': nrm(ks[11], (DEPTH, KV_LORA, MLA_HEADS * (MLA_NOPE + MLA_V)), KV_LORA ** -0.5),
        'mla_qn': gain(ks[12], (DEPTH, MLA_QK)),
        'mla_kn': gain(ks[13], (DEPTH, MLA_QK)),
        'ax_qn': gain(ks[14], (DEPTH, AX_HD)),
        'ax_kn': gain(ks[15], (DEPTH, AX_HD)),
        'win_qn': gain(ks[16], (DEPTH, WIN_HD)),
        'win_kn': gain(ks[17], (DEPTH, WIN_HD)),
        'win_sink': nrm(ks[18], (DEPTH, WIN_HEADS), 1.0),
        'rel_bias': nrm(ks[19], (N_BUCKETS, WIN_HEADS), 0.5),
        'w_br_mla': nrm(ks[20], (DEPTH, MLA_W, D_MODEL), MLA_W ** -0.5),
        'w_br_ax': nrm(ks[21], (DEPTH, AX_W, D_MODEL), AX_W ** -0.5),
        'w_br_win': nrm(ks[22], (DEPTH, WIN_W, D_MODEL), WIN_W ** -0.5),
        'w_out': nrm(ks[23], (DEPTH, D_MODEL, D_MODEL), D_MODEL ** -0.5),
    }


def reference(x_prompt, x_sample, c_prompt, c_sample, ln_g, w_ada, b_ada, w_in,
              q_a_norm, w_q_up, kv_a_norm, w_kv_up, mla_qn, mla_kn, ax_qn, ax_kn,
              win_qn, win_kn, win_sink, rel_bias, w_br_mla, w_br_ax, w_br_win, w_out):
    y_prompt = x_prompt
    y_sample = x_sample
    for l in range(DEPTH):
        p = (ln_g[l], w_ada[l], b_ada[l], w_in[l], q_a_norm[l], w_q_up[l],
             kv_a_norm[l], w_kv_up[l], mla_qn[l], mla_kn[l], ax_qn[l], ax_kn[l],
             win_qn[l], win_kn[l], win_sink[l], rel_bias,
             w_br_mla[l], w_br_ax[l], w_br_win[l], w_out[l])
        y_prompt = layer(y_prompt, c_prompt, *p)
        y_sample = layer(y_sample, c_sample, *p)
    return (y_prompt, y_sample)
```

```cpp
#include <hip/hip_runtime.h>
#include <cstdio>
#include <cstdint>

#ifndef MK_ONE_LAUNCH
#define MK_ONE_LAUNCH 1
#endif

#define LAS __attribute__((address_space(3)))
typedef unsigned short bf16_t;
typedef short bf16x8 __attribute__((ext_vector_type(8)));
typedef short s16x4 __attribute__((ext_vector_type(4)));
typedef float f32x2 __attribute__((ext_vector_type(2)));
typedef float f32x4 __attribute__((ext_vector_type(4)));
typedef float f32x16 __attribute__((ext_vector_type(16)));
typedef unsigned u32x2 __attribute__((ext_vector_type(2)));
typedef unsigned u32x4 __attribute__((ext_vector_type(4)));

__device__ __forceinline__ unsigned cvt_pk_bf16(float lo, float hi) { unsigned r; asm volatile("v_cvt_pk_bf16_f32 %0, %1, %2" : "=v"(r) : "v"(lo), "v"(hi)); return r; }
__device__ __forceinline__ float bf_lo(unsigned w) { return __builtin_bit_cast(float, w << 16); }
__device__ __forceinline__ float bf_hi(unsigned w) { return __builtin_bit_cast(float, w & 0xffff0000u); }
__device__ __forceinline__ float bf2f(bf16_t x) { return __builtin_bit_cast(float, (unsigned)x << 16); }
__device__ __forceinline__ bf16_t f2bf(float f) { return (bf16_t)(cvt_pk_bf16(f, 0.f) & 0xffffu); }
__device__ __forceinline__ float sigmoid_f(float v) { return __builtin_amdgcn_rcpf(1.0f + __builtin_amdgcn_exp2f(-1.4426950408889634f * v)); }
__device__ __forceinline__ float silu_f(float v) { return v * sigmoid_f(v); }

namespace pg8 {
#define PG8_LAS __attribute__((address_space(3)))
constexpr int BM = 256, BK = 64, HALF = 128, HTB = HALF * BK * 2  , STAGE_BYTES = 8 * HTB, NXCD = 8, WGM = 8;
__host__ __device__ __forceinline__ int lds_byte(int r, int c) { const int st = (r >> 4) * 2 + (c >> 5), rr = r & 15, cc = c & 31, ob = rr * 64 + cc * 2; return st * 1024 + (ob ^ (((ob >> 9) & 1) << 5)); }
__host__ __device__ __forceinline__ void stage_rc(int b, int& R, int& C) { const int st = b / 1024, sb = b % 1024, swz = sb ^ (((sb >> 9) & 1) << 5); R = (st >> 1) * 16 + swz / 64; C = (st & 1) * 32 + (swz % 64) / 2; }
__host__ __device__ __forceinline__ int perm32(int rho) { const int n = rho >> 4, i = rho & 15; return 8 * (i >> 2) + 4 * n + (i & 3); }

struct Unit { int pm, pn; };
struct Gemm { const bf16_t* A; const bf16_t* Bt; int M, N, K, lda, ldb; };

struct StaticOrder {
    int nM, nN, nwg, G, c;
    __host__ __device__ void init(int M, int N, int G_, int c_) { nM = M / BM; nN = N / BM; nwg = nM * nN; G = G_; c = c_; }
    __host__ __device__ bool next(int i, Unit& u) const {
        const long L = (long)i * G + c; if (L >= nwg) return false;
        int wgid = (int)L; { const int q = nwg / NXCD, r = nwg % NXCD, xcd = wgid % NXCD, off = wgid / NXCD; wgid = (xcd < r ? xcd * (q + 1) : r * (q + 1) + (xcd - r) * q) + off; }
        const int nig = WGM * nN, gid = wgid / nig, fm = gid * WGM, gsz = (nM - fm) < WGM ? (nM - fm) : WGM;
        u.pm = fm + ((wgid % nig) % gsz); u.pn = (wgid % nig) / gsz; return true;
    }
};
template <class Epi, class Sched, bool ALIGN_EPI = false, bool SP2 = false>
__device__ __forceinline__ void gemm_phase(PG8_LAS unsigned char* lds, const Gemm g, const Sched& S, const Epi& E) {
    int tid_ = threadIdx.x; asm volatile("" : "+v"(tid_));
    const int tid = tid_, wid = __builtin_amdgcn_readfirstlane(tid >> 6), lane = tid & 63, wr = wid >> 2, wc = wid & 3, fr = lane & 15, fq = lane >> 4;
    int K_ = g.K; asm volatile("" : "+s"(K_));
    const int K = K_, nt = K / BK;
    unsigned voffA[2], voffB[2];
#pragma unroll
    for (int i = 0; i < 2; ++i) { int R, C; stage_rc(tid * 16 + i * 8192, R, C); const int Rb = Epi::PERM ? ((R & ~31) + perm32(R & 31)) : R;
        voffA[i] = (unsigned)(R * g.lda + C) * 2u; voffB[i] = (unsigned)(Rb * g.ldb + C) * 2u; }
    const size_t kstep = (size_t)(BK * 2);
    const size_t hstepA = (size_t)HALF * g.lda * 2, hstepB = (size_t)HALF * g.ldb * 2;
    const size_t tstepA = 2 * hstepA, tstepB = 2 * hstepB;
    const unsigned ldsw = (unsigned)wid * 1024u;
    const int aoff = lds_byte(wr * 64 + fr, fq * 8), boff = lds_byte(wc * 32 + fr, fq * 8);
#define PG8_SA(b, h) (((b) * 2 + (h)) * HTB)
#define PG8_SB(b, h) ((4 + (b) * 2 + (h)) * HTB)
#define PG8_STAGE(bufoff, gbase, voff) do { _Pragma("unroll") for (int _i = 0; _i < 2; ++_i) \
        __builtin_amdgcn_global_load_lds((const unsigned*)((const char*)(gbase) + (voff)[_i]), (PG8_LAS unsigned*)(lds + (bufoff) + ldsw + _i * 8192), 16, 0, 0); } while (0)
#define PG8_LDA(dst, b, h) do { _Pragma("unroll") for (int m = 0; m < 4; ++m) _Pragma("unroll") for (int k = 0; k < 2; ++k) dst[m][k] = *(const PG8_LAS bf16x8*)(lds + PG8_SA(b, h) + aoff + m * 2048 + k * 1024); } while (0)
#define PG8_LDB(dst, b, h) do { _Pragma("unroll") for (int n = 0; n < 2; ++n) _Pragma("unroll") for (int k = 0; k < 2; ++k) dst[n][k] = *(const PG8_LAS bf16x8*)(lds + PG8_SB(b, h) + boff + n * 2048 + k * 1024); } while (0)
#define PG8_MMA(ai, bj, At, Bt) do { __builtin_amdgcn_s_setprio(1); _Pragma("unroll") for (int m = 0; m < 4; ++m) _Pragma("unroll") for (int n = 0; n < 2; ++n) _Pragma("unroll") for (int k = 0; k < 2; ++k) \
        acc[ai][bj][m][n] = __builtin_amdgcn_mfma_f32_16x16x32_bf16(Bt[n][k], At[m][k], acc[ai][bj][m][n], 0, 0, 0); __builtin_amdgcn_s_setprio(0); } while (0)
#define PG8_WAIT_V(n) asm volatile("s_waitcnt vmcnt(" #n ")" ::: "memory")
#define PG8_WAIT_L(n) asm volatile("s_waitcnt lgkmcnt(" #n ")" ::: "memory")
#define PG8_BAR __builtin_amdgcn_s_barrier()
#define PG8_SCHED __builtin_amdgcn_sched_barrier(0)
    Unit cur, nxt; int ui = 0;
    if (!S.next(0, cur)) return;
    f32x4 acc[2][2][4][2];
#pragma unroll
    for (int a = 0; a < 2; ++a)
#pragma unroll
        for (int b = 0; b < 2; ++b)
#pragma unroll
            for (int m = 0; m < 4; ++m)
#pragma unroll
                for (int n = 0; n < 2; ++n) acc[a][b][m][n] = (f32x4){0.f, 0.f, 0.f, 0.f};
    bf16x8 At[4][2], B0[2][2], B1[2][2];
    const char* cA = (const char*)g.A + (size_t)cur.pm * tstepA; const char* cB = (const char*)g.Bt + (size_t)cur.pn * tstepB;

    if constexpr (SP2) {
        PG8_STAGE(PG8_SB(0, 0), cB, voffB); PG8_STAGE(PG8_SB(0, 1), cB + hstepB, voffB); PG8_STAGE(PG8_SA(0, 0), cA, voffA); PG8_STAGE(PG8_SA(0, 1), cA + hstepA, voffA);
        if (wr == 1) PG8_BAR;
        PG8_WAIT_V(2); PG8_BAR;
        PG8_STAGE(PG8_SB(1, 0), cB + kstep, voffB); PG8_STAGE(PG8_SA(1, 0), cA + kstep, voffA); PG8_STAGE(PG8_SB(1, 1), cB + hstepB + kstep, voffB);
        PG8_WAIT_V(6); PG8_BAR;
    } else {
        PG8_STAGE(PG8_SB(0, 0), cB, voffB); PG8_STAGE(PG8_SA(0, 0), cA, voffA); PG8_STAGE(PG8_SB(0, 1), cB + hstepB, voffB); PG8_STAGE(PG8_SA(0, 1), cA + hstepA, voffA);
        if (wr == 1) PG8_BAR;
        PG8_WAIT_V(4); PG8_BAR;
        PG8_STAGE(PG8_SB(1, 0), cB + kstep, voffB); PG8_STAGE(PG8_SA(1, 0), cA + kstep, voffA); PG8_STAGE(PG8_SB(1, 1), cB + hstepB + kstep, voffB);
        PG8_WAIT_V(6); PG8_BAR;
    }
    for (;;) {
        const bool has_next = S.next(ui + 1, nxt);
        const char* nA = has_next ? (const char*)g.A + (size_t)nxt.pm * tstepA : cA; const char* nB = has_next ? (const char*)g.Bt + (size_t)nxt.pn * tstepB : cB;
        for (int t = 0; t < nt; t += 2) {
            const bool last = (t == nt - 2);
            const char* a1 = cA + (size_t)(t + 1) * kstep;
            const char* a2 = last ? nA : cA + (size_t)(t + 2) * kstep; const char* b2 = last ? nB : cB + (size_t)(t + 2) * kstep;
            const char* a3 = a2 + kstep; const char* b3 = b2 + kstep;

            if constexpr (SP2) {
            PG8_LDB(B0, 0, 0); PG8_LDB(B1, 0, 1); PG8_SCHED; PG8_LDA(At, 0, 0); PG8_STAGE(PG8_SA(1, 1), a1 + hstepA, voffA);
            PG8_WAIT_V(8); PG8_WAIT_L(0); PG8_BAR; PG8_MMA(0, 0, At, B0); PG8_MMA(0, 1, At, B1); PG8_BAR; PG8_SCHED;
            PG8_LDA(At, 0, 1); PG8_STAGE(PG8_SB(0, 0), b2, voffB); PG8_STAGE(PG8_SB(0, 1), b2 + hstepB, voffB); PG8_STAGE(PG8_SA(0, 0), a2, voffA);
            PG8_WAIT_V(8); PG8_WAIT_L(0); PG8_BAR; PG8_MMA(1, 0, At, B0); PG8_MMA(1, 1, At, B1); PG8_BAR; PG8_SCHED;
            PG8_LDB(B0, 1, 0); PG8_LDB(B1, 1, 1); PG8_SCHED; PG8_LDA(At, 1, 0); PG8_STAGE(PG8_SA(0, 1), a2 + hstepA, voffA);
            PG8_WAIT_V(8); PG8_WAIT_L(0); PG8_BAR; PG8_MMA(0, 0, At, B0); PG8_MMA(0, 1, At, B1); PG8_BAR; PG8_SCHED;
            PG8_LDA(At, 1, 1); PG8_STAGE(PG8_SB(1, 0), b3, voffB); PG8_STAGE(PG8_SB(1, 1), b3 + hstepB, voffB); PG8_STAGE(PG8_SA(1, 0), a3, voffA);
            PG8_WAIT_V(8); PG8_WAIT_L(0); PG8_BAR; PG8_MMA(1, 0, At, B0); PG8_MMA(1, 1, At, B1); PG8_BAR; PG8_SCHED;
            } else {
            PG8_LDB(B0, 0, 0); PG8_SCHED; PG8_LDA(At, 0, 0); PG8_STAGE(PG8_SA(1, 1), a1 + hstepA, voffA);
            PG8_WAIT_L(8); PG8_BAR; PG8_WAIT_L(0); PG8_MMA(0, 0, At, B0); PG8_BAR; PG8_SCHED;
            PG8_LDB(B1, 0, 1); PG8_STAGE(PG8_SB(0, 0), b2, voffB);
            PG8_BAR; PG8_WAIT_L(0); PG8_MMA(0, 1, At, B1); PG8_BAR;
            PG8_LDA(At, 0, 1); PG8_STAGE(PG8_SA(0, 0), a2, voffA);
            PG8_BAR; PG8_WAIT_L(0); PG8_MMA(1, 0, At, B0); PG8_BAR; PG8_SCHED;
            PG8_STAGE(PG8_SB(0, 1), b2 + hstepB, voffB);
            PG8_WAIT_V(6); PG8_BAR; PG8_MMA(1, 1, At, B1); PG8_BAR;
            PG8_LDB(B0, 1, 0); PG8_SCHED; PG8_LDA(At, 1, 0); PG8_STAGE(PG8_SA(0, 1), a2 + hstepA, voffA);
            PG8_WAIT_L(8); PG8_BAR; PG8_WAIT_L(0); PG8_MMA(0, 0, At, B0); PG8_BAR; PG8_SCHED;
            PG8_LDB(B1, 1, 1); PG8_STAGE(PG8_SB(1, 0), b3, voffB);
            PG8_BAR; PG8_WAIT_L(0); PG8_MMA(0, 1, At, B1); PG8_BAR;
            PG8_LDA(At, 1, 1); PG8_STAGE(PG8_SA(1, 0), a3, voffA);
            PG8_BAR; PG8_WAIT_L(0); PG8_MMA(1, 0, At, B0); PG8_BAR; PG8_SCHED;
            PG8_STAGE(PG8_SB(1, 1), b3 + hstepB, voffB);
            PG8_WAIT_V(6); PG8_BAR; PG8_MMA(1, 1, At, B1); PG8_BAR;
            }
        }
        if constexpr (ALIGN_EPI) { if (wr == 0) PG8_BAR; }
        E(acc, cur, wr, wc, fr, fq);
        if (!has_next) break;
#pragma unroll
        for (int a = 0; a < 2; ++a)
#pragma unroll
            for (int b = 0; b < 2; ++b)
#pragma unroll
                for (int m = 0; m < 4; ++m)
#pragma unroll
                    for (int n = 0; n < 2; ++n) acc[a][b][m][n] = (f32x4){0.f, 0.f, 0.f, 0.f};
        cur = nxt; cA = nA; cB = nB; ++ui;
        if constexpr (ALIGN_EPI) { if (wr == 1) PG8_BAR; }
    }
    PG8_WAIT_V(0);
    if constexpr (!ALIGN_EPI) { if (wr == 0) PG8_BAR; }
    PG8_BAR;
#undef PG8_SA
#undef PG8_SB
#undef PG8_STAGE
#undef PG8_LDA
#undef PG8_LDB
#undef PG8_MMA
#undef PG8_WAIT_V
#undef PG8_WAIT_L
#undef PG8_BAR
#undef PG8_SCHED
}
}

template <int ACT> __device__ __forceinline__ u32x4 act_pack8(f32x4 v0, f32x4 v1) {
    if (ACT == 1) {
#pragma unroll
        for (int j = 0; j < 4; ++j) { v0[j] = silu_f(v0[j]); v1[j] = silu_f(v1[j]); } }
    if (ACT == 2) {
#pragma unroll
        for (int j = 0; j < 4; ++j) { v0[j] = sigmoid_f(v0[j]); v1[j] = sigmoid_f(v1[j]); } }
    u32x4 w; w.x = cvt_pk_bf16(v0[0], v0[1]); w.y = cvt_pk_bf16(v0[2], v0[3]); w.z = cvt_pk_bf16(v1[0], v1[1]); w.w = cvt_pk_bf16(v1[2], v1[3]); return w;
}
template <int ACT> __device__ __forceinline__ void store_tile_bf16(const f32x4 (&acc)[2][2][4][2], bf16_t* p00  , bf16_t* p01  , int ldc) {
#pragma unroll
    for (int ai = 0; ai < 2; ++ai)
#pragma unroll
        for (int m = 0; m < 4; ++m) { const size_t ro = (size_t)(ai * 128 + m * 16) * ldc;
            *(u32x4*)(p00 + ro) = act_pack8<ACT>(acc[ai][0][m][0], acc[ai][0][m][1]);
            *(u32x4*)(p01 + ro) = act_pack8<ACT>(acc[ai][1][m][0], acc[ai][1][m][1]); }
}
struct EpiInProj {
    static constexpr bool PERM = true;
    bf16_t *CQKV, *G, *AXb, *WINb, *MG;
    __device__ __forceinline__ void operator()(const f32x4 (&acc)[2][2][4][2], const pg8::Unit& u, int wr, int wc, int fr, int fq) const {
        const int pn = u.pn; bf16_t* base; int ldc, colt, act;
        if (pn < 4)       { base = CQKV; ldc = 1024; colt = pn * 256;               act = 0; }
        else if (pn < 8)  { base = G;    ldc = 3072; colt = (pn - 4) * 256;         act = 1; }
        else if (pn < 14) { base = AXb;  ldc = 1536; colt = (pn - 8) * 256;         act = 0; }
        else if (pn < 18) { base = G;    ldc = 3072; colt = 1024 + (pn - 14) * 256; act = 1; }
        else if (pn < 24) { base = WINb; ldc = 1536; colt = (pn - 18) * 256;        act = 0; }
        else if (pn < 28) { base = G;    ldc = 3072; colt = 2048 + (pn - 24) * 256; act = 1; }
        else              { base = MG;   ldc = 6144; colt = (pn - 28) * 256;        act = 2; }
        bf16_t* p0 = base + (size_t)(u.pm * 256 + wr * 64 + fr) * ldc + colt + wc * 32 + 8 * fq;
        const float ka = (act == 2) ? 0.f : 1.f, kb = (act == 2) ? 1.f : 0.f, kc = (act == 0) ? 0.f : 1.f, kd = (act == 0) ? 1.f : 0.f;
#pragma unroll
        for (int ai = 0; ai < 2; ++ai)
#pragma unroll
            for (int m = 0; m < 4; ++m) { bf16_t* rp = p0 + (size_t)(ai * 128 + m * 16) * ldc;
#pragma unroll
                for (int bj = 0; bj < 2; ++bj) { f32x4 v0 = acc[ai][bj][m][0], v1 = acc[ai][bj][m][1];
#pragma unroll
                    for (int j = 0; j < 4; ++j) { v0[j] = (ka * v0[j] + kb) * (kc * sigmoid_f(v0[j]) + kd); v1[j] = (ka * v1[j] + kb) * (kc * sigmoid_f(v1[j]) + kd); }
                    u32x4 w; w.x = cvt_pk_bf16(v0[0], v0[1]); w.y = cvt_pk_bf16(v0[2], v0[3]); w.z = cvt_pk_bf16(v1[0], v1[1]); w.w = cvt_pk_bf16(v1[2], v1[3]);
                    *(u32x4*)(rp + bj * 128) = w; } }
    }
};
struct EpiPlain {
    static constexpr bool PERM = true;
    bf16_t* O; int ldc;
    __device__ __forceinline__ void operator()(const f32x4 (&acc)[2][2][4][2], const pg8::Unit& u, int wr, int wc, int fr, int fq) const {
        bf16_t* p0 = O + (size_t)(u.pm * 256 + wr * 64 + fr) * ldc + u.pn * 256 + wc * 32 + 8 * fq;
        store_tile_bf16<0>(acc, p0, p0 + 128, ldc);
    }
};
struct EpiKV {
    static constexpr bool PERM = true;
    bf16_t *KF, *VM;
    __device__ __forceinline__ void operator()(const f32x4 (&acc)[2][2][4][2], const pg8::Unit& u, int wr, int wc, int fr, int fq) const {
        const int row = u.pm * 256 + wr * 64 + fr, cin = wc * 32 + 8 * fq;
        const bool isk = u.pn < 4; const int ldc = isk ? 1536 : 1024;
        bf16_t* p0 = (isk ? KF + (u.pn * 2) * 192 : VM + (u.pn - 4) * 256) + (size_t)row * ldc + cin;
        store_tile_bf16<0>(acc, p0, p0 + (isk ? 192 : 128), ldc);
    }
};
template <int B> struct EpiBranch {
    static constexpr bool PERM = true;
    const bf16_t* MG; float* Y; bf16_t* YB;
    __device__ __forceinline__ void operator()(const f32x4 (&acc)[2][2][4][2], const pg8::Unit& u, int wr, int wc, int fr, int fq) const {
        const int row0 = u.pm * 256 + wr * 64 + fr, col0 = u.pn * 256 + wc * 32 + 8 * fq;
#pragma unroll
        for (int ai = 0; ai < 2; ++ai)
#pragma unroll
            for (int m = 0; m < 4; ++m)
#pragma unroll
                for (int bj = 0; bj < 2; ++bj) {
                    const size_t r = (size_t)(row0 + ai * 128 + m * 16); const int c = col0 + bj * 128;
                    const u32x4 gw = *(const u32x4*)(MG + r * 6144 + B * 2048 + c);
                    f32x4 v0 = acc[ai][bj][m][0], v1 = acc[ai][bj][m][1];
                    v0[0] *= bf_lo(gw.x); v0[1] *= bf_hi(gw.x); v0[2] *= bf_lo(gw.y); v0[3] *= bf_hi(gw.y);
                    v1[0] *= bf_lo(gw.z); v1[1] *= bf_hi(gw.z); v1[2] *= bf_lo(gw.w); v1[3] *= bf_hi(gw.w);
                    float* yp = Y + r * 2048 + c;
                    if (B > 0) { v0 += *(const f32x4*)yp; v1 += *(const f32x4*)(yp + 4); }
                    if (B < 2) { *(f32x4*)yp = v0; *(f32x4*)(yp + 4) = v1; }
                    else { u32x4 w; w.x = cvt_pk_bf16(v0[0], v0[1]); w.y = cvt_pk_bf16(v0[2], v0[3]); w.z = cvt_pk_bf16(v1[0], v1[1]); w.w = cvt_pk_bf16(v1[2], v1[3]); *(u32x4*)(YB + r * 2048 + c) = w; }
                }
    }
};
struct EpiOut {
    static constexpr bool PERM = false;
    const float* X; float* O; const float* gate0  ; int bbase, S;
    __device__ __forceinline__ void operator()(const f32x4 (&acc)[2][2][4][2], const pg8::Unit& u, int wr, int wc, int fr, int fq) const {
        const int row0 = u.pm * 256 + wr * 64 + fr, col0 = u.pn * 256 + wc * 32 + 4 * fq;
        const float* gp = gate0 + (size_t)(bbase + (u.pm * 256) / S) * 6144 + col0;
        f32x4 gv[2][2];
#pragma unroll
        for (int bj = 0; bj < 2; ++bj)
#pragma unroll
            for (int n = 0; n < 2; ++n) gv[bj][n] = *(const f32x4*)(gp + bj * 128 + n * 16);
#pragma unroll
        for (int ai = 0; ai < 2; ++ai)
#pragma unroll
            for (int m = 0; m < 4; ++m) { const size_t ro = (size_t)(row0 + ai * 128 + m * 16) * 2048 + col0;
#pragma unroll
                for (int bj = 0; bj < 2; ++bj)
#pragma unroll
                    for (int n = 0; n < 2; ++n) { const size_t o = ro + bj * 128 + n * 16; *(f32x4*)(O + o) = *(const f32x4*)(X + o) + gv[bj][n] * acc[ai][bj][m][n]; } }
    }
};
namespace att {
constexpr int NW = 8, QBLK = 32, KVBLK = 64;
constexpr float THR = 8.f;
constexpr size_t SHM_V = KVBLK * 128 * 2;
#define KSWZ(row, colB) ((row) * 256 + ((colB) ^ (((row) & 7) << 4)))
#define KSWZ192(row, colB) ((row) * 384 + ((colB) ^ (((row) & 7) << 4)))
#define SBAR() __builtin_amdgcn_sched_barrier(0)
__device__ __forceinline__ int crow(int r, int hi) { return (r & 3) + 8 * (r >> 2) + 4 * hi; }
__device__ __forceinline__ unsigned cvtpk(float lo, float hi) { unsigned r; asm volatile("v_cvt_pk_bf16_f32 %0, %1, %2" : "=v"(r) : "v"(lo), "v"(hi)); return r; }
__device__ __forceinline__ bf16x8 ld8(const bf16_t* p) { return *reinterpret_cast<const bf16x8*>(p); }

template <bool WIN> __device__ __forceinline__ void partialSM(f32x16& p0, f32x16& p1, float& m_reg, float& mn, float& alpha, const float C, const float* tl) {
  if constexpr (WIN) {
#pragma unroll
    for (int r = 0; r < 16; ++r) { p0[r] = fmaf(p0[r], C, tl[(r & 3) + 8 * (r >> 2)]); p1[r] = fmaf(p1[r], C, tl[32 + (r & 3) + 8 * (r >> 2)]); }
  }
  float pmax = p0[0];
#pragma unroll
  for (int r = 1; r < 16; ++r) pmax = fmaxf(pmax, p0[r]);
#pragma unroll
  for (int r = 0; r < 16; ++r) pmax = fmaxf(pmax, p1[r]);
  { auto rr = __builtin_amdgcn_permlane32_swap(__float_as_uint(pmax), __float_as_uint(pmax), false, false);
    pmax = fmaxf(__uint_as_float(rr[0]), __uint_as_float(rr[1])); }
  if constexpr (WIN) {
    if (__builtin_expect(__all(pmax - m_reg <= THR * 1.4426950408889634f), 1)) { mn = m_reg; alpha = 1.f; }
    else { mn = fmaxf(m_reg, pmax); alpha = __builtin_amdgcn_exp2f(m_reg - mn); m_reg = mn; }
#pragma unroll
    for (int r = 0; r < 16; ++r) { p0[r] -= mn; p1[r] -= mn; }
  } else {
    if (__builtin_expect(__all((pmax - m_reg) * C <= THR * 1.4426950408889634f), 1)) { mn = m_reg; alpha = 1.f; }
    else { mn = fmaxf(m_reg, pmax); alpha = __builtin_amdgcn_exp2f((m_reg - mn) * C); m_reg = mn; }
    const float mnC = -mn * C;
#pragma unroll
    for (int r = 0; r < 16; ++r) { p0[r] = fmaf(p0[r], C, mnC); p1[r] = fmaf(p1[r], C, mnC); }
  }
#pragma unroll
  for (int r = 0; r < 16; ++r) p0[r] = __builtin_amdgcn_exp2f(p0[r]);
}
__device__ __forceinline__ void finishSM(f32x16& p0, f32x16& p1, float alpha, float& l_reg, bf16x8& pa0, bf16x8& pa1, bf16x8& pa2, bf16x8& pa3) {
#pragma unroll
  for (int r = 0; r < 16; ++r) p1[r] = __builtin_amdgcn_exp2f(p1[r]);
  float ps = 0;
#pragma unroll
  for (int r = 0; r < 16; ++r) ps += p0[r];
#pragma unroll
  for (int r = 0; r < 16; ++r) ps += p1[r];
  { auto rr = __builtin_amdgcn_permlane32_swap(__float_as_uint(ps), __float_as_uint(ps), false, false);
    ps = __uint_as_float(rr[0]) + __uint_as_float(rr[1]); }
  l_reg = l_reg * alpha + ps;
#define PK4(P, BASE, OUT) do { unsigned a0 = cvtpk(P[BASE + 0], P[BASE + 1]), a1 = cvtpk(P[BASE + 2], P[BASE + 3]);   \
    unsigned b0 = cvtpk(P[BASE + 4], P[BASE + 5]), b1 = cvtpk(P[BASE + 6], P[BASE + 7]);                              \
    auto r0 = __builtin_amdgcn_permlane32_swap(a0, b0, false, false); auto r1 = __builtin_amdgcn_permlane32_swap(a1, b1, false, false); \
    u32x4 w = {r0[0], r1[0], r0[1], r1[1]}; OUT = *reinterpret_cast<bf16x8*>(&w); } while (0)
  PK4(p0, 0, pa0); PK4(p0, 8, pa1); PK4(p1, 0, pa2); PK4(p1, 8, pa3);
#undef PK4
}
template <int DK> __device__ __forceinline__ void qkt(f32x16& p0, f32x16& p1, const char* Ks, const bf16x8* qr, int r32, int hi) {
  p0 = f32x16{}; p1 = f32x16{};
#pragma unroll
  for (int d0 = 0; d0 < DK / 16; ++d0) { const int cb = (d0 * 16 + hi * 8) * 2;
    const bf16x8 b0 = *reinterpret_cast<const bf16x8*>(Ks + (DK == 128 ? KSWZ(r32, cb) : KSWZ192(r32, cb)));
    const bf16x8 b1 = *reinterpret_cast<const bf16x8*>(Ks + (DK == 128 ? KSWZ(32 + r32, cb) : KSWZ192(32 + r32, cb)));
    p0 = __builtin_amdgcn_mfma_f32_32x32x16_bf16(b0, qr[d0], p0, 0, 0, 0);
    p1 = __builtin_amdgcn_mfma_f32_32x32x16_bf16(b1, qr[d0], p1, 0, 0, 0); }
}
__device__ __forceinline__ int v_st(int k, int c) { const int kk = (k & ~0xC) | ((k & 4) << 1) | ((k & 8) >> 1); return ((kk >> 3) * 4 + (c >> 5)) * 512 + ((kk & 7) * 32 + (c & 31)) * 2; }
__device__ __forceinline__ int v_rd_base(int lane) { return ((lane & 3) << 3) | (((lane >> 2) & 3) << 6) | (((lane >> 4) & 1) << 5) | (((lane >> 5) & 1) << 8); }
constexpr int v_rd_off(int d0, int ks, int half) { return d0 * 512 + ks * 4096 + half * 2048; }
template <int OFF> __device__ __forceinline__ s16x4 tr_read(int vb) {
  s16x4 r; asm volatile("ds_read_b64_tr_b16 %0, %1 offset:%2" : "=&v"(r) : "v"(vb), "i"(OFF) : "memory"); return r;
}
template <int D0> __device__ __forceinline__ void pv_one(f32x16& od, int vb, bf16x8 pa0, bf16x8 pa1, bf16x8 pa2, bf16x8 pa3) {
  const s16x4 l0 = tr_read<v_rd_off(D0, 0, 0)>(vb), h0 = tr_read<v_rd_off(D0, 0, 1)>(vb), l1 = tr_read<v_rd_off(D0, 1, 0)>(vb), h1 = tr_read<v_rd_off(D0, 1, 1)>(vb);
  const s16x4 l2 = tr_read<v_rd_off(D0, 2, 0)>(vb), h2 = tr_read<v_rd_off(D0, 2, 1)>(vb), l3 = tr_read<v_rd_off(D0, 3, 0)>(vb), h3 = tr_read<v_rd_off(D0, 3, 1)>(vb);
  asm volatile("s_waitcnt lgkmcnt(0)" ::: "memory"); SBAR();
#define PK(L, H) (bf16x8){L[0], L[1], L[2], L[3], H[0], H[1], H[2], H[3]}
  od = __builtin_amdgcn_mfma_f32_32x32x16_bf16(pa0, PK(l0, h0), od, 0, 0, 0);
  od = __builtin_amdgcn_mfma_f32_32x32x16_bf16(pa1, PK(l1, h1), od, 0, 0, 0);
  od = __builtin_amdgcn_mfma_f32_32x32x16_bf16(pa2, PK(l2, h2), od, 0, 0, 0);
  od = __builtin_amdgcn_mfma_f32_32x32x16_bf16(pa3, PK(l3, h3), od, 0, 0, 0);
#undef PK
}
__device__ __forceinline__ void pv_d0(f32x16* o, int vb, bf16x8 pa0, bf16x8 pa1, bf16x8 pa2, bf16x8 pa3) {
  pv_one<0>(o[0], vb, pa0, pa1, pa2, pa3); pv_one<1>(o[1], vb, pa0, pa1, pa2, pa3); pv_one<2>(o[2], vb, pa0, pa1, pa2, pa3); pv_one<3>(o[3], vb, pa0, pa1, pa2, pa3);
}
constexpr size_t lds_bytes(int DK) { return 2 * SHM_V + 2 * (size_t)KVBLK * DK * 2 + NW * 64 * 4 + 768 * 4; }

template <int DK, int SD, int LDQ, int LDK, int LDV, int LDO, bool WIN>
__device__ __forceinline__ void attn_unit(const bf16_t* __restrict__ Qb, const bf16_t* __restrict__ Kh, const bf16_t* __restrict__ Vh, bf16_t* __restrict__ Ob,
                                          const int NT, const float m_init, const float l_init, const float* __restrict__ tbg, const int tb0, char* lds) {
  constexpr int ND = DK / 16;
  constexpr size_t SHM_K = (size_t)KVBLK * DK * 2;
  constexpr float SCALE = (DK == 128) ? 0.088388347648318440f : 0.072168783648703220f;
  constexpr float C = SCALE * 1.4426950408889634f;
  int tid_ = threadIdx.x; asm volatile("" : "+v"(tid_));
  const int tid = tid_, wid = tid >> 6, lane = tid & 63, r32 = lane & 31, hi = lane >> 5;
  char* V_lds = lds; char* K_lds = lds + 2 * SHM_V;
  float* ws = (float*)(lds + 2 * SHM_V + 2 * SHM_K) + wid * 64; float* li_l = ws; float* al_l = ws + 32;
  float* tbl = (float*)(lds + 2 * SHM_V + 2 * SHM_K + NW * 64 * 4);
  __syncthreads();
  if constexpr (WIN) { for (int i = tid; i < 768; i += 512) tbl[i] = tbg[i]; }
  const float* tlw = tbl + (tb0 - wid * 32 - r32 + 4 * hi);
  float m_reg = m_init, l_reg = l_init; f32x16 o[4] = {}; bf16x8 qr[ND];
  const bf16_t* Qw = Qb + (long)(wid * QBLK + r32) * LDQ + hi * 8;
#pragma unroll
  for (int d0 = 0; d0 < ND; ++d0) qr[d0] = ld8(Qw + d0 * 16);
  const int sr = tid >> 4, sc = (tid & 15) * 8, vst0 = v_st(sr, sc), vst1 = v_st(32 + sr, sc);
  const int kr0 = tid >> 3, kc0 = tid & 7;
  const int vb0 = (int)(uintptr_t)V_lds + v_rd_base(lane);
  struct Slot { bf16x8 vs0, vs1, ks0, ks1, ks2; } sr_[SD];
#define SLOAD(i, k0) do { sr_[i].vs0 = ld8(&Vh[(long)((k0) + sr) * LDV + sc]); sr_[i].vs1 = ld8(&Vh[(long)((k0) + 32 + sr) * LDV + sc]); \
    if constexpr (DK == 128) { sr_[i].ks0 = ld8(&Kh[(long)((k0) + sr) * LDK + sc]); sr_[i].ks1 = ld8(&Kh[(long)((k0) + 32 + sr) * LDK + sc]); } \
    else { const bf16_t* kp_ = &Kh[(long)((k0) + kr0) * LDK + kc0 * 8]; sr_[i].ks0 = ld8(kp_); sr_[i].ks1 = ld8(kp_ + 64); sr_[i].ks2 = ld8(kp_ + 128); } } while (0)
#define SWRITE(b, i) do { *(bf16x8*)(V_lds + (b) * SHM_V + vst0) = sr_[i].vs0; *(bf16x8*)(V_lds + (b) * SHM_V + vst1) = sr_[i].vs1; \
    if constexpr (DK == 128) { const int kc = sc * 2; *(bf16x8*)(K_lds + (b) * SHM_K + KSWZ(sr, kc)) = sr_[i].ks0; *(bf16x8*)(K_lds + (b) * SHM_K + KSWZ(32 + sr, kc)) = sr_[i].ks1; } \
    else { char* kw_ = K_lds + (b) * SHM_K + KSWZ192(kr0, kc0 * 16); *(bf16x8*)kw_ = sr_[i].ks0; *(bf16x8*)(kw_ + 128) = sr_[i].ks1; *(bf16x8*)(kw_ + 256) = sr_[i].ks2; } } while (0)
#define SWAIT() do { if constexpr (SD == 2) { if constexpr (DK == 128) asm volatile("s_waitcnt vmcnt(4)" ::: "memory"); else asm volatile("s_waitcnt vmcnt(5)" ::: "memory"); } \
    else asm volatile("s_waitcnt vmcnt(0)" ::: "memory"); } while (0)
#define RESC(a) do { if (__any((a) < 1.f)) { if (hi == 0) al_l[r32] = (a); asm volatile("s_waitcnt lgkmcnt(0)" ::: "memory"); \
    _Pragma("unroll") for (int d = 0; d < 4; ++d) _Pragma("unroll") for (int r = 0; r < 16; ++r) o[d][r] *= al_l[crow(r, hi)]; } } while (0)
  f32x16 pA0, pA1, pB0, pB1; float mnA, mnB, alA, alB; bf16x8 pa0, pa1, pa2, pa3;
  constexpr int SE = 0, SO = SD - 1;
  SLOAD(SE, 0); asm volatile("s_waitcnt vmcnt(0)" ::: "memory"); SWRITE(0, SE); __syncthreads();
  qkt<DK>(pA0, pA1, K_lds, qr, r32, hi); partialSM<WIN>(pA0, pA1, m_reg, mnA, alA, C, tlw);
  SLOAD(SO, KVBLK); if constexpr (SD == 2) { if (2 < NT) SLOAD(SE, 2 * KVBLK); }
  SWAIT(); SWRITE(1, SO); __syncthreads();
  for (int j = 1; j + 1 < NT; j += 2) {
    SBAR(); qkt<DK>(pB0, pB1, K_lds + SHM_K, qr, r32, hi);
    finishSM(pA0, pA1, alA, l_reg, pa0, pa1, pa2, pa3); SBAR();
    SLOAD(SO, (j + SD) * KVBLK); SBAR();
    pv_d0(o, vb0, pa0, pa1, pa2, pa3); partialSM<WIN>(pB0, pB1, m_reg, mnB, alB, C, tlw + 64 * j);
    __syncthreads(); SWAIT(); SWRITE(0, SE);
    RESC(alB); __syncthreads();
    SBAR(); qkt<DK>(pA0, pA1, K_lds, qr, r32, hi);
    finishSM(pB0, pB1, alB, l_reg, pa0, pa1, pa2, pa3); SBAR();
    if (SD == 1 || j + 3 < NT) SLOAD(SE, (j + 1 + SD) * KVBLK); SBAR();
    pv_d0(o, vb0 + (int)SHM_V, pa0, pa1, pa2, pa3); partialSM<WIN>(pA0, pA1, m_reg, mnA, alA, C, tlw + 64 * (j + 1));
    __syncthreads(); SWAIT(); SWRITE(1, SO);
    RESC(alA); __syncthreads();
  }
  SBAR(); qkt<DK>(pB0, pB1, K_lds + SHM_K, qr, r32, hi);
  finishSM(pA0, pA1, alA, l_reg, pa0, pa1, pa2, pa3); SBAR();
  pv_d0(o, vb0, pa0, pa1, pa2, pa3); partialSM<WIN>(pB0, pB1, m_reg, mnB, alB, C, tlw + 64 * (NT - 1));
  __syncthreads(); RESC(alB);
  finishSM(pB0, pB1, alB, l_reg, pa0, pa1, pa2, pa3); SBAR();
  pv_d0(o, vb0 + (int)SHM_V, pa0, pa1, pa2, pa3);
  if (hi == 0) li_l[r32] = l_reg; asm volatile("s_waitcnt lgkmcnt(0)" ::: "memory");
  float rli[16];
#pragma unroll
  for (int r = 0; r < 16; ++r) rli[r] = __builtin_amdgcn_rcpf(li_l[crow(r, hi)]);
  bf16_t* Ow = Ob + (long)(wid * QBLK) * LDO + r32;
#pragma unroll
  for (int r = 0; r < 16; ++r) { const int orow = crow(r, hi);
#pragma unroll
    for (int d0 = 0; d0 < 4; ++d0) { bf16_t* p = Ow + (long)orow * LDO + d0 * 32; const float g = bf2f(*p); *p = f2bf(o[d0][r] * rli[r] * g); } }
#undef SLOAD
#undef SWRITE
#undef SWAIT
#undef RESC
}
}
constexpr int DM = 2048, DEPTH = 4, NPASS = 3, TP = 16384, NIN = 13120, NINP = 13312, NWAVES = 8;
constexpr int T_PROMPT = 32768, T_SAMPLE = 16384;
constexpr float RMS_EPS = 1e-6f;
constexpr int KS_ADA = 32;
constexpr int NSTEP_PRO = 2, NSTEP_IT = 8, NSTEPS = NSTEP_PRO + DEPTH * NPASS * NSTEP_IT;
constexpr size_t MiB = 1u << 20;
constexpr size_t WS_CTL = 0, CTL_ZERO_BYTES = 1 * MiB;
constexpr size_t WS_PTRS = 512 * 1024;
constexpr size_t WS_MOD = 1 * MiB;
constexpr size_t WS_ROPE = 3 * MiB;
constexpr size_t WS_TB = 4 * MiB;
constexpr size_t WS_MODP = 5 * MiB;
constexpr size_t WS_WIN_T = 64 * MiB;
constexpr size_t WS_WQ_T = 272 * MiB;
constexpr size_t WS_WKV_T = 278 * MiB;
constexpr size_t WS_WBR_T = 282 * MiB;
constexpr size_t WS_WOUT_T = 330 * MiB;
constexpr size_t WS_H = 362 * MiB;
constexpr size_t WS_CQKV = 426 * MiB;
constexpr size_t WS_QM = 458 * MiB;
constexpr size_t WS_KF = 506 * MiB;
constexpr size_t WS_VM = 554 * MiB;
constexpr size_t WS_Y = WS_QM;
constexpr size_t WS_AX = 586 * MiB;
constexpr size_t WS_WINB = 634 * MiB;
constexpr size_t WS_G = 682 * MiB;
constexpr size_t WS_MG = 778 * MiB;
constexpr size_t WS_END = 970 * MiB;
static_assert(WS_WIN_T + (size_t)4 * NINP * DM * 2 <= WS_WQ_T && WS_MODP + (size_t)KS_ADA * 4 * 16 * 6144 * 4 <= WS_WIN_T && WS_MG + (size_t)TP * 6144 * 2 <= WS_END, "d_ws map");
static_assert((size_t)TP * 2048 * 4 == WS_AX - WS_QM, "Y overlays exactly QM|KF|VM");
constexpr int RING_OFF = 0, RING_BYTES = 131072;
constexpr int LDSCTL_OFF = RING_BYTES;
constexpr int LDS_BYTES = 147456;
static_assert(att::lds_bytes(192) <= RING_BYTES, "attention LDS");

#define LDS_WAIT() asm volatile("s_waitcnt lgkmcnt(0)" ::: "memory")
#define VM_WAIT() asm volatile("s_waitcnt vmcnt(0)" ::: "memory")

#define XB_TMO      128
#define XB_XCNT(j)  (256  + 64 * (j))
#define XB_XSUB(j)  (1280 + 64 * (j))
#define XB_XGEN(j)  (2304 + 64 * (j))
#define XB_TOP      3328
#define XB_TOPGEN   3392
#define XCD_BAR_WORDS 3456
#define XB_SPIN_CAP (1u << 22)

__device__ __forceinline__ unsigned xb_ld(unsigned* p)              { return __hip_atomic_load(p, __ATOMIC_RELAXED, __HIP_MEMORY_SCOPE_AGENT); }
__device__ __forceinline__ unsigned xb_add(unsigned* p, unsigned v) { return __hip_atomic_fetch_add(p, v, __ATOMIC_RELAXED, __HIP_MEMORY_SCOPE_AGENT); }
__device__ __forceinline__ unsigned xb_xcc_id() { return (unsigned)__builtin_amdgcn_s_getreg((3 << 11) | 20) & 0xFu; }
#define XB_SPIN(cond, bar) do { unsigned _sp = 0; while (cond) { __builtin_amdgcn_s_sleep(1); \
    if ((++_sp & 255u) == 0u) { if (xb_ld(&(bar)[XB_TMO])) break; if (_sp > XB_SPIN_CAP) { atomicAdd(&(bar)[XB_TMO], 1u); break; } } } } while (0)

struct XcdBarrier {
    unsigned* bar; unsigned x;
    volatile LAS unsigned* st;
};
__device__ __forceinline__ XcdBarrier xcd_barrier_post(unsigned* bar, volatile LAS unsigned* st) {
    XcdBarrier b; b.bar = bar; b.x = xb_xcc_id(); b.st = st;
    if (threadIdx.x == 0) (void)xb_add(&bar[XB_XCNT(b.x)], 1u);
    return b;
}
__device__ __forceinline__ void xcd_barrier_complete(unsigned* bar, unsigned x, unsigned& nloc, unsigned& nx) {
    const unsigned G = gridDim.x * gridDim.y * gridDim.z;
    unsigned sum, cnt, mine, sp = 0u;
    for (;;) {
        sum = 0u; cnt = 0u; mine = 0u;
#pragma unroll
        for (unsigned j = 0; j < 16; ++j) { const unsigned c = xb_ld(&bar[XB_XCNT(j)]); sum += c; cnt += (c > 0u) ? 1u : 0u; }
        mine = xb_ld(&bar[XB_XCNT(x)]);
        if (sum == G) break;
        __builtin_amdgcn_s_sleep(1);
        if ((++sp & 255u) == 0u) { if (xb_ld(&bar[XB_TMO])) break; if (sp > XB_SPIN_CAP) { atomicAdd(&bar[XB_TMO], 1u); break; } }
    }
    nloc = mine > 0u ? mine : 1u; nx = cnt > 0u ? cnt : 1u;
}
__device__ __forceinline__ void xcd_barrier(const XcdBarrier& b) {
    asm volatile("s_waitcnt vmcnt(0)" ::: "memory");
    __syncthreads();
    if (threadIdx.x == 0) {
        unsigned* bar = b.bar;
        __builtin_amdgcn_s_waitcnt(0);
        unsigned nloc = b.st[0], nx = b.st[1];
        if (nloc == 0u) { xcd_barrier_complete(bar, b.x, nloc, nx); b.st[0] = nloc; b.st[1] = nx; }
        const unsigned old = xb_add(&bar[XB_XSUB(b.x)], 1u);
        const unsigned gen = old / nloc;
        if (old + 1u == (gen + 1u) * nloc) {
            __builtin_amdgcn_fence(__ATOMIC_RELEASE, "agent");
            asm volatile("s_waitcnt vmcnt(0)" ::: "memory");
            const unsigned og = xb_add(&bar[XB_TOP], 1u);
            const unsigned tg = og / nx;
            if (og + 1u == (tg + 1u) * nx) xb_add(&bar[XB_TOPGEN], 1u);
            else XB_SPIN(xb_ld(&bar[XB_TOPGEN]) == tg, bar);
            __builtin_amdgcn_fence(__ATOMIC_ACQUIRE, "agent");
            xb_add(&bar[XB_XGEN(b.x)], 1u);
            asm volatile("s_waitcnt vmcnt(0)" ::: "memory");
        } else {
            XB_SPIN(xb_ld(&bar[XB_XGEN(b.x)]) == gen, bar);
            __builtin_amdgcn_fence(__ATOMIC_ACQUIRE, "agent");
            asm volatile("s_waitcnt vmcnt(0)" ::: "memory");
        }
    }
    __syncthreads();
}

template <int M> __device__ __forceinline__ float shx(float v) { return __builtin_bit_cast(float, __builtin_amdgcn_ds_swizzle(__builtin_bit_cast(int, v), (M << 10) | 0x1f)); }
__device__ __forceinline__ float sum16(float v) {
    v += shx<1>(v); v += shx<2>(v); v += shx<4>(v); v += shx<8>(v); return v;
}
__device__ __forceinline__ float wave_sum(float v) {
    v = sum16(v); v += shx<16>(v);
    const auto rr = __builtin_amdgcn_permlane32_swap(__builtin_bit_cast(unsigned, v), __builtin_bit_cast(unsigned, v), false, false);
    return __builtin_bit_cast(float, rr[0]) + __builtin_bit_cast(float, rr[1]);
}
__device__ __forceinline__ void tr_item(const float* W, int N, int k0, int n0, bf16_t* dst, int ldd, LAS float* scr, int lane) {
#pragma unroll 8
    for (int i = 0; i < 32; ++i) { const int kk = 2 * i + (lane >> 5); scr[kk * 33 + (lane & 31)] = W[(size_t)(k0 + kk) * N + n0 + (lane & 31)]; }
    LDS_WAIT(); asm volatile("" ::: "memory");
    const int c = lane & 7;
#pragma unroll
    for (int j = 0; j < 4; ++j) { const int n = (lane >> 3) + 8 * j; const LAS float* s = scr + (8 * c) * 33 + n;
        u32x4 o; o.x = cvt_pk_bf16(s[0 * 33], s[1 * 33]); o.y = cvt_pk_bf16(s[2 * 33], s[3 * 33]); o.z = cvt_pk_bf16(s[4 * 33], s[5 * 33]); o.w = cvt_pk_bf16(s[6 * 33], s[7 * 33]);
        *(u32x4*)(dst + (size_t)n * ldd + 8 * c) = o; }
    LDS_WAIT(); asm volatile("" ::: "memory");
}
__device__ __forceinline__ void sincos_acc(float ang, float& co, float& si) {
    const double a = (double)ang; const double k = __builtin_rint(a * 0.63661977236758134308);
    const double r = (a - k * 1.5707963267948966192) - k * 6.123233995736766e-17, r2 = r * r;
    const double s = r * (1.0 + r2 * (-1.0 / 6 + r2 * (1.0 / 120 + r2 * (-1.0 / 5040 + r2 * (1.0 / 362880 + r2 * (-1.0 / 39916800 + r2 * (1.0 / 6227020800.0)))))));
    const double c = 1.0 + r2 * (-0.5 + r2 * (1.0 / 24 + r2 * (-1.0 / 720 + r2 * (1.0 / 40320 + r2 * (-1.0 / 3628800 + r2 * (1.0 / 479001600.0 + r2 * (-1.0 / 87178291200.0)))))));
    const int q = (int)(long long)k & 3;
    const double cc = (q == 0) ? c : (q == 1) ? -s : (q == 2) ? -c : s;
    const double ss = (q == 0) ? s : (q == 1) ? c : (q == 2) ? -s : -c;
    co = (float)cc; si = (float)ss;
}
__device__ const float ROPE_FREQ[32] = {1.f, 0.749894261f, 0.562341332f, 0.421696514f, 0.316227764f, 0.237137377f, 0.177827939f, 0.133352131f, 0.100000001f, 0.0749894157f, 0.0562341325f,
    0.0421696529f, 0.0316227749f, 0.0237137377f, 0.0177827943f, 0.0133352149f, 0.00999999978f, 0.00749894185f, 0.00562341325f, 0.00421696482f, 0.00316227763f, 0.00237137359f, 0.00177827943f,
    0.00133352145f, 0.00100000005f, 0.000749894243f, 0.000562341302f, 0.000421696517f, 0.000316227757f, 0.00023713737f, 0.00017782794f, 0.00013335215f};

struct Frame {
    LAS unsigned char* lds; unsigned char* ws;
    int tid, lane, wave, vcu, G;
    const float* const* in;
};
__device__ __forceinline__ void step_prologue(const float* const (&in)[24], unsigned char* ws, LAS unsigned char* lds, int tid, int lane, int wave, int vcu, int G) {
    LAS float* scr = (LAS float*)(lds + RING_OFF + wave * 16384);
    const int gw = vcu * NWAVES + wave, NGW = G * NWAVES;
    const int gt = (vcu * NWAVES + wave) * 64 + lane, NT = G * NWAVES * 64;
    bf16_t* WIN_T = (bf16_t*)(ws + WS_WIN_T); bf16_t* WQ_T = (bf16_t*)(ws + WS_WQ_T); bf16_t* WKV_T = (bf16_t*)(ws + WS_WKV_T);
    bf16_t* WBR_T = (bf16_t*)(ws + WS_WBR_T); bf16_t* WOUT_T = (bf16_t*)(ws + WS_WOUT_T);
    {
        const float* cP = in[2]; const float* cS = in[3]; const float* w_ada = in[5]; float* modp = (float*)(ws + WS_MODP);
        for (int u = gw; u < DEPTH * 48 * KS_ADA; u += NGW) {
            const int ks = u % KS_ADA, cc = (u / KS_ADA) % 48, l = u / (KS_ADA * 48);
#pragma unroll 1
            for (int b = 0; b < 16; ++b) scr[b * 64 + lane] = (b < 8 ? cP + (size_t)b * DM : cS + (size_t)(b - 8) * DM)[ks * 64 + lane];
            LDS_WAIT(); asm volatile("" ::: "memory");
            f32x2 acc[16];
#pragma unroll
            for (int b = 0; b < 16; ++b) acc[b] = (f32x2){0.f, 0.f};
            const float* wp = w_ada + ((size_t)l * DM + ks * 64) * 6144 + cc * 128 + lane * 2;
#pragma unroll 1
            for (int k4 = 0; k4 < 16; ++k4) {
                f32x2 w[4];
#pragma unroll
                for (int q = 0; q < 4; ++q) w[q] = *(const f32x2*)(wp + (size_t)(k4 * 4 + q) * 6144);
#pragma unroll
                for (int b = 0; b < 16; ++b) { const f32x4 cv = *(const LAS f32x4*)(scr + b * 64 + k4 * 4);
                    acc[b] += w[0] * cv[0]; acc[b] += w[1] * cv[1]; acc[b] += w[2] * cv[2]; acc[b] += w[3] * cv[3]; }
            }
#pragma unroll
            for (int b = 0; b < 16; ++b) *(f32x2*)(modp + ((size_t)(ks * DEPTH + l) * 16 + b) * 6144 + cc * 128 + lane * 2) = acc[b];
            LDS_WAIT(); asm volatile("" ::: "memory");
        }
    }
    {
        constexpr int I_IN = (DM / 64) * (NIN / 32), I_Q = (512 / 64) * (1536 / 32), I_KV = (256 / 64) * (2048 / 32), I_BR = (1024 / 64) * (2048 / 32), I_OUT = (DM / 64) * (DM / 32);
        constexpr int I_L = I_IN + I_Q + I_KV + 3 * I_BR + I_OUT;
        for (int it = gw; it < DEPTH * I_L; it += NGW) {
            const int l = it / I_L; int r = it % I_L;
            if (r < I_IN) { const int nblk = NIN / 32, kb = r / nblk, nb = r % nblk, n0 = nb * 32, dn = n0 + (n0 >= 832 ? 192 : 0);
                tr_item(in[7] + (size_t)l * DM * NIN, NIN, kb * 64, n0, WIN_T + ((size_t)l * NINP + dn) * DM + kb * 64, DM, scr, lane); continue; }
            r -= I_IN;
            if (r < I_Q) { const int nblk = 1536 / 32, kb = r / nblk, nb = r % nblk;
                tr_item(in[9] + (size_t)l * 512 * 1536, 1536, kb * 64, nb * 32, WQ_T + ((size_t)l * 1536 + nb * 32) * 512 + kb * 64, 512, scr, lane); continue; }
            r -= I_Q;
            if (r < I_KV) { const int nblk = 2048 / 32, kb = r / nblk, nb = r % nblk, n0 = nb * 32, hh = n0 >> 8, wi = n0 & 255, dn = wi < 128 ? hh * 128 + wi : 1024 + hh * 128 + (wi - 128);
                tr_item(in[11] + (size_t)l * 256 * 2048, 2048, kb * 64, n0, WKV_T + ((size_t)l * 2048 + dn) * 256 + kb * 64, 256, scr, lane); continue; }
            r -= I_KV;
            if (r < 3 * I_BR) { const int br = r / I_BR, rr = r % I_BR, nblk = 2048 / 32, kb = rr / nblk, nb = rr % nblk;
                const float* src = (br == 0 ? in[20] : br == 1 ? in[21] : in[22]) + (size_t)l * 1024 * 2048;
                tr_item(src, 2048, kb * 64, nb * 32, WBR_T + ((size_t)l * 2048 + nb * 32) * 3072 + br * 1024 + kb * 64, 3072, scr, lane); continue; }
            r -= 3 * I_BR;
            { const int nblk = DM / 32, kb = r / nblk, nb = r % nblk;
                tr_item(in[23] + (size_t)l * DM * DM, DM, kb * 64, nb * 32, WOUT_T + ((size_t)l * DM + nb * 32) * DM + kb * 64, DM, scr, lane); }
        }
    }
    for (int e = gt; e < DEPTH * 192 * (DM / 8); e += NT) { const int l = e / (192 * (DM / 8)), r = e % (192 * (DM / 8));
        *(u32x4*)(WIN_T + ((size_t)l * NINP + 832) * DM + (size_t)r * 8) = (u32x4){0u, 0u, 0u, 0u}; }
    { f32x2* rope = (f32x2*)(ws + WS_ROPE);
      for (int e = gt; e < 4096 * 32; e += NT) { const float ang = (float)(e >> 5) * ROPE_FREQ[e & 31]; float c, s; sincos_acc(ang, c, s); rope[e] = (f32x2){c, s}; } }
    { float* tb = (float*)(ws + WS_TB); const float* rel_bias = in[19];
      for (int e = gt; e < 8 * 768; e += NT) { const int h = e / 768, rel = (e % 768) - 383, n = rel < 0 ? -rel : rel; float v = -1e30f;
          if (n <= 128) { int bk = rel > 0 ? 16 : 0;
              if (n < 8) bk += n; else bk += 8 + (n >= 12) + (n >= 16) + (n >= 23) + (n >= 32) + (n >= 46) + (n >= 64) + (n >= 91);
              v = rel_bias[bk * 8 + h] * 1.4426950408889634f; }
          tb[e] = v; } }
}
__device__ __forceinline__ void step_modreduce(const float* b_ada, unsigned char* ws, int gt, int NT) {
    const float* modp = (const float*)(ws + WS_MODP); float* mod = (float*)(ws + WS_MOD);
    for (int e = gt; e < DEPTH * 16 * 6144; e += NT) { const int l = e / (16 * 6144), j = e % 6144; float s = b_ada[l * 6144 + j];
#pragma unroll 8
        for (int ks = 0; ks < KS_ADA; ++ks) s += modp[(size_t)ks * (DEPTH * 16 * 6144) + e];
        mod[e] = s; }
}
__device__ __forceinline__ void step_norm(const float* x, bf16_t* H, const float* ln_g, const float* mod_l, int bbase, int S, int gw, int NGW, int lane) {
    for (int ch = gw; ch < TP / 8; ch += NGW) {
        const float* mb = mod_l + (size_t)(bbase + (ch * 8) / S) * 6144;
        f32x4 gs[8], sh[8];
#pragma unroll
        for (int j = 0; j < 8; ++j) { const int c = (64 * j + lane) * 4; const f32x4 g = *(const f32x4*)(ln_g + c), sc = *(const f32x4*)(mb + 2048 + c); gs[j] = g * (sc + 1.0f); sh[j] = *(const f32x4*)(mb + c); }
        for (int rr = 0; rr < 8; ++rr) { const size_t row = (size_t)ch * 8 + rr;
            const f32x4* xr = (const f32x4*)(x + row * DM) + lane; f32x4 v[8]; float ss = 0.f;
#pragma unroll
            for (int j = 0; j < 8; ++j) { v[j] = xr[64 * j]; ss += (v[j].x * v[j].x + v[j].y * v[j].y) + (v[j].z * v[j].z + v[j].w * v[j].w); }
            const float rstd = 1.0f / sqrtf(wave_sum(ss) * (1.0f / DM) + RMS_EPS);
            u32x2* o8 = (u32x2*)(H + row * DM) + lane;
#pragma unroll
            for (int j = 0; j < 8; ++j) { const f32x4 y = v[j] * rstd * gs[j] + sh[j]; o8[64 * j] = (u32x2){cvt_pk_bf16(y.x, y.y), cvt_pk_bf16(y.z, y.w)}; }
        }
    }
}
__device__ __forceinline__ void head128_norm_rope(bf16_t* base, const float* gain, bool do_rope, const f32x2* cs_row, const f32x2* cs_col, int j) {
    unsigned w[4]; float v[8];
#pragma unroll
    for (int q = 0; q < 4; ++q) { w[q] = *(const unsigned*)(base + 32 * q + 2 * j); v[2 * q] = bf_lo(w[q]); v[2 * q + 1] = bf_hi(w[q]); }
    float ss = 0.f;
#pragma unroll
    for (int e = 0; e < 8; ++e) ss += v[e] * v[e];
    const float rstd = 1.0f / sqrtf(sum16(ss) * (1.0f / 128) + RMS_EPS);
#pragma unroll
    for (int q = 0; q < 4; ++q) { const f32x2 g = *(const f32x2*)(gain + 32 * q + 2 * j); v[2 * q] *= rstd * g.x; v[2 * q + 1] *= rstd * g.y; }
    if (do_rope) {
        const f32x4 ca = *(const f32x4*)(cs_row + 2 * j), cb = *(const f32x4*)(cs_col + 2 * j);
        const float a0 = v[0], a1 = v[1], a2 = v[2], a3 = v[3], b0 = v[4], b1 = v[5], b2 = v[6], b3 = v[7];
        v[0] = a0 * ca.x - a2 * ca.y; v[1] = a1 * ca.z - a3 * ca.w; v[2] = a2 * ca.x + a0 * ca.y; v[3] = a3 * ca.z + a1 * ca.w;
        v[4] = b0 * cb.x - b2 * cb.y; v[5] = b1 * cb.z - b3 * cb.w; v[6] = b2 * cb.x + b0 * cb.y; v[7] = b3 * cb.z + b1 * cb.w;
    }
#pragma unroll
    for (int q = 0; q < 4; ++q) *(unsigned*)(base + 32 * q + 2 * j) = cvt_pk_bf16(v[2 * q], v[2 * q + 1]);
}
__device__ __forceinline__ void step_prep1(bf16_t* CQKV, bf16_t* AXb, bf16_t* WINb, const float* q_a_norm, const float* kv_a_norm, const float* ax_qn, const float* ax_kn,
                                           const float* win_qn, const float* win_kn, const f32x2* rope, int S, int gw, int NGW, int lane) {
    for (int ch = gw; ch < TP / 8; ch += NGW)
        for (int rr = 0; rr < 8; ++rr) { const size_t row = (size_t)ch * 8 + rr; const int s = (int)(row % (size_t)S);
            { bf16_t* p = CQKV + row * 1024 + lane * 8; const u32x4 w = *(const u32x4*)p; float v[8] = {bf_lo(w.x), bf_hi(w.x), bf_lo(w.y), bf_hi(w.y), bf_lo(w.z), bf_hi(w.z), bf_lo(w.w), bf_hi(w.w)};
              float ss = 0.f;
#pragma unroll
              for (int e = 0; e < 8; ++e) ss += v[e] * v[e];
              const float rstd = 1.0f / sqrtf(wave_sum(ss) * (1.0f / 512) + RMS_EPS);
              const f32x4 g0 = *(const f32x4*)(q_a_norm + lane * 8), g1 = *(const f32x4*)(q_a_norm + lane * 8 + 4);
              u32x4 o; o.x = cvt_pk_bf16(v[0] * rstd * g0.x, v[1] * rstd * g0.y); o.y = cvt_pk_bf16(v[2] * rstd * g0.z, v[3] * rstd * g0.w);
              o.z = cvt_pk_bf16(v[4] * rstd * g1.x, v[5] * rstd * g1.y); o.w = cvt_pk_bf16(v[6] * rstd * g1.z, v[7] * rstd * g1.w); *(u32x4*)p = o; }
            { bf16_t* p = CQKV + row * 1024 + 512 + lane * 4; const u32x2 w = *(const u32x2*)p; float v[4] = {bf_lo(w.x), bf_hi(w.x), bf_lo(w.y), bf_hi(w.y)};
              const float ss = (v[0] * v[0] + v[1] * v[1]) + (v[2] * v[2] + v[3] * v[3]);
              const float rstd = 1.0f / sqrtf(wave_sum(ss) * (1.0f / 256) + RMS_EPS);
              const f32x4 g = *(const f32x4*)(kv_a_norm + lane * 4);
              *(u32x2*)p = (u32x2){cvt_pk_bf16(v[0] * rstd * g.x, v[1] * rstd * g.y), cvt_pk_bf16(v[2] * rstd * g.z, v[3] * rstd * g.w)}; }
            const f32x2* cs_row = rope + (size_t)(s >> 6) * 32; const f32x2* cs_col = rope + (size_t)(s & 63) * 32;
#pragma unroll 1
            for (int it = 0; it < 5; ++it) { const int hh = it * 4 + (lane >> 4);
                const bool isax = hh < 10; const int hw = isax ? hh : hh - 10;
                bf16_t* base = (isax ? AXb : WINb) + row * 1536 + hw * 128;
                const float* gain = isax ? (hw < 8 ? ax_qn : ax_kn) : (hw < 8 ? win_qn : win_kn);
                head128_norm_rope(base, gain, isax, cs_row, cs_col, lane & 15); }
        }
}
__device__ __forceinline__ void step_prep2(bf16_t* QM, bf16_t* KF, const bf16_t* CQKV, const float* mla_qn, const float* mla_kn, const f32x2* rope, int S, int gw, int NGW, int lane) {
    const int j = lane & 15;
    for (int ch = gw; ch < TP / 8; ch += NGW)
        for (int rr = 0; rr < 8; ++rr) { const size_t row = (size_t)ch * 8 + rr; const int s = (int)(row % (size_t)S);
            const f32x4 cs = *(const f32x4*)(rope + (size_t)s * 32 + 2 * j);
#pragma unroll 1
            for (int it = 0; it < 4; ++it) { const int h = (it & 1) * 4 + (lane >> 4); const bool isq = it < 2;
                bf16_t* base = (isq ? QM : KF) + row * 1536 + h * 192; const float* gain = isq ? mla_qn : mla_kn;
                const u32x4 wn = *(const u32x4*)(base + 8 * j);
                unsigned r0, r1;
                if (isq) { r0 = *(const unsigned*)(base + 128 + 2 * j); r1 = *(const unsigned*)(base + 160 + 2 * j); }
                else { r0 = *(const unsigned*)(CQKV + row * 1024 + 768 + 2 * j); r1 = *(const unsigned*)(CQKV + row * 1024 + 800 + 2 * j); }
                float v[8] = {bf_lo(wn.x), bf_hi(wn.x), bf_lo(wn.y), bf_hi(wn.y), bf_lo(wn.z), bf_hi(wn.z), bf_lo(wn.w), bf_hi(wn.w)};
                float x0 = bf_lo(r0), x1 = bf_hi(r0), y0 = bf_lo(r1), y1 = bf_hi(r1);
                float ss = (x0 * x0 + x1 * x1) + (y0 * y0 + y1 * y1);
#pragma unroll
                for (int e = 0; e < 8; ++e) ss += v[e] * v[e];
                const float rstd = 1.0f / sqrtf(sum16(ss) * (1.0f / 192) + RMS_EPS);
                const f32x4 g0 = *(const f32x4*)(gain + 8 * j), g1 = *(const f32x4*)(gain + 8 * j + 4); const f32x2 gx = *(const f32x2*)(gain + 128 + 2 * j), gy = *(const f32x2*)(gain + 160 + 2 * j);
                u32x4 o; o.x = cvt_pk_bf16(v[0] * rstd * g0.x, v[1] * rstd * g0.y); o.y = cvt_pk_bf16(v[2] * rstd * g0.z, v[3] * rstd * g0.w);
                o.z = cvt_pk_bf16(v[4] * rstd * g1.x, v[5] * rstd * g1.y); o.w = cvt_pk_bf16(v[6] * rstd * g1.z, v[7] * rstd * g1.w);
                x0 *= rstd * gx.x; x1 *= rstd * gx.y; y0 *= rstd * gy.x; y1 *= rstd * gy.y;
                *(u32x4*)(base + 8 * j) = o;
                *(unsigned*)(base + 128 + 2 * j) = cvt_pk_bf16(x0 * cs.x - y0 * cs.y, x1 * cs.z - y1 * cs.w);
                *(unsigned*)(base + 160 + 2 * j) = cvt_pk_bf16(y0 * cs.x + x0 * cs.y, y1 * cs.z + x1 * cs.w); }
        }
}
struct Args { const float* in[24]; float* out; unsigned char* ws; int step_lo, step_hi, li, pad; };
__global__ void __launch_bounds__(NWAVES * 64, 2) fwd(Args args) {
    extern __shared__ __attribute__((aligned(16))) unsigned char lds_raw[];
    LAS unsigned char* lds = (LAS unsigned char*)lds_raw;
    const int G = gridDim.x, bx = blockIdx.x, vcu = (G % 8 == 0) ? (bx % 8) * (G / 8) + bx / 8 : bx;
    const int NGW = G * NWAVES, NTH = NGW * 64;
    { const int tid = threadIdx.x; if (tid < 64) ((LAS unsigned*)(lds + LDSCTL_OFF))[tid] = 0u; }
    __syncthreads();
    const int lo = args.step_lo, hi = args.step_hi;
    XcdBarrier bar; bar.bar = (unsigned*)(args.ws + WS_CTL) + args.li * XCD_BAR_WORDS; bar.x = 0; bar.st = (volatile LAS unsigned*)(lds + LDSCTL_OFF) + 8;
    if (hi - lo > 1) bar = xcd_barrier_post((unsigned*)(args.ws + WS_CTL) + args.li * XCD_BAR_WORDS, (volatile LAS unsigned*)(lds + LDSCTL_OFF) + 8);
#ifndef PH_MASK
#define PH_MASK 0x3ff
#endif
#define PH(k) (((PH_MASK) >> (k)) & 1)
#define PHASE_IDS() int tid_ = threadIdx.x; asm volatile("" : "+v"(tid_)); const int tid = tid_, lane = tid & 63, wave = __builtin_amdgcn_readfirstlane(tid >> 6), gw = vcu * NWAVES + wave, gt = gw * 64 + lane; (void)gt; (void)gw; (void)lane
#define PHASE_PTRS() PHASE_IDS(); unsigned char* ws = args.ws; asm volatile("" : "+s"(ws)); const float* const* tab = (const float* const*)(ws + WS_PTRS); \
    bf16_t* WIN_T = (bf16_t*)(ws + WS_WIN_T); bf16_t* WQ_T = (bf16_t*)(ws + WS_WQ_T); bf16_t* WKV_T = (bf16_t*)(ws + WS_WKV_T); \
    bf16_t* WBR_T = (bf16_t*)(ws + WS_WBR_T); bf16_t* WOUT_T = (bf16_t*)(ws + WS_WOUT_T); \
    bf16_t* Hb = (bf16_t*)(ws + WS_H); bf16_t* CQKV = (bf16_t*)(ws + WS_CQKV); bf16_t* QM = (bf16_t*)(ws + WS_QM); bf16_t* KF = (bf16_t*)(ws + WS_KF); bf16_t* VM = (bf16_t*)(ws + WS_VM); \
    bf16_t* AXb = (bf16_t*)(ws + WS_AX); bf16_t* WINb = (bf16_t*)(ws + WS_WINB); bf16_t* Gb = (bf16_t*)(ws + WS_G); bf16_t* MG = (bf16_t*)(ws + WS_MG); \
    float* Yf = (float*)(ws + WS_Y); const float* mod_l = (const float*)(ws + WS_MOD) + (size_t)l * 16 * 6144; const f32x2* rope = (const f32x2*)(ws + WS_ROPE); const float* tb = (const float*)(ws + WS_TB); \
    (void)tab; (void)WIN_T; (void)WQ_T; (void)WKV_T; (void)WBR_T; (void)WOUT_T; (void)Hb; (void)CQKV; (void)QM; (void)KF; (void)VM; (void)AXb; (void)WINb; (void)Gb; (void)MG; (void)Yf; (void)mod_l; (void)rope; (void)tb
#define IN(s) (lo <= (s) && (s) < hi)
#define SEAM(s) do { if (IN(s) && IN((s) + 1)) xcd_barrier(bar); } while (0)

    if (PH(0) && IN(0)) { PHASE_IDS(); if (bx == 0 && tid == 0) { const float** tw = (const float**)(args.ws + WS_PTRS);
#pragma unroll
            for (int i = 0; i < 24; ++i) tw[i] = args.in[i];
            tw[24] = (const float*)args.out; }
        step_prologue(args.in, args.ws, lds, tid, lane, wave, vcu, G); }
    SEAM(0);
    if (PH(1) && IN(1)) { PHASE_IDS(); step_modreduce(args.in[6], args.ws, gt, NTH); }
    SEAM(1);

    int it_lo = (lo - NSTEP_PRO) / NSTEP_IT; if (lo < NSTEP_PRO) it_lo = 0;
    int it_hi = (hi - NSTEP_PRO + NSTEP_IT - 1) / NSTEP_IT; if (hi <= NSTEP_PRO) it_hi = 0; if (it_hi > DEPTH * NPASS) it_hi = DEPTH * NPASS;
    for (int it = it_lo; it < it_hi; ++it) {
        const int l = it / NPASS, p = it % NPASS, s0 = NSTEP_PRO + it * NSTEP_IT;
        const int S = p < 2 ? 4096 : 2048, bbase = p < 2 ? p * 4 : 8;
        const size_t row0 = (size_t)p * TP;

        if (PH(2) && IN(s0 + 0)) { PHASE_PTRS(); const float* xin = (l == 0) ? (p < 2 ? tab[0] + row0 * DM : tab[1]) : (const float*)tab[24] + row0 * DM; float* xout = (float*)tab[24] + row0 * DM; (void)xout; step_norm(xin, Hb, tab[4] + (size_t)l * DM, mod_l, bbase, S, gw, NGW, lane); }
        SEAM(s0 + 0);
        if (PH(3) && IN(s0 + 1)) { PHASE_PTRS();
            pg8::Gemm g{Hb, WIN_T + (size_t)l * NINP * DM, TP, NINP, DM, DM, DM}; pg8::StaticOrder So; So.init(TP, NINP, G, bx);
            EpiInProj E{CQKV, Gb, AXb, WINb, MG};
            pg8::gemm_phase<EpiInProj, pg8::StaticOrder, true, true>(lds + RING_OFF, g, So, E);
        }
        SEAM(s0 + 1);
        if (PH(4) && IN(s0 + 2)) { PHASE_PTRS(); step_prep1(CQKV, AXb, WINb, tab[8] + (size_t)l * 512, tab[10] + (size_t)l * 256, tab[14] + (size_t)l * 128, tab[15] + (size_t)l * 128,
                                   tab[16] + (size_t)l * 128, tab[17] + (size_t)l * 128, rope, S, gw, NGW, lane); }
        SEAM(s0 + 2);
        if (PH(5) && IN(s0 + 3)) { PHASE_PTRS();
            { pg8::Gemm g{CQKV, WQ_T + (size_t)l * 1536 * 512, TP, 1536, 512, 1024, 512}; pg8::StaticOrder So; So.init(TP, 1536, G, bx);
              EpiPlain E{QM, 1536};
              pg8::gemm_phase<EpiPlain, pg8::StaticOrder, true, true>(lds + RING_OFF, g, So, E); }
            { pg8::Gemm g{CQKV + 512, WKV_T + (size_t)l * 2048 * 256, TP, 2048, 256, 1024, 256}; pg8::StaticOrder So; So.init(TP, 2048, G, G - 1 - bx);
              EpiKV E{KF, VM};
              pg8::gemm_phase<EpiKV, pg8::StaticOrder, true, true>(lds + RING_OFF, g, So, E); }
        }
        SEAM(s0 + 3);
        if (PH(6) && IN(s0 + 4)) { PHASE_PTRS(); step_prep2(QM, KF, CQKV, tab[12] + (size_t)l * 192, tab[13] + (size_t)l * 192, rope, S, gw, NGW, lane); }
        SEAM(s0 + 4);
        if (PH(7) && IN(s0 + 5)) { PHASE_PTRS();
            const int nqb = S / 256, nunits = (TP / 256) * 8; char* al = (char*)lds_raw + RING_OFF;
            for (int u = vcu; u < nunits; u += G) { const int qb = u % nqb, h = (u / nqb) % 8, b = u / (nqb * 8); const size_t t0 = (size_t)b * S, tq = t0 + (size_t)qb * 256;
                att::attn_unit<192, 1, 1536, 1536, 1024, 3072, false>(QM + tq * 1536 + h * 192, KF + t0 * 1536 + h * 192, VM + t0 * 1024 + h * 128, Gb + tq * 3072 + h * 128,
                                                                     S / 64, -1e30f, 0.f, tb, 0, al); }
            for (int u = vcu; u < nunits; u += G) { const int qb = u % nqb, h = (u / nqb) % 8, b = u / (nqb * 8); const size_t t0 = (size_t)b * S, tq = t0 + (size_t)qb * 256;
                att::attn_unit<128, 2, 1536, 1536, 1536, 3072, false>(AXb + tq * 1536 + h * 128, AXb + t0 * 1536 + 1024 + (h >> 2) * 128, AXb + t0 * 1536 + 1280 + (h >> 2) * 128,
                                                                     Gb + tq * 3072 + 1024 + h * 128, S / 64, -1e30f, 0.f, tb, 0, al); }
            const float* sink = tab[18] + l * 8;
            for (int u = vcu; u < nunits; u += G) { const int qb = u % nqb, h = (u / nqb) % 8, b = u / (nqb * 8); const size_t t0 = (size_t)b * S, tq = t0 + (size_t)qb * 256;
                const int q0 = qb * 256, ks = q0 >= 128 ? q0 - 128 : 0, ke = q0 + 384 <= S ? q0 + 384 : S; const size_t tk = t0 + ks;
                att::attn_unit<128, 1, 1536, 1536, 1536, 3072, true>(WINb + tq * 1536 + h * 128, WINb + tk * 1536 + 1024 + (h >> 2) * 128, WINb + tk * 1536 + 1280 + (h >> 2) * 128,
                                                                    Gb + tq * 3072 + 2048 + h * 128, (ke - ks) / 64, sink[h] * 1.4426950408889634f, 1.f, tb + h * 768, ks - q0 + 383, al); }
            __syncthreads();
        }
        SEAM(s0 + 5);
        if (PH(8) && IN(s0 + 6)) { PHASE_PTRS();
            pg8::StaticOrder So; So.init(TP, DM, G, bx);
            const bf16_t* wb = WBR_T + (size_t)l * DM * 3072;
            { pg8::Gemm g{Gb, wb, TP, DM, 1024, 3072, 3072}; EpiBranch<0> E{MG, Yf, Hb}; pg8::gemm_phase<EpiBranch<0>, pg8::StaticOrder, true, true>(lds + RING_OFF, g, So, E); }
            { pg8::Gemm g{Gb + 1024, wb + 1024, TP, DM, 1024, 3072, 3072}; EpiBranch<1> E{MG, Yf, Hb}; pg8::gemm_phase<EpiBranch<1>, pg8::StaticOrder, true, true>(lds + RING_OFF, g, So, E); }
            { pg8::Gemm g{Gb + 2048, wb + 2048, TP, DM, 1024, 3072, 3072}; EpiBranch<2> E{MG, Yf, Hb}; pg8::gemm_phase<EpiBranch<2>, pg8::StaticOrder, true, true>(lds + RING_OFF, g, So, E); }
        }
        SEAM(s0 + 6);
        if (PH(9) && IN(s0 + 7)) { PHASE_PTRS(); const float* xin = (l == 0) ? (p < 2 ? tab[0] + row0 * DM : tab[1]) : (const float*)tab[24] + row0 * DM; float* xout = (float*)tab[24] + row0 * DM; (void)xout;
            pg8::Gemm g{Hb, WOUT_T + (size_t)l * DM * DM, TP, DM, DM, DM, DM}; pg8::StaticOrder So; So.init(TP, DM, G, bx);
            EpiOut E{xin, xout, mod_l + 4096, bbase, S};
            pg8::gemm_phase<EpiOut, pg8::StaticOrder, true, true>(lds + RING_OFF, g, So, E);
        }
        SEAM(s0 + 7);
    }
#undef IN
#undef SEAM
}

extern "C" void kernel_launch(void* const* d_in, const int* in_sizes, int n_in, void* d_out, int out_size, void* d_ws, size_t ws_size, hipStream_t stream) {
    static int grid = 0;
    if (grid == 0) {
        if (n_in != 24 || in_sizes[0] != T_PROMPT * DM || in_sizes[1] != T_SAMPLE * DM || out_size != (T_PROMPT + T_SAMPLE) * DM || ws_size < WS_END) {
            fprintf(stderr, "kernel_launch: shape mismatch (n_in %d, in0 %d, in1 %d, out %d, ws %zu, need ws >= %zu); nothing launched\n", n_in, n_in > 0 ? in_sizes[0] : -1, n_in > 1 ? in_sizes[1] : -1, out_size, ws_size, (size_t)WS_END);
            grid = -1; return; }
        int dev = 0, cus = 0, per_cu = 0;
        if (hipGetDevice(&dev) != hipSuccess || hipDeviceGetAttribute(&cus, hipDeviceAttributeMultiprocessorCount, dev) != hipSuccess) { fprintf(stderr, "kernel_launch: device query failed\n"); grid = -1; return; }
        if (hipFuncSetAttribute((const void*)fwd, hipFuncAttributeMaxDynamicSharedMemorySize, LDS_BYTES) != hipSuccess) { fprintf(stderr, "kernel_launch: hipFuncSetAttribute failed\n"); grid = -1; return; }
        if (hipOccupancyMaxActiveBlocksPerMultiprocessor(&per_cu, (const void*)fwd, NWAVES * 64, LDS_BYTES) != hipSuccess || per_cu < 1)
            fprintf(stderr, "kernel_launch: note: occupancy query reports %d workgroups per CU\n", per_cu);
        (void)hipGetLastError();
        grid = cus;
    }
    if (grid < 0) return;
    if (hipMemsetAsync((char*)d_ws + WS_CTL, 0, CTL_ZERO_BYTES, stream) != hipSuccess) { fprintf(stderr, "kernel_launch: hipMemsetAsync failed\n"); return; }
    Args a{};
    for (int i = 0; i < 24; ++i) a.in[i] = (const float*)d_in[i];
    a.out = (float*)d_out; a.ws = (unsigned char*)d_ws; a.li = 0; a.pad = 0;
#if MK_ONE_LAUNCH
    a.step_lo = 0; a.step_hi = NSTEPS;
    hipLaunchKernelGGL(fwd, dim3(grid), dim3(NWAVES * 64), LDS_BYTES, stream, a);
#else
    for (int s = 0; s < NSTEPS; ++s) { a.step_lo = s; a.step_hi = s + 1;
        hipLaunchKernelGGL(fwd, dim3(grid), dim3(NWAVES * 64), LDS_BYTES, stream, a); }
#endif
    const hipError_t le = hipPeekAtLastError();
    if (le != hipSuccess) fprintf(stderr, "kernel_launch: launch failed: %s\n", hipGetErrorName(le));
}
```

```cpp
#include <hip/hip_runtime.h>
#include <cstdio>
#include <cstdint>

#ifndef MK_ONE_LAUNCH
#define MK_ONE_LAUNCH 1
#endif

#define LAS __attribute__((address_space(3)))
typedef unsigned short bf16_t;
typedef short bf16x8 __attribute__((ext_vector_type(8)));
typedef short s16x4 __attribute__((ext_vector_type(4)));
typedef float f32x2 __attribute__((ext_vector_type(2)));
typedef float f32x4 __attribute__((ext_vector_type(4)));
typedef float f32x16 __attribute__((ext_vector_type(16)));
typedef unsigned u32x2 __attribute__((ext_vector_type(2)));
typedef unsigned u32x4 __attribute__((ext_vector_type(4)));

__device__ __forceinline__ unsigned cvt_pk_bf16(float lo, float hi) { unsigned r; asm volatile("v_cvt_pk_bf16_f32 %0, %1, %2" : "=v"(r) : "v"(lo), "v"(hi)); return r; }
__device__ __forceinline__ float bf_lo(unsigned w) { return __builtin_bit_cast(float, w << 16); }
__device__ __forceinline__ float bf_hi(unsigned w) { return __builtin_bit_cast(float, w & 0xffff0000u); }
__device__ __forceinline__ float bf2f(bf16_t x) { return __builtin_bit_cast(float, (unsigned)x << 16); }
__device__ __forceinline__ bf16_t f2bf(float f) { return (bf16_t)(cvt_pk_bf16(f, 0.f) & 0xffffu); }
__device__ __forceinline__ float sigmoid_f(float v) { return __builtin_amdgcn_rcpf(1.0f + __builtin_amdgcn_exp2f(-1.4426950408889634f * v)); }
__device__ __forceinline__ float silu_f(float v) { return v * sigmoid_f(v); }

namespace pg8 {
#define PG8_LAS __attribute__((address_space(3)))
constexpr int BM = 256, BK = 64, HALF = 128, HTB = HALF * BK * 2  , STAGE_BYTES = 8 * HTB, NXCD = 8, WGM = 8;
__host__ __device__ __forceinline__ int lds_byte(int r, int c) { const int st = (r >> 4) * 2 + (c >> 5), rr = r & 15, cc = c & 31, ob = rr * 64 + cc * 2; return st * 1024 + (ob ^ (((ob >> 9) & 1) << 5)); }
__host__ __device__ __forceinline__ void stage_rc(int b, int& R, int& C) { const int st = b / 1024, sb = b % 1024, swz = sb ^ (((sb >> 9) & 1) << 5); R = (st >> 1) * 16 + swz / 64; C = (st & 1) * 32 + (swz % 64) / 2; }
__host__ __device__ __forceinline__ int perm32(int rho) { const int n = rho >> 4, i = rho & 15; return 8 * (i >> 2) + 4 * n + (i & 3); }

struct Unit { int pm, pn; };
struct Gemm { const bf16_t* A; const bf16_t* Bt; int M, N, K, lda, ldb; };

struct StaticOrder {
    int nM, nN, nwg, G, c;
    __host__ __device__ void init(int M, int N, int G_, int c_) { nM = M / BM; nN = N / BM; nwg = nM * nN; G = G_; c = c_; }
    __host__ __device__ bool next(int i, Unit& u) const {
        const long L = (long)i * G + c; if (L >= nwg) return false;
        int wgid = (int)L; { const int q = nwg / NXCD, r = nwg % NXCD, xcd = wgid % NXCD, off = wgid / NXCD; wgid = (xcd < r ? xcd * (q + 1) : r * (q + 1) + (xcd - r) * q) + off; }
        const int nig = WGM * nN, gid = wgid / nig, fm = gid * WGM, gsz = (nM - fm) < WGM ? (nM - fm) : WGM;
        u.pm = fm + ((wgid % nig) % gsz); u.pn = (wgid % nig) / gsz; return true;
    }
};
template <class Epi, class Sched, bool ALIGN_EPI = false, bool SP2 = false>
__device__ __forceinline__ void gemm_phase(PG8_LAS unsigned char* lds, const Gemm g, const Sched& S, const Epi& E) {
    int tid_ = threadIdx.x; asm volatile("" : "+v"(tid_));
    const int tid = tid_, wid = __builtin_amdgcn_readfirstlane(tid >> 6), lane = tid & 63, wr = wid >> 2, wc = wid & 3, fr = lane & 15, fq = lane >> 4;
    int K_ = g.K; asm volatile("" : "+s"(K_));
    const int K = K_, nt = K / BK;
    unsigned voffA[2], voffB[2];
#pragma unroll
    for (int i = 0; i < 2; ++i) { int R, C; stage_rc(tid * 16 + i * 8192, R, C); const int Rb = Epi::PERM ? ((R & ~31) + perm32(R & 31)) : R;
        voffA[i] = (unsigned)(R * g.lda + C) * 2u; voffB[i] = (unsigned)(Rb * g.ldb + C) * 2u; }
    const size_t kstep = (size_t)(BK * 2);
    const size_t hstepA = (size_t)HALF * g.lda * 2, hstepB = (size_t)HALF * g.ldb * 2;
    const size_t tstepA = 2 * hstepA, tstepB = 2 * hstepB;
    const unsigned ldsw = (unsigned)wid * 1024u;
    const int aoff = lds_byte(wr * 64 + fr, fq * 8), boff = lds_byte(wc * 32 + fr, fq * 8);
#define PG8_SA(b, h) (((b) * 2 + (h)) * HTB)
#define PG8_SB(b, h) ((4 + (b) * 2 + (h)) * HTB)
#define PG8_STAGE(bufoff, gbase, voff) do { _Pragma("unroll") for (int _i = 0; _i < 2; ++_i) \
        __builtin_amdgcn_global_load_lds((const unsigned*)((const char*)(gbase) + (voff)[_i]), (PG8_LAS unsigned*)(lds + (bufoff) + ldsw + _i * 8192), 16, 0, 0); } while (0)
#define PG8_LDA(dst, b, h) do { _Pragma("unroll") for (int m = 0; m < 4; ++m) _Pragma("unroll") for (int k = 0; k < 2; ++k) dst[m][k] = *(const PG8_LAS bf16x8*)(lds + PG8_SA(b, h) + aoff + m * 2048 + k * 1024); } while (0)
#define PG8_LDB(dst, b, h) do { _Pragma("unroll") for (int n = 0; n < 2; ++n) _Pragma("unroll") for (int k = 0; k < 2; ++k) dst[n][k] = *(const PG8_LAS bf16x8*)(lds + PG8_SB(b, h) + boff + n * 2048 + k * 1024); } while (0)
#define PG8_MMA(ai, bj, At, Bt) do { __builtin_amdgcn_s_setprio(1); _Pragma("unroll") for (int m = 0; m < 4; ++m) _Pragma("unroll") for (int n = 0; n < 2; ++n) _Pragma("unroll") for (int k = 0; k < 2; ++k) \
        acc[ai][bj][m][n] = __builtin_amdgcn_mfma_f32_16x16x32_bf16(Bt[n][k], At[m][k], acc[ai][bj][m][n], 0, 0, 0); __builtin_amdgcn_s_setprio(0); } while (0)
#define PG8_WAIT_V(n) asm volatile("s_waitcnt vmcnt(" #n ")" ::: "memory")
#define PG8_WAIT_L(n) asm volatile("s_waitcnt lgkmcnt(" #n ")" ::: "memory")
#define PG8_BAR __builtin_amdgcn_s_barrier()
#define PG8_SCHED __builtin_amdgcn_sched_barrier(0)
    Unit cur, nxt; int ui = 0;
    if (!S.next(0, cur)) return;
    f32x4 acc[2][2][4][2];
#pragma unroll
    for (int a = 0; a < 2; ++a)
#pragma unroll
        for (int b = 0; b < 2; ++b)
#pragma unroll
            for (int m = 0; m < 4; ++m)
#pragma unroll
                for (int n = 0; n < 2; ++n) acc[a][b][m][n] = (f32x4){0.f, 0.f, 0.f, 0.f};
    bf16x8 At[4][2], B0[2][2], B1[2][2];
    const char* cA = (const char*)g.A + (size_t)cur.pm * tstepA; const char* cB = (const char*)g.Bt + (size_t)cur.pn * tstepB;

    if constexpr (SP2) {
        PG8_STAGE(PG8_SB(0, 0), cB, voffB); PG8_STAGE(PG8_SB(0, 1), cB + hstepB, voffB); PG8_STAGE(PG8_SA(0, 0), cA, voffA); PG8_STAGE(PG8_SA(0, 1), cA + hstepA, voffA);
        if (wr == 1) PG8_BAR;
        PG8_WAIT_V(2); PG8_BAR;
        PG8_STAGE(PG8_SB(1, 0), cB + kstep, voffB); PG8_STAGE(PG8_SA(1, 0), cA + kstep, voffA); PG8_STAGE(PG8_SB(1, 1), cB + hstepB + kstep, voffB);
        PG8_WAIT_V(6); PG8_BAR;
    } else {
        PG8_STAGE(PG8_SB(0, 0), cB, voffB); PG8_STAGE(PG8_SA(0, 0), cA, voffA); PG8_STAGE(PG8_SB(0, 1), cB + hstepB, voffB); PG8_STAGE(PG8_SA(0, 1), cA + hstepA, voffA);
        if (wr == 1) PG8_BAR;
        PG8_WAIT_V(4); PG8_BAR;
        PG8_STAGE(PG8_SB(1, 0), cB + kstep, voffB); PG8_STAGE(PG8_SA(1, 0), cA + kstep, voffA); PG8_STAGE(PG8_SB(1, 1), cB + hstepB + kstep, voffB);
        PG8_WAIT_V(6); PG8_BAR;
    }
    for (;;) {
        const bool has_next = S.next(ui + 1, nxt);
        const char* nA = has_next ? (const char*)g.A + (size_t)nxt.pm * tstepA : cA; const char* nB = has_next ? (const char*)g.Bt + (size_t)nxt.pn * tstepB : cB;
        for (int t = 0; t < nt; t += 2) {
            const bool last = (t == nt - 2);
            const char* a1 = cA + (size_t)(t + 1) * kstep;
            const char* a2 = last ? nA : cA + (size_t)(t + 2) * kstep; const char* b2 = last ? nB : cB + (size_t)(t + 2) * kstep;
            const char* a3 = a2 + kstep; const char* b3 = b2 + kstep;

            if constexpr (SP2) {
            PG8_LDB(B0, 0, 0); PG8_LDB(B1, 0, 1); PG8_SCHED; PG8_LDA(At, 0, 0); PG8_STAGE(PG8_SA(1, 1), a1 + hstepA, voffA);
            PG8_WAIT_V(8); PG8_WAIT_L(0); PG8_BAR; PG8_MMA(0, 0, At, B0); PG8_MMA(0, 1, At, B1); PG8_BAR; PG8_SCHED;
            PG8_LDA(At, 0, 1); PG8_STAGE(PG8_SB(0, 0), b2, voffB); PG8_STAGE(PG8_SB(0, 1), b2 + hstepB, voffB); PG8_STAGE(PG8_SA(0, 0), a2, voffA);
            PG8_WAIT_V(8); PG8_WAIT_L(0); PG8_BAR; PG8_MMA(1, 0, At, B0); PG8_MMA(1, 1, At, B1); PG8_BAR; PG8_SCHED;
            PG8_LDB(B0, 1, 0); PG8_LDB(B1, 1, 1); PG8_SCHED; PG8_LDA(At, 1, 0); PG8_STAGE(PG8_SA(0, 1), a2 + hstepA, voffA);
            PG8_WAIT_V(8); PG8_WAIT_L(0); PG8_BAR; PG8_MMA(0, 0, At, B0); PG8_MMA(0, 1, At, B1); PG8_BAR; PG8_SCHED;
            PG8_LDA(At, 1, 1); PG8_STAGE(PG8_SB(1, 0), b3, voffB); PG8_STAGE(PG8_SB(1, 1), b3 + hstepB, voffB); PG8_STAGE(PG8_SA(1, 0), a3, voffA);
            PG8_WAIT_V(8); PG8_WAIT_L(0); PG8_BAR; PG8_MMA(1, 0, At, B0); PG8_MMA(1, 1, At, B1); PG8_BAR; PG8_SCHED;
            } else {
            PG8_LDB(B0, 0, 0); PG8_SCHED; PG8_LDA(At, 0, 0); PG8_STAGE(PG8_SA(1, 1), a1 + hstepA, voffA);
            PG8_WAIT_L(8); PG8_BAR; PG8_WAIT_L(0); PG8_MMA(0, 0, At, B0); PG8_BAR; PG8_SCHED;
            PG8_LDB(B1, 0, 1); PG8_STAGE(PG8_SB(0, 0), b2, voffB);
            PG8_BAR; PG8_WAIT_L(0); PG8_MMA(0, 1, At, B1); PG8_BAR;
            PG8_LDA(At, 0, 1); PG8_STAGE(PG8_SA(0, 0), a2, voffA);
            PG8_BAR; PG8_WAIT_L(0); PG8_MMA(1, 0, At, B0); PG8_BAR; PG8_SCHED;
            PG8_STAGE(PG8_SB(0, 1), b2 + hstepB, voffB);
            PG8_WAIT_V(6); PG8_BAR; PG8_MMA(1, 1, At, B1); PG8_BAR;
            PG8_LDB(B0, 1, 0); PG8_SCHED; PG8_LDA(At, 1, 0); PG8_STAGE(PG8_SA(0, 1), a2 + hstepA, voffA);
            PG8_WAIT_L(8); PG8_BAR; PG8_WAIT_L(0); PG8_MMA(0, 0, At, B0); PG8_BAR; PG8_SCHED;
            PG8_LDB(B1, 1, 1); PG8_STAGE(PG8_SB(1, 0), b3, voffB);
            PG8_BAR; PG8_WAIT_L(0); PG8_MMA(0, 1, At, B1); PG8_BAR;
            PG8_LDA(At, 1, 1); PG8_STAGE(PG8_SA(1, 0), a3, voffA);
            PG8_BAR; PG8_WAIT_L(0); PG8_MMA(1, 0, At, B0); PG8_BAR; PG8_SCHED;
            PG8_STAGE(PG8_SB(1, 1), b3 + hstepB, voffB);
            PG8_WAIT_V(6); PG8_BAR; PG8_MMA(1, 1, At, B1); PG8_BAR;
            }
        }
        if constexpr (ALIGN_EPI) { if (wr == 0) PG8_BAR; }
        E(acc, cur, wr, wc, fr, fq);
        if (!has_next) break;
#pragma unroll
        for (int a = 0; a < 2; ++a)
#pragma unroll
            for (int b = 0; b < 2; ++b)
#pragma unroll
                for (int m = 0; m < 4; ++m)
#pragma unroll
                    for (int n = 0; n < 2; ++n) acc[a][b][m][n] = (f32x4){0.f, 0.f, 0.f, 0.f};
        cur = nxt; cA = nA; cB = nB; ++ui;
        if constexpr (ALIGN_EPI) { if (wr == 1) PG8_BAR; }
    }
    PG8_WAIT_V(0);
    if constexpr (!ALIGN_EPI) { if (wr == 0) PG8_BAR; }
    PG8_BAR;
#undef PG8_SA
#undef PG8_SB
#undef PG8_STAGE
#undef PG8_LDA
#undef PG8_LDB
#undef PG8_MMA
#undef PG8_WAIT_V
#undef PG8_WAIT_L
#undef PG8_BAR
#undef PG8_SCHED
}
}

template <int ACT> __device__ __forceinline__ u32x4 act_pack8(f32x4 v0, f32x4 v1) {
    if (ACT == 1) {
#pragma unroll
        for (int j = 0; j < 4; ++j) { v0[j] = silu_f(v0[j]); v1[j] = silu_f(v1[j]); } }
    if (ACT == 2) {
#pragma unroll
        for (int j = 0; j < 4; ++j) { v0[j] = sigmoid_f(v0[j]); v1[j] = sigmoid_f(v1[j]); } }
    u32x4 w; w.x = cvt_pk_bf16(v0[0], v0[1]); w.y = cvt_pk_bf16(v0[2], v0[3]); w.z = cvt_pk_bf16(v1[0], v1[1]); w.w = cvt_pk_bf16(v1[2], v1[3]); return w;
}
template <int ACT> __device__ __forceinline__ void store_tile_bf16(const f32x4 (&acc)[2][2][4][2], bf16_t* p00  , bf16_t* p01  , int ldc) {
#pragma unroll
    for (int ai = 0; ai < 2; ++ai)
#pragma unroll
        for (int m = 0; m < 4; ++m) { const size_t ro = (size_t)(ai * 128 + m * 16) * ldc;
            *(u32x4*)(p00 + ro) = act_pack8<ACT>(acc[ai][0][m][0], acc[ai][0][m][1]);
            *(u32x4*)(p01 + ro) = act_pack8<ACT>(acc[ai][1][m][0], acc[ai][1][m][1]); }
}
struct EpiInProj {
    static constexpr bool PERM = true;
    bf16_t *CQKV, *G, *AXb, *WINb, *MG;
    __device__ __forceinline__ void operator()(const f32x4 (&acc)[2][2][4][2], const pg8::Unit& u, int wr, int wc, int fr, int fq) const {
        const int pn = u.pn; bf16_t* base; int ldc, colt, act;
        if (pn < 4)       { base = CQKV; ldc = 1024; colt = pn * 256;               act = 0; }
        else if (pn < 8)  { base = G;    ldc = 3072; colt = (pn - 4) * 256;         act = 1; }
        else if (pn < 14) { base = AXb;  ldc = 1536; colt = (pn - 8) * 256;         act = 0; }
        else if (pn < 18) { base = G;    ldc = 3072; colt = 1024 + (pn - 14) * 256; act = 1; }
        else if (pn < 24) { base = WINb; ldc = 1536; colt = (pn - 18) * 256;        act = 0; }
        else if (pn < 28) { base = G;    ldc = 3072; colt = 2048 + (pn - 24) * 256; act = 1; }
        else              { base = MG;   ldc = 6144; colt = (pn - 28) * 256;        act = 2; }
        bf16_t* p0 = base + (size_t)(u.pm * 256 + wr * 64 + fr) * ldc + colt + wc * 32 + 8 * fq;
        const float ka = (act == 2) ? 0.f : 1.f, kb = (act == 2) ? 1.f : 0.f, kc = (act == 0) ? 0.f : 1.f, kd = (act == 0) ? 1.f : 0.f;
#pragma unroll
        for (int ai = 0; ai < 2; ++ai)
#pragma unroll
            for (int m = 0; m < 4; ++m) { bf16_t* rp = p0 + (size_t)(ai * 128 + m * 16) * ldc;
#pragma unroll
                for (int bj = 0; bj < 2; ++bj) { f32x4 v0 = acc[ai][bj][m][0], v1 = acc[ai][bj][m][1];
#pragma unroll
                    for (int j = 0; j < 4; ++j) { v0[j] = (ka * v0[j] + kb) * (kc * sigmoid_f(v0[j]) + kd); v1[j] = (ka * v1[j] + kb) * (kc * sigmoid_f(v1[j]) + kd); }
                    u32x4 w; w.x = cvt_pk_bf16(v0[0], v0[1]); w.y = cvt_pk_bf16(v0[2], v0[3]); w.z = cvt_pk_bf16(v1[0], v1[1]); w.w = cvt_pk_bf16(v1[2], v1[3]);
                    *(u32x4*)(rp + bj * 128) = w; } }
    }
};
struct EpiPlain {
    static constexpr bool PERM = true;
    bf16_t* O; int ldc;
    __device__ __forceinline__ void operator()(const f32x4 (&acc)[2][2][4][2], const pg8::Unit& u, int wr, int wc, int fr, int fq) const {
        bf16_t* p0 = O + (size_t)(u.pm * 256 + wr * 64 + fr) * ldc + u.pn * 256 + wc * 32 + 8 * fq;
        store_tile_bf16<0>(acc, p0, p0 + 128, ldc);
    }
};
struct EpiKV {
    static constexpr bool PERM = true;
    bf16_t *KF, *VM;
    __device__ __forceinline__ void operator()(const f32x4 (&acc)[2][2][4][2], const pg8::Unit& u, int wr, int wc, int fr, int fq) const {
        const int row = u.pm * 256 + wr * 64 + fr, cin = wc * 32 + 8 * fq;
        const bool isk = u.pn < 4; const int ldc = isk ? 1536 : 1024;
        bf16_t* p0 = (isk ? KF + (u.pn * 2) * 192 : VM + (u.pn - 4) * 256) + (size_t)row * ldc + cin;
        store_tile_bf16<0>(acc, p0, p0 + (isk ? 192 : 128), ldc);
    }
};
template <int B> struct EpiBranch {
    static constexpr bool PERM = true;
    const bf16_t* MG; float* Y; bf16_t* YB;
    __device__ __forceinline__ void operator()(const f32x4 (&acc)[2][2][4][2], const pg8::Unit& u, int wr, int wc, int fr, int fq) const {
        const int row0 = u.pm * 256 + wr * 64 + fr, col0 = u.pn * 256 + wc * 32 + 8 * fq;
#pragma unroll
        for (int ai = 0; ai < 2; ++ai)
#pragma unroll
            for (int m = 0; m < 4; ++m)
#pragma unroll
                for (int bj = 0; bj < 2; ++bj) {
                    const size_t r = (size_t)(row0 + ai * 128 + m * 16); const int c = col0 + bj * 128;
                    const u32x4 gw = *(const u32x4*)(MG + r * 6144 + B * 2048 + c);
                    f32x4 v0 = acc[ai][bj][m][0], v1 = acc[ai][bj][m][1];
                    v0[0] *= bf_lo(gw.x); v0[1] *= bf_hi(gw.x); v0[2] *= bf_lo(gw.y); v0[3] *= bf_hi(gw.y);
                    v1[0] *= bf_lo(gw.z); v1[1] *= bf_hi(gw.z); v1[2] *= bf_lo(gw.w); v1[3] *= bf_hi(gw.w);
                    float* yp = Y + r * 2048 + c;
                    if (B > 0) { v0 += *(const f32x4*)yp; v1 += *(const f32x4*)(yp + 4); }
                    if (B < 2) { *(f32x4*)yp = v0; *(f32x4*)(yp + 4) = v1; }
                    else { u32x4 w; w.x = cvt_pk_bf16(v0[0], v0[1]); w.y = cvt_pk_bf16(v0[2], v0[3]); w.z = cvt_pk_bf16(v1[0], v1[1]); w.w = cvt_pk_bf16(v1[2], v1[3]); *(u32x4*)(YB + r * 2048 + c) = w; }
                }
    }
};
struct EpiOut {
    static constexpr bool PERM = false;
    const float* X; float* O; const float* gate0  ; int bbase, S;
    __device__ __forceinline__ void operator()(const f32x4 (&acc)[2][2][4][2], const pg8::Unit& u, int wr, int wc, int fr, int fq) const {
        const int row0 = u.pm * 256 + wr * 64 + fr, col0 = u.pn * 256 + wc * 32 + 4 * fq;
        const float* gp = gate0 + (size_t)(bbase + (u.pm * 256) / S) * 6144 + col0;
        f32x4 gv[2][2];
#pragma unroll
        for (int bj = 0; bj < 2; ++bj)
#pragma unroll
            for (int n = 0; n < 2; ++n) gv[bj][n] = *(const f32x4*)(gp + bj * 128 + n * 16);
#pragma unroll
        for (int ai = 0; ai < 2; ++ai)
#pragma unroll
            for (int m = 0; m < 4; ++m) { const size_t ro = (size_t)(row0 + ai * 128 + m * 16) * 2048 + col0;
#pragma unroll
                for (int bj = 0; bj < 2; ++bj)
#pragma unroll
                    for (int n = 0; n < 2; ++n) { const size_t o = ro + bj * 128 + n * 16; *(f32x4*)(O + o) = *(const f32x4*)(X + o) + gv[bj][n] * acc[ai][bj][m][n]; } }
    }
};
namespace att {
constexpr int NW = 8, QBLK = 32, KVBLK = 64;
constexpr float THR = 8.f;
constexpr size_t SHM_V = KVBLK * 128 * 2;
#define KSWZ(row, colB) ((row) * 256 + ((colB) ^ (((row) & 7) << 4)))
#define KSWZ192(row, colB) ((row) * 384 + ((colB) ^ (((row) & 7) << 4)))
#define SBAR() __builtin_amdgcn_sched_barrier(0)
__device__ __forceinline__ int crow(int r, int hi) { return (r & 3) + 8 * (r >> 2) + 4 * hi; }
__device__ __forceinline__ unsigned cvtpk(float lo, float hi) { unsigned r; asm volatile("v_cvt_pk_bf16_f32 %0, %1, %2" : "=v"(r) : "v"(lo), "v"(hi)); return r; }
__device__ __forceinline__ bf16x8 ld8(const bf16_t* p) { return *reinterpret_cast<const bf16x8*>(p); }

template <bool WIN> __device__ __forceinline__ void partialSM(f32x16& p0, f32x16& p1, float& m_reg, float& mn, float& alpha, const float C, const float* tl) {
  if constexpr (WIN) {
#pragma unroll
    for (int r = 0; r < 16; ++r) { p0[r] = fmaf(p0[r], C, tl[(r & 3) + 8 * (r >> 2)]); p1[r] = fmaf(p1[r], C, tl[32 + (r & 3) + 8 * (r >> 2)]); }
  }
  float pmax = p0[0];
#pragma unroll
  for (int r = 1; r < 16; ++r) pmax = fmaxf(pmax, p0[r]);
#pragma unroll
  for (int r = 0; r < 16; ++r) pmax = fmaxf(pmax, p1[r]);
  { auto rr = __builtin_amdgcn_permlane32_swap(__float_as_uint(pmax), __float_as_uint(pmax), false, false);
    pmax = fmaxf(__uint_as_float(rr[0]), __uint_as_float(rr[1])); }
  if constexpr (WIN) {
    if (__builtin_expect(__all(pmax - m_reg <= THR * 1.4426950408889634f), 1)) { mn = m_reg; alpha = 1.f; }
    else { mn = fmaxf(m_reg, pmax); alpha = __builtin_amdgcn_exp2f(m_reg - mn); m_reg = mn; }
#pragma unroll
    for (int r = 0; r < 16; ++r) { p0[r] -= mn; p1[r] -= mn; }
  } else {
    if (__builtin_expect(__all((pmax - m_reg) * C <= THR * 1.4426950408889634f), 1)) { mn = m_reg; alpha = 1.f; }
    else { mn = fmaxf(m_reg, pmax); alpha = __builtin_amdgcn_exp2f((m_reg - mn) * C); m_reg = mn; }
    const float mnC = -mn * C;
#pragma unroll
    for (int r = 0; r < 16; ++r) { p0[r] = fmaf(p0[r], C, mnC); p1[r] = fmaf(p1[r], C, mnC); }
  }
#pragma unroll
  for (int r = 0; r < 16; ++r) p0[r] = __builtin_amdgcn_exp2f(p0[r]);
}
__device__ __forceinline__ void finishSM(f32x16& p0, f32x16& p1, float alpha, float& l_reg, bf16x8& pa0, bf16x8& pa1, bf16x8& pa2, bf16x8& pa3) {
#pragma unroll
  for (int r = 0; r < 16; ++r) p1[r] = __builtin_amdgcn_exp2f(p1[r]);
  float ps = 0;
#pragma unroll
  for (int r = 0; r < 16; ++r) ps += p0[r];
#pragma unroll
  for (int r = 0; r < 16; ++r) ps += p1[r];
  { auto rr = __builtin_amdgcn_permlane32_swap(__float_as_uint(ps), __float_as_uint(ps), false, false);
    ps = __uint_as_float(rr[0]) + __uint_as_float(rr[1]); }
  l_reg = l_reg * alpha + ps;
#define PK4(P, BASE, OUT) do { unsigned a0 = cvtpk(P[BASE + 0], P[BASE + 1]), a1 = cvtpk(P[BASE + 2], P[BASE + 3]);   \
    unsigned b0 = cvtpk(P[BASE + 4], P[BASE + 5]), b1 = cvtpk(P[BASE + 6], P[BASE + 7]);                              \
    auto r0 = __builtin_amdgcn_permlane32_swap(a0, b0, false, false); auto r1 = __builtin_amdgcn_permlane32_swap(a1, b1, false, false); \
    u32x4 w = {r0[0], r1[0], r0[1], r1[1]}; OUT = *reinterpret_cast<bf16x8*>(&w); } while (0)
  PK4(p0, 0, pa0); PK4(p0, 8, pa1); PK4(p1, 0, pa2); PK4(p1, 8, pa3);
#undef PK4
}
template <int DK> __device__ __forceinline__ void qkt(f32x16& p0, f32x16& p1, const char* Ks, const bf16x8* qr, int r32, int hi) {
  p0 = f32x16{}; p1 = f32x16{};
#pragma unroll
  for (int d0 = 0; d0 < DK / 16; ++d0) { const int cb = (d0 * 16 + hi * 8) * 2;
    const bf16x8 b0 = *reinterpret_cast<const bf16x8*>(Ks + (DK == 128 ? KSWZ(r32, cb) : KSWZ192(r32, cb)));
    const bf16x8 b1 = *reinterpret_cast<const bf16x8*>(Ks + (DK == 128 ? KSWZ(32 + r32, cb) : KSWZ192(32 + r32, cb)));
    p0 = __builtin_amdgcn_mfma_f32_32x32x16_bf16(b0, qr[d0], p0, 0, 0, 0);
    p1 = __builtin_amdgcn_mfma_f32_32x32x16_bf16(b1, qr[d0], p1, 0, 0, 0); }
}
__device__ __forceinline__ int v_st(int k, int c) { const int kk = (k & ~0xC) | ((k & 4) << 1) | ((k & 8) >> 1); return ((kk >> 3) * 4 + (c >> 5)) * 512 + ((kk & 7) * 32 + (c & 31)) * 2; }
__device__ __forceinline__ int v_rd_base(int lane) { return ((lane & 3) << 3) | (((lane >> 2) & 3) << 6) | (((lane >> 4) & 1) << 5) | (((lane >> 5) & 1) << 8); }
constexpr int v_rd_off(int d0, int ks, int half) { return d0 * 512 + ks * 4096 + half * 2048; }
template <int OFF> __device__ __forceinline__ s16x4 tr_read(int vb) {
  s16x4 r; asm volatile("ds_read_b64_tr_b16 %0, %1 offset:%2" : "=&v"(r) : "v"(vb), "i"(OFF) : "memory"); return r;
}
template <int D0> __device__ __forceinline__ void pv_one(f32x16& od, int vb, bf16x8 pa0, bf16x8 pa1, bf16x8 pa2, bf16x8 pa3) {
  const s16x4 l0 = tr_read<v_rd_off(D0, 0, 0)>(vb), h0 = tr_read<v_rd_off(D0, 0, 1)>(vb), l1 = tr_read<v_rd_off(D0, 1, 0)>(vb), h1 = tr_read<v_rd_off(D0, 1, 1)>(vb);
  const s16x4 l2 = tr_read<v_rd_off(D0, 2, 0)>(vb), h2 = tr_read<v_rd_off(D0, 2, 1)>(vb), l3 = tr_read<v_rd_off(D0, 3, 0)>(vb), h3 = tr_read<v_rd_off(D0, 3, 1)>(vb);
  asm volatile("s_waitcnt lgkmcnt(0)" ::: "memory"); SBAR();
#define PK(L, H) (bf16x8){L[0], L[1], L[2], L[3], H[0], H[1], H[2], H[3]}
  od = __builtin_amdgcn_mfma_f32_32x32x16_bf16(pa0, PK(l0, h0), od, 0, 0, 0);
  od = __builtin_amdgcn_mfma_f32_32x32x16_bf16(pa1, PK(l1, h1), od, 0, 0, 0);
  od = __builtin_amdgcn_mfma_f32_32x32x16_bf16(pa2, PK(l2, h2), od, 0, 0, 0);
  od = __builtin_amdgcn_mfma_f32_32x32x16_bf16(pa3, PK(l3, h3), od, 0, 0, 0);
#undef PK
}
__device__ __forceinline__ void pv_d0(f32x16* o, int vb, bf16x8 pa0, bf16x8 pa1, bf16x8 pa2, bf16x8 pa3) {
  pv_one<0>(o[0], vb, pa0, pa1, pa2, pa3); pv_one<1>(o[1], vb, pa0, pa1, pa2, pa3); pv_one<2>(o[2], vb, pa0, pa1, pa2, pa3); pv_one<3>(o[3], vb, pa0, pa1, pa2, pa3);
}
constexpr size_t lds_bytes(int DK) { return 2 * SHM_V + 2 * (size_t)KVBLK * DK * 2 + NW * 64 * 4 + 768 * 4; }

template <int DK, int SD, int LDQ, int LDK, int LDV, int LDO, bool WIN>
__device__ __forceinline__ void attn_unit(const bf16_t* __restrict__ Qb, const bf16_t* __restrict__ Kh, const bf16_t* __restrict__ Vh, bf16_t* __restrict__ Ob,
                                          const int NT, const float m_init, const float l_init, const float* __restrict__ tbg, const int tb0, char* lds) {
  constexpr int ND = DK / 16;
  constexpr size_t SHM_K = (size_t)KVBLK * DK * 2;
  constexpr float SCALE = (DK == 128) ? 0.088388347648318440f : 0.072168783648703220f;
  constexpr float C = SCALE * 1.4426950408889634f;
  int tid_ = threadIdx.x; asm volatile("" : "+v"(tid_));
  const int tid = tid_, wid = tid >> 6, lane = tid & 63, r32 = lane & 31, hi = lane >> 5;
  char* V_lds = lds; char* K_lds = lds + 2 * SHM_V;
  float* ws = (float*)(lds + 2 * SHM_V + 2 * SHM_K) + wid * 64; float* li_l = ws; float* al_l = ws + 32;
  float* tbl = (float*)(lds + 2 * SHM_V + 2 * SHM_K + NW * 64 * 4);
  __syncthreads();
  if constexpr (WIN) { for (int i = tid; i < 768; i += 512) tbl[i] = tbg[i]; }
  const float* tlw = tbl + (tb0 - wid * 32 - r32 + 4 * hi);
  float m_reg = m_init, l_reg = l_init; f32x16 o[4] = {}; bf16x8 qr[ND];
  const bf16_t* Qw = Qb + (long)(wid * QBLK + r32) * LDQ + hi * 8;
#pragma unroll
  for (int d0 = 0; d0 < ND; ++d0) qr[d0] = ld8(Qw + d0 * 16);
  const int sr = tid >> 4, sc = (tid & 15) * 8, vst0 = v_st(sr, sc), vst1 = v_st(32 + sr, sc);
  const int kr0 = tid >> 3, kc0 = tid & 7;
  const int vb0 = (int)(uintptr_t)V_lds + v_rd_base(lane);
  struct Slot { bf16x8 vs0, vs1, ks0, ks1, ks2; } sr_[SD];
#define SLOAD(i, k0) do { sr_[i].vs0 = ld8(&Vh[(long)((k0) + sr) * LDV + sc]); sr_[i].vs1 = ld8(&Vh[(long)((k0) + 32 + sr) * LDV + sc]); \
    if constexpr (DK == 128) { sr_[i].ks0 = ld8(&Kh[(long)((k0) + sr) * LDK + sc]); sr_[i].ks1 = ld8(&Kh[(long)((k0) + 32 + sr) * LDK + sc]); } \
    else { const bf16_t* kp_ = &Kh[(long)((k0) + kr0) * LDK + kc0 * 8]; sr_[i].ks0 = ld8(kp_); sr_[i].ks1 = ld8(kp_ + 64); sr_[i].ks2 = ld8(kp_ + 128); } } while (0)
#define SWRITE(b, i) do { *(bf16x8*)(V_lds + (b) * SHM_V + vst0) = sr_[i].vs0; *(bf16x8*)(V_lds + (b) * SHM_V + vst1) = sr_[i].vs1; \
    if constexpr (DK == 128) { const int kc = sc * 2; *(bf16x8*)(K_lds + (b) * SHM_K + KSWZ(sr, kc)) = sr_[i].ks0; *(bf16x8*)(K_lds + (b) * SHM_K + KSWZ(32 + sr, kc)) = sr_[i].ks1; } \
    else { char* kw_ = K_lds + (b) * SHM_K + KSWZ192(kr0, kc0 * 16); *(bf16x8*)kw_ = sr_[i].ks0; *(bf16x8*)(kw_ + 128) = sr_[i].ks1; *(bf16x8*)(kw_ + 256) = sr_[i].ks2; } } while (0)
#define SWAIT() do { if constexpr (SD == 2) { if constexpr (DK == 128) asm volatile("s_waitcnt vmcnt(4)" ::: "memory"); else asm volatile("s_waitcnt vmcnt(5)" ::: "memory"); } \
    else asm volatile("s_waitcnt vmcnt(0)" ::: "memory"); } while (0)
#define RESC(a) do { if (__any((a) < 1.f)) { if (hi == 0) al_l[r32] = (a); asm volatile("s_waitcnt lgkmcnt(0)" ::: "memory"); \
    _Pragma("unroll") for (int d = 0; d < 4; ++d) _Pragma("unroll") for (int r = 0; r < 16; ++r) o[d][r] *= al_l[crow(r, hi)]; } } while (0)
  f32x16 pA0, pA1, pB0, pB1; float mnA, mnB, alA, alB; bf16x8 pa0, pa1, pa2, pa3;
  constexpr int SE = 0, SO = SD - 1;
  SLOAD(SE, 0); asm volatile("s_waitcnt vmcnt(0)" ::: "memory"); SWRITE(0, SE); __syncthreads();
  qkt<DK>(pA0, pA1, K_lds, qr, r32, hi); partialSM<WIN>(pA0, pA1, m_reg, mnA, alA, C, tlw);
  SLOAD(SO, KVBLK); if constexpr (SD == 2) { if (2 < NT) SLOAD(SE, 2 * KVBLK); }
  SWAIT(); SWRITE(1, SO); __syncthreads();
  for (int j = 1; j + 1 < NT; j += 2) {
    SBAR(); qkt<DK>(pB0, pB1, K_lds + SHM_K, qr, r32, hi);
    finishSM(pA0, pA1, alA, l_reg, pa0, pa1, pa2, pa3); SBAR();
    SLOAD(SO, (j + SD) * KVBLK); SBAR();
    pv_d0(o, vb0, pa0, pa1, pa2, pa3); partialSM<WIN>(pB0, pB1, m_reg, mnB, alB, C, tlw + 64 * j);
    __syncthreads(); SWAIT(); SWRITE(0, SE);
    RESC(alB); __syncthreads();
    SBAR(); qkt<DK>(pA0, pA1, K_lds, qr, r32, hi);
    finishSM(pB0, pB1, alB, l_reg, pa0, pa1, pa2, pa3); SBAR();
    if (SD == 1 || j + 3 < NT) SLOAD(SE, (j + 1 + SD) * KVBLK); SBAR();
    pv_d0(o, vb0 + (int)SHM_V, pa0, pa1, pa2, pa3); partialSM<WIN>(pA0, pA1, m_reg, mnA, alA, C, tlw + 64 * (j + 1));
    __syncthreads(); SWAIT(); SWRITE(1, SO);
    RESC(alA); __syncthreads();
  }
  SBAR(); qkt<DK>(pB0, pB1, K_lds + SHM_K, qr, r32, hi);
  finishSM(pA0, pA1, alA, l_reg, pa0, pa1, pa2, pa3); SBAR();
  pv_d0(o, vb0, pa0, pa1, pa2, pa3); partialSM<WIN>(pB0, pB1, m_reg, mnB, alB, C, tlw + 64 * (NT - 1));
  __syncthreads(); RESC(alB);
  finishSM(pB0, pB1, alB, l_reg, pa0, pa1, pa2, pa3); SBAR();
  pv_d0(o, vb0 + (int)SHM_V, pa0, pa1, pa2, pa3);
  if (hi == 0) li_l[r32] = l_reg; asm volatile("s_waitcnt lgkmcnt(0)" ::: "memory");
  float rli[16];
#pragma unroll
  for (int r = 0; r < 16; ++r) rli[r] = __builtin_amdgcn_rcpf(li_l[crow(r, hi)]);
  bf16_t* Ow = Ob + (long)(wid * QBLK) * LDO + r32;
#pragma unroll
  for (int r = 0; r < 16; ++r) { const int orow = crow(r, hi);
#pragma unroll
    for (int d0 = 0; d0 < 4; ++d0) { bf16_t* p = Ow + (long)orow * LDO + d0 * 32; const float g = bf2f(*p); *p = f2bf(o[d0][r] * rli[r] * g); } }
#undef SLOAD
#undef SWRITE
#undef SWAIT
#undef RESC
}
}
constexpr int DM = 2048, DEPTH = 4, NPASS = 3, TP = 16384, NIN = 13120, NINP = 13312, NWAVES = 8;
constexpr int T_PROMPT = 32768, T_SAMPLE = 16384;
constexpr float RMS_EPS = 1e-6f;
constexpr int KS_ADA = 32;
constexpr int NSTEP_PRO = 2, NSTEP_IT = 8, NSTEPS = NSTEP_PRO + DEPTH * NPASS * NSTEP_IT;
constexpr size_t MiB = 1u << 20;
constexpr size_t WS_CTL = 0, CTL_ZERO_BYTES = 1 * MiB;
constexpr size_t WS_PTRS = 512 * 1024;
constexpr size_t WS_MOD = 1 * MiB;
constexpr size_t WS_ROPE = 3 * MiB;
constexpr size_t WS_TB = 4 * MiB;
constexpr size_t WS_MODP = 5 * MiB;
constexpr size_t WS_WIN_T = 64 * MiB;
constexpr size_t WS_WQ_T = 272 * MiB;
constexpr size_t WS_WKV_T = 278 * MiB;
constexpr size_t WS_WBR_T = 282 * MiB;
constexpr size_t WS_WOUT_T = 330 * MiB;
constexpr size_t WS_H = 362 * MiB;
constexpr size_t WS_CQKV = 426 * MiB;
constexpr size_t WS_QM = 458 * MiB;
constexpr size_t WS_KF = 506 * MiB;
constexpr size_t WS_VM = 554 * MiB;
constexpr size_t WS_Y = WS_QM;
constexpr size_t WS_AX = 586 * MiB;
constexpr size_t WS_WINB = 634 * MiB;
constexpr size_t WS_G = 682 * MiB;
constexpr size_t WS_MG = 778 * MiB;
constexpr size_t WS_END = 970 * MiB;
static_assert(WS_WIN_T + (size_t)4 * NINP * DM * 2 <= WS_WQ_T && WS_MODP + (size_t)KS_ADA * 4 * 16 * 6144 * 4 <= WS_WIN_T && WS_MG + (size_t)TP * 6144 * 2 <= WS_END, "d_ws map");
static_assert((size_t)TP * 2048 * 4 == WS_AX - WS_QM, "Y overlays exactly QM|KF|VM");
constexpr int RING_OFF = 0, RING_BYTES = 131072;
constexpr int LDSCTL_OFF = RING_BYTES;
constexpr int LDS_BYTES = 147456;
static_assert(att::lds_bytes(192) <= RING_BYTES, "attention LDS");

#define LDS_WAIT() asm volatile("s_waitcnt lgkmcnt(0)" ::: "memory")
#define VM_WAIT() asm volatile("s_waitcnt vmcnt(0)" ::: "memory")

#define XB_TMO      128
#define XB_XCNT(j)  (256  + 64 * (j))
#define XB_XSUB(j)  (1280 + 64 * (j))
#define XB_XGEN(j)  (2304 + 64 * (j))
#define XB_TOP      3328
#define XB_TOPGEN   3392
#define XCD_BAR_WORDS 3456
#define XB_SPIN_CAP (1u << 22)

__device__ __forceinline__ unsigned xb_ld(unsigned* p)              { return __hip_atomic_load(p, __ATOMIC_RELAXED, __HIP_MEMORY_SCOPE_AGENT); }
__device__ __forceinline__ unsigned xb_add(unsigned* p, unsigned v) { return __hip_atomic_fetch_add(p, v, __ATOMIC_RELAXED, __HIP_MEMORY_SCOPE_AGENT); }
__device__ __forceinline__ unsigned xb_xcc_id() { return (unsigned)__builtin_amdgcn_s_getreg((3 << 11) | 20) & 0xFu; }
#define XB_SPIN(cond, bar) do { unsigned _sp = 0; while (cond) { __builtin_amdgcn_s_sleep(1); \
    if ((++_sp & 255u) == 0u) { if (xb_ld(&(bar)[XB_TMO])) break; if (_sp > XB_SPIN_CAP) { atomicAdd(&(bar)[XB_TMO], 1u); break; } } } } while (0)

struct XcdBarrier {
    unsigned* bar; unsigned x;
    volatile LAS unsigned* st;
};
__device__ __forceinline__ XcdBarrier xcd_barrier_post(unsigned* bar, volatile LAS unsigned* st) {
    XcdBarrier b; b.bar = bar; b.x = xb_xcc_id(); b.st = st;
    if (threadIdx.x == 0) (void)xb_add(&bar[XB_XCNT(b.x)], 1u);
    return b;
}
__device__ __forceinline__ void xcd_barrier_complete(unsigned* bar, unsigned x, unsigned& nloc, unsigned& nx) {
    const unsigned G = gridDim.x * gridDim.y * gridDim.z;
    unsigned sum, cnt, mine, sp = 0u;
    for (;;) {
        sum = 0u; cnt = 0u; mine = 0u;
#pragma unroll
        for (unsigned j = 0; j < 16; ++j) { const unsigned c = xb_ld(&bar[XB_XCNT(j)]); sum += c; cnt += (c > 0u) ? 1u : 0u; }
        mine = xb_ld(&bar[XB_XCNT(x)]);
        if (sum == G) break;
        __builtin_amdgcn_s_sleep(1);
        if ((++sp & 255u) == 0u) { if (xb_ld(&bar[XB_TMO])) break; if (sp > XB_SPIN_CAP) { atomicAdd(&bar[XB_TMO], 1u); break; } }
    }
    nloc = mine > 0u ? mine : 1u; nx = cnt > 0u ? cnt : 1u;
}
__device__ __forceinline__ void xcd_barrier(const XcdBarrier& b) {
    asm volatile("s_waitcnt vmcnt(0)" ::: "memory");
    __syncthreads();
    if (threadIdx.x == 0) {
        unsigned* bar = b.bar;
        __builtin_amdgcn_s_waitcnt(0);
        unsigned nloc = b.st[0], nx = b.st[1];
        if (nloc == 0u) { xcd_barrier_complete(bar, b.x, nloc, nx); b.st[0] = nloc; b.st[1] = nx; }
        const unsigned old = xb_add(&bar[XB_XSUB(b.x)], 1u);
        const unsigned gen = old / nloc;
        if (old + 1u == (gen + 1u) * nloc) {
            __builtin_amdgcn_fence(__ATOMIC_RELEASE, "agent");
            asm volatile("s_waitcnt vmcnt(0)" ::: "memory");
            const unsigned og = xb_add(&bar[XB_TOP], 1u);
            const unsigned tg = og / nx;
            if (og + 1u == (tg + 1u) * nx) xb_add(&bar[XB_TOPGEN], 1u);
            else XB_SPIN(xb_ld(&bar[XB_TOPGEN]) == tg, bar);
            __builtin_amdgcn_fence(__ATOMIC_ACQUIRE, "agent");
            xb_add(&bar[XB_XGEN(b.x)], 1u);
            asm volatile("s_waitcnt vmcnt(0)" ::: "memory");
        } else {
            XB_SPIN(xb_ld(&bar[XB_XGEN(b.x)]) == gen, bar);
            __builtin_amdgcn_fence(__ATOMIC_ACQUIRE, "agent");
            asm volatile("s_waitcnt vmcnt(0)" ::: "memory");
        }
    }
    __syncthreads();
}

template <int CTRL> __device__ __forceinline__ float dpp_f(float v) { return __builtin_bit_cast(float, __builtin_amdgcn_update_dpp(0, __builtin_bit_cast(int, v), CTRL, 0xf, 0xf, true)); }
__device__ __forceinline__ float sum16(float v) {
    v += dpp_f<0xB1>(v); v += dpp_f<0x4E>(v); v += dpp_f<0x141>(v); v += dpp_f<0x140>(v); return v;
}
__device__ __forceinline__ float wave_sum(float v) {
    v = sum16(v);
    const int b = __builtin_bit_cast(int, v);
    return (__builtin_bit_cast(float, __builtin_amdgcn_readlane(b, 0)) + __builtin_bit_cast(float, __builtin_amdgcn_readlane(b, 16)))
         + (__builtin_bit_cast(float, __builtin_amdgcn_readlane(b, 32)) + __builtin_bit_cast(float, __builtin_amdgcn_readlane(b, 48)));
}
__device__ __forceinline__ void tr_item(const float* W, int N, int k0, int n0, bf16_t* dst, int ldd, LAS float* scr, int lane) {
#pragma unroll 8
    for (int i = 0; i < 32; ++i) { const int kk = 2 * i + (lane >> 5); scr[kk * 33 + (lane & 31)] = W[(size_t)(k0 + kk) * N + n0 + (lane & 31)]; }
    LDS_WAIT(); asm volatile("" ::: "memory");
    const int c = lane & 7;
#pragma unroll
    for (int j = 0; j < 4; ++j) { const int n = (lane >> 3) + 8 * j; const LAS float* s = scr + (8 * c) * 33 + n;
        u32x4 o; o.x = cvt_pk_bf16(s[0 * 33], s[1 * 33]); o.y = cvt_pk_bf16(s[2 * 33], s[3 * 33]); o.z = cvt_pk_bf16(s[4 * 33], s[5 * 33]); o.w = cvt_pk_bf16(s[6 * 33], s[7 * 33]);
        *(u32x4*)(dst + (size_t)n * ldd + 8 * c) = o; }
    LDS_WAIT(); asm volatile("" ::: "memory");
}
__device__ __forceinline__ void sincos_acc(float ang, float& co, float& si) {
    const double a = (double)ang; const double k = __builtin_rint(a * 0.63661977236758134308);
    const double r = (a - k * 1.5707963267948966192) - k * 6.123233995736766e-17, r2 = r * r;
    const double s = r * (1.0 + r2 * (-1.0 / 6 + r2 * (1.0 / 120 + r2 * (-1.0 / 5040 + r2 * (1.0 / 362880 + r2 * (-1.0 / 39916800 + r2 * (1.0 / 6227020800.0)))))));
    const double c = 1.0 + r2 * (-0.5 + r2 * (1.0 / 24 + r2 * (-1.0 / 720 + r2 * (1.0 / 40320 + r2 * (-1.0 / 3628800 + r2 * (1.0 / 479001600.0 + r2 * (-1.0 / 87178291200.0)))))));
    const int q = (int)(long long)k & 3;
    const double cc = (q == 0) ? c : (q == 1) ? -s : (q == 2) ? -c : s;
    const double ss = (q == 0) ? s : (q == 1) ? c : (q == 2) ? -s : -c;
    co = (float)cc; si = (float)ss;
}
__device__ const float ROPE_FREQ[32] = {1.f, 0.749894261f, 0.562341332f, 0.421696514f, 0.316227764f, 0.237137377f, 0.177827939f, 0.133352131f, 0.100000001f, 0.0749894157f, 0.0562341325f,
    0.0421696529f, 0.0316227749f, 0.0237137377f, 0.0177827943f, 0.0133352149f, 0.00999999978f, 0.00749894185f, 0.00562341325f, 0.00421696482f, 0.00316227763f, 0.00237137359f, 0.00177827943f,
    0.00133352145f, 0.00100000005f, 0.000749894243f, 0.000562341302f, 0.000421696517f, 0.000316227757f, 0.00023713737f, 0.00017782794f, 0.00013335215f};

struct Frame {
    LAS unsigned char* lds; unsigned char* ws;
    int tid, lane, wave, vcu, G;
    const float* const* in;
};
__device__ __forceinline__ void step_prologue(const float* const (&in)[24], unsigned char* ws, LAS unsigned char* lds, int tid, int lane, int wave, int vcu, int G) {
    LAS float* scr = (LAS float*)(lds + RING_OFF + wave * 16384);
    const int gw = vcu * NWAVES + wave, NGW = G * NWAVES;
    const int gt = (vcu * NWAVES + wave) * 64 + lane, NT = G * NWAVES * 64;
    bf16_t* WIN_T = (bf16_t*)(ws + WS_WIN_T); bf16_t* WQ_T = (bf16_t*)(ws + WS_WQ_T); bf16_t* WKV_T = (bf16_t*)(ws + WS_WKV_T);
    bf16_t* WBR_T = (bf16_t*)(ws + WS_WBR_T); bf16_t* WOUT_T = (bf16_t*)(ws + WS_WOUT_T);
    {
        const float* cP = in[2]; const float* cS = in[3]; const float* w_ada = in[5]; float* modp = (float*)(ws + WS_MODP);
        for (int u = gw; u < DEPTH * 48 * KS_ADA; u += NGW) {
            const int ks = u % KS_ADA, cc = (u / KS_ADA) % 48, l = u / (KS_ADA * 48);
#pragma unroll 1
            for (int b = 0; b < 16; ++b) scr[b * 64 + lane] = (b < 8 ? cP + (size_t)b * DM : cS + (size_t)(b - 8) * DM)[ks * 64 + lane];
            LDS_WAIT(); asm volatile("" ::: "memory");
            f32x2 acc[16];
#pragma unroll
            for (int b = 0; b < 16; ++b) acc[b] = (f32x2){0.f, 0.f};
            const float* wp = w_ada + ((size_t)l * DM + ks * 64) * 6144 + cc * 128 + lane * 2;
#pragma unroll 1
            for (int k4 = 0; k4 < 16; ++k4) {
                f32x2 w[4];
#pragma unroll
                for (int q = 0; q < 4; ++q) w[q] = *(const f32x2*)(wp + (size_t)(k4 * 4 + q) * 6144);
#pragma unroll
                for (int b = 0; b < 16; ++b) { const f32x4 cv = *(const LAS f32x4*)(scr + b * 64 + k4 * 4);
                    acc[b] += w[0] * cv[0]; acc[b] += w[1] * cv[1]; acc[b] += w[2] * cv[2]; acc[b] += w[3] * cv[3]; }
            }
#pragma unroll
            for (int b = 0; b < 16; ++b) *(f32x2*)(modp + ((size_t)(ks * DEPTH + l) * 16 + b) * 6144 + cc * 128 + lane * 2) = acc[b];
            LDS_WAIT(); asm volatile("" ::: "memory");
        }
    }
    {
        constexpr int I_IN = (DM / 64) * (NIN / 32), I_Q = (512 / 64) * (1536 / 32), I_KV = (256 / 64) * (2048 / 32), I_BR = (1024 / 64) * (2048 / 32), I_OUT = (DM / 64) * (DM / 32);
        constexpr int I_L = I_IN + I_Q + I_KV + 3 * I_BR + I_OUT;
        for (int it = gw; it < DEPTH * I_L; it += NGW) {
            const int l = it / I_L; int r = it % I_L;
            if (r < I_IN) { const int nblk = NIN / 32, kb = r / nblk, nb = r % nblk, n0 = nb * 32, dn = n0 + (n0 >= 832 ? 192 : 0);
                tr_item(in[7] + (size_t)l * DM * NIN, NIN, kb * 64, n0, WIN_T + ((size_t)l * NINP + dn) * DM + kb * 64, DM, scr, lane); continue; }
            r -= I_IN;
            if (r < I_Q) { const int nblk = 1536 / 32, kb = r / nblk, nb = r % nblk;
                tr_item(in[9] + (size_t)l * 512 * 1536, 1536, kb * 64, nb * 32, WQ_T + ((size_t)l * 1536 + nb * 32) * 512 + kb * 64, 512, scr, lane); continue; }
            r -= I_Q;
            if (r < I_KV) { const int nblk = 2048 / 32, kb = r / nblk, nb = r % nblk, n0 = nb * 32, hh = n0 >> 8, wi = n0 & 255, dn = wi < 128 ? hh * 128 + wi : 1024 + hh * 128 + (wi - 128);
                tr_item(in[11] + (size_t)l * 256 * 2048, 2048, kb * 64, n0, WKV_T + ((size_t)l * 2048 + dn) * 256 + kb * 64, 256, scr, lane); continue; }
            r -= I_KV;
            if (r < 3 * I_BR) { const int br = r / I_BR, rr = r % I_BR, nblk = 2048 / 32, kb = rr / nblk, nb = rr % nblk;
                const float* src = (br == 0 ? in[20] : br == 1 ? in[21] : in[22]) + (size_t)l * 1024 * 2048;
                tr_item(src, 2048, kb * 64, nb * 32, WBR_T + ((size_t)l * 2048 + nb * 32) * 3072 + br * 1024 + kb * 64, 3072, scr, lane); continue; }
            r -= 3 * I_BR;
            { const int nblk = DM / 32, kb = r / nblk, nb = r % nblk;
                tr_item(in[23] + (size_t)l * DM * DM, DM, kb * 64, nb * 32, WOUT_T + ((size_t)l * DM + nb * 32) * DM + kb * 64, DM, scr, lane); }
        }
    }
    for (int e = gt; e < DEPTH * 192 * (DM / 8); e += NT) { const int l = e / (192 * (DM / 8)), r = e % (192 * (DM / 8));
        *(u32x4*)(WIN_T + ((size_t)l * NINP + 832) * DM + (size_t)r * 8) = (u32x4){0u, 0u, 0u, 0u}; }
    { f32x2* rope = (f32x2*)(ws + WS_ROPE);
      for (int e = gt; e < 4096 * 32; e += NT) { const float ang = (float)(e >> 5) * ROPE_FREQ[e & 31]; float c, s; sincos_acc(ang, c, s); rope[e] = (f32x2){c, s}; } }
    { float* tb = (float*)(ws + WS_TB); const float* rel_bias = in[19];
      for (int e = gt; e < 8 * 768; e += NT) { const int h = e / 768, rel = (e % 768) - 383, n = rel < 0 ? -rel : rel; float v = -1e30f;
          if (n <= 128) { int bk = rel > 0 ? 16 : 0;
              if (n < 8) bk += n; else bk += 8 + (n >= 12) + (n >= 16) + (n >= 23) + (n >= 32) + (n >= 46) + (n >= 64) + (n >= 91);
              v = rel_bias[bk * 8 + h] * 1.4426950408889634f; }
          tb[e] = v; } }
}
__device__ __forceinline__ void step_modreduce(const float* b_ada, unsigned char* ws, int gt, int NT) {
    const float* modp = (const float*)(ws + WS_MODP); float* mod = (float*)(ws + WS_MOD);
    for (int e = gt; e < DEPTH * 16 * 6144; e += NT) { const int l = e / (16 * 6144), j = e % 6144; float s = b_ada[l * 6144 + j];
#pragma unroll 8
        for (int ks = 0; ks < KS_ADA; ++ks) s += modp[(size_t)ks * (DEPTH * 16 * 6144) + e];
        mod[e] = s; }
}
__device__ __forceinline__ void step_norm(const float* x, bf16_t* H, const float* ln_g, const float* mod_l, int bbase, int S, int gw, int NGW, int lane) {
    for (int ch = gw; ch < TP / 8; ch += NGW) {
        const float* mb = mod_l + (size_t)(bbase + (ch * 8) / S) * 6144;
        f32x4 gs[8], sh[8];
#pragma unroll
        for (int j = 0; j < 8; ++j) { const int c = (64 * j + lane) * 4; const f32x4 g = *(const f32x4*)(ln_g + c), sc = *(const f32x4*)(mb + 2048 + c); gs[j] = g * (sc + 1.0f); sh[j] = *(const f32x4*)(mb + c); }
        for (int rr = 0; rr < 8; ++rr) { const size_t row = (size_t)ch * 8 + rr;
            const f32x4* xr = (const f32x4*)(x + row * DM) + lane; f32x4 v[8]; float ss = 0.f;
#pragma unroll
            for (int j = 0; j < 8; ++j) { v[j] = xr[64 * j]; ss += (v[j].x * v[j].x + v[j].y * v[j].y) + (v[j].z * v[j].z + v[j].w * v[j].w); }
            const float rstd = 1.0f / sqrtf(wave_sum(ss) * (1.0f / DM) + RMS_EPS);
            u32x2* o8 = (u32x2*)(H + row * DM) + lane;
#pragma unroll
            for (int j = 0; j < 8; ++j) { const f32x4 y = v[j] * rstd * gs[j] + sh[j]; o8[64 * j] = (u32x2){cvt_pk_bf16(y.x, y.y), cvt_pk_bf16(y.z, y.w)}; }
        }
    }
}
__device__ __forceinline__ void head128_norm_rope(bf16_t* base, const float* gain, bool do_rope, const f32x2* cs_row, const f32x2* cs_col, int j) {
    unsigned w[4]; float v[8];
#pragma unroll
    for (int q = 0; q < 4; ++q) { w[q] = *(const unsigned*)(base + 32 * q + 2 * j); v[2 * q] = bf_lo(w[q]); v[2 * q + 1] = bf_hi(w[q]); }
    float ss = 0.f;
#pragma unroll
    for (int e = 0; e < 8; ++e) ss += v[e] * v[e];
    const float rstd = 1.0f / sqrtf(sum16(ss) * (1.0f / 128) + RMS_EPS);
#pragma unroll
    for (int q = 0; q < 4; ++q) { const f32x2 g = *(const f32x2*)(gain + 32 * q + 2 * j); v[2 * q] *= rstd * g.x; v[2 * q + 1] *= rstd * g.y; }
    if (do_rope) {
        const f32x4 ca = *(const f32x4*)(cs_row + 2 * j), cb = *(const f32x4*)(cs_col + 2 * j);
        const float a0 = v[0], a1 = v[1], a2 = v[2], a3 = v[3], b0 = v[4], b1 = v[5], b2 = v[6], b3 = v[7];
        v[0] = a0 * ca.x - a2 * ca.y; v[1] = a1 * ca.z - a3 * ca.w; v[2] = a2 * ca.x + a0 * ca.y; v[3] = a3 * ca.z + a1 * ca.w;
        v[4] = b0 * cb.x - b2 * cb.y; v[5] = b1 * cb.z - b3 * cb.w; v[6] = b2 * cb.x + b0 * cb.y; v[7] = b3 * cb.z + b1 * cb.w;
    }
#pragma unroll
    for (int q = 0; q < 4; ++q) *(unsigned*)(base + 32 * q + 2 * j) = cvt_pk_bf16(v[2 * q], v[2 * q + 1]);
}
__device__ __forceinline__ void step_prep1(bf16_t* CQKV, bf16_t* AXb, bf16_t* WINb, const float* q_a_norm, const float* kv_a_norm, const float* ax_qn, const float* ax_kn,
                                           const float* win_qn, const float* win_kn, const f32x2* rope, int S, int gw, int NGW, int lane) {
    for (int ch = gw; ch < TP / 8; ch += NGW)
        for (int rr = 0; rr < 8; ++rr) { const size_t row = (size_t)ch * 8 + rr; const int s = (int)(row % (size_t)S);
            { bf16_t* p = CQKV + row * 1024 + lane * 8; const u32x4 w = *(const u32x4*)p; float v[8] = {bf_lo(w.x), bf_hi(w.x), bf_lo(w.y), bf_hi(w.y), bf_lo(w.z), bf_hi(w.z), bf_lo(w.w), bf_hi(w.w)};
              float ss = 0.f;
#pragma unroll
              for (int e = 0; e < 8; ++e) ss += v[e] * v[e];
              const float rstd = 1.0f / sqrtf(wave_sum(ss) * (1.0f / 512) + RMS_EPS);
              const f32x4 g0 = *(const f32x4*)(q_a_norm + lane * 8), g1 = *(const f32x4*)(q_a_norm + lane * 8 + 4);
              u32x4 o; o.x = cvt_pk_bf16(v[0] * rstd * g0.x, v[1] * rstd * g0.y); o.y = cvt_pk_bf16(v[2] * rstd * g0.z, v[3] * rstd * g0.w);
              o.z = cvt_pk_bf16(v[4] * rstd * g1.x, v[5] * rstd * g1.y); o.w = cvt_pk_bf16(v[6] * rstd * g1.z, v[7] * rstd * g1.w); *(u32x4*)p = o; }
            { bf16_t* p = CQKV + row * 1024 + 512 + lane * 4; const u32x2 w = *(const u32x2*)p; float v[4] = {bf_lo(w.x), bf_hi(w.x), bf_lo(w.y), bf_hi(w.y)};
              const float ss = (v[0] * v[0] + v[1] * v[1]) + (v[2] * v[2] + v[3] * v[3]);
              const float rstd = 1.0f / sqrtf(wave_sum(ss) * (1.0f / 256) + RMS_EPS);
              const f32x4 g = *(const f32x4*)(kv_a_norm + lane * 4);
              *(u32x2*)p = (u32x2){cvt_pk_bf16(v[0] * rstd * g.x, v[1] * rstd * g.y), cvt_pk_bf16(v[2] * rstd * g.z, v[3] * rstd * g.w)}; }
            const f32x2* cs_row = rope + (size_t)(s >> 6) * 32; const f32x2* cs_col = rope + (size_t)(s & 63) * 32;
#pragma unroll 1
            for (int it = 0; it < 5; ++it) { const int hh = it * 4 + (lane >> 4);
                const bool isax = hh < 10; const int hw = isax ? hh : hh - 10;
                bf16_t* base = (isax ? AXb : WINb) + row * 1536 + hw * 128;
                const float* gain = isax ? (hw < 8 ? ax_qn : ax_kn) : (hw < 8 ? win_qn : win_kn);
                head128_norm_rope(base, gain, isax, cs_row, cs_col, lane & 15); }
        }
}
__device__ __forceinline__ void step_prep2(bf16_t* QM, bf16_t* KF, const bf16_t* CQKV, const float* mla_qn, const float* mla_kn, const f32x2* rope, int S, int gw, int NGW, int lane) {
    const int j = lane & 15;
    for (int ch = gw; ch < TP / 8; ch += NGW)
        for (int rr = 0; rr < 8; ++rr) { const size_t row = (size_t)ch * 8 + rr; const int s = (int)(row % (size_t)S);
            const f32x4 cs = *(const f32x4*)(rope + (size_t)s * 32 + 2 * j);
#pragma unroll 1
            for (int it = 0; it < 4; ++it) { const int h = (it & 1) * 4 + (lane >> 4); const bool isq = it < 2;
                bf16_t* base = (isq ? QM : KF) + row * 1536 + h * 192; const float* gain = isq ? mla_qn : mla_kn;
                const u32x4 wn = *(const u32x4*)(base + 8 * j);
                unsigned r0, r1;
                if (isq) { r0 = *(const unsigned*)(base + 128 + 2 * j); r1 = *(const unsigned*)(base + 160 + 2 * j); }
                else { r0 = *(const unsigned*)(CQKV + row * 1024 + 768 + 2 * j); r1 = *(const unsigned*)(CQKV + row * 1024 + 800 + 2 * j); }
                float v[8] = {bf_lo(wn.x), bf_hi(wn.x), bf_lo(wn.y), bf_hi(wn.y), bf_lo(wn.z), bf_hi(wn.z), bf_lo(wn.w), bf_hi(wn.w)};
                float x0 = bf_lo(r0), x1 = bf_hi(r0), y0 = bf_lo(r1), y1 = bf_hi(r1);
                float ss = (x0 * x0 + x1 * x1) + (y0 * y0 + y1 * y1);
#pragma unroll
                for (int e = 0; e < 8; ++e) ss += v[e] * v[e];
                const float rstd = 1.0f / sqrtf(sum16(ss) * (1.0f / 192) + RMS_EPS);
                const f32x4 g0 = *(const f32x4*)(gain + 8 * j), g1 = *(const f32x4*)(gain + 8 * j + 4); const f32x2 gx = *(const f32x2*)(gain + 128 + 2 * j), gy = *(const f32x2*)(gain + 160 + 2 * j);
                u32x4 o; o.x = cvt_pk_bf16(v[0] * rstd * g0.x, v[1] * rstd * g0.y); o.y = cvt_pk_bf16(v[2] * rstd * g0.z, v[3] * rstd * g0.w);
                o.z = cvt_pk_bf16(v[4] * rstd * g1.x, v[5] * rstd * g1.y); o.w = cvt_pk_bf16(v[6] * rstd * g1.z, v[7] * rstd * g1.w);
                x0 *= rstd * gx.x; x1 *= rstd * gx.y; y0 *= rstd * gy.x; y1 *= rstd * gy.y;
                *(u32x4*)(base + 8 * j) = o;
                *(unsigned*)(base + 128 + 2 * j) = cvt_pk_bf16(x0 * cs.x - y0 * cs.y, x1 * cs.z - y1 * cs.w);
                *(unsigned*)(base + 160 + 2 * j) = cvt_pk_bf16(y0 * cs.x + x0 * cs.y, y1 * cs.z + x1 * cs.w); }
        }
}
struct Args { const float* in[24]; float* out; unsigned char* ws; int step_lo, step_hi, li, pad; };
__global__ void __launch_bounds__(NWAVES * 64, 2) fwd(Args args) {
    extern __shared__ __attribute__((aligned(16))) unsigned char lds_raw[];
    LAS unsigned char* lds = (LAS unsigned char*)lds_raw;
    const int G = gridDim.x, bx = blockIdx.x, vcu = (G % 8 == 0) ? (bx % 8) * (G / 8) + bx / 8 : bx;
    const int NGW = G * NWAVES, NTH = NGW * 64;
    { const int tid = threadIdx.x; if (tid < 64) ((LAS unsigned*)(lds + LDSCTL_OFF))[tid] = 0u; }
    __syncthreads();
    const int lo = args.step_lo, hi = args.step_hi;
    XcdBarrier bar; bar.bar = (unsigned*)(args.ws + WS_CTL) + args.li * XCD_BAR_WORDS; bar.x = 0; bar.st = (volatile LAS unsigned*)(lds + LDSCTL_OFF) + 8;
    if (hi - lo > 1) bar = xcd_barrier_post((unsigned*)(args.ws + WS_CTL) + args.li * XCD_BAR_WORDS, (volatile LAS unsigned*)(lds + LDSCTL_OFF) + 8);
#ifndef PH_MASK
#define PH_MASK 0x3ff
#endif
#define PH(k) (((PH_MASK) >> (k)) & 1)
#define PHASE_IDS() int tid_ = threadIdx.x; asm volatile("" : "+v"(tid_)); const int tid = tid_, lane = tid & 63, wave = __builtin_amdgcn_readfirstlane(tid >> 6), gw = vcu * NWAVES + wave, gt = gw * 64 + lane; (void)gt; (void)gw; (void)lane
#define PHASE_PTRS() PHASE_IDS(); unsigned char* ws = args.ws; asm volatile("" : "+s"(ws)); const float* const* tab = (const float* const*)(ws + WS_PTRS); \
    bf16_t* WIN_T = (bf16_t*)(ws + WS_WIN_T); bf16_t* WQ_T = (bf16_t*)(ws + WS_WQ_T); bf16_t* WKV_T = (bf16_t*)(ws + WS_WKV_T); \
    bf16_t* WBR_T = (bf16_t*)(ws + WS_WBR_T); bf16_t* WOUT_T = (bf16_t*)(ws + WS_WOUT_T); \
    bf16_t* Hb = (bf16_t*)(ws + WS_H); bf16_t* CQKV = (bf16_t*)(ws + WS_CQKV); bf16_t* QM = (bf16_t*)(ws + WS_QM); bf16_t* KF = (bf16_t*)(ws + WS_KF); bf16_t* VM = (bf16_t*)(ws + WS_VM); \
    bf16_t* AXb = (bf16_t*)(ws + WS_AX); bf16_t* WINb = (bf16_t*)(ws + WS_WINB); bf16_t* Gb = (bf16_t*)(ws + WS_G); bf16_t* MG = (bf16_t*)(ws + WS_MG); \
    float* Yf = (float*)(ws + WS_Y); const float* mod_l = (const float*)(ws + WS_MOD) + (size_t)l * 16 * 6144; const f32x2* rope = (const f32x2*)(ws + WS_ROPE); const float* tb = (const float*)(ws + WS_TB); \
    (void)tab; (void)WIN_T; (void)WQ_T; (void)WKV_T; (void)WBR_T; (void)WOUT_T; (void)Hb; (void)CQKV; (void)QM; (void)KF; (void)VM; (void)AXb; (void)WINb; (void)Gb; (void)MG; (void)Yf; (void)mod_l; (void)rope; (void)tb
#define IN(s) (lo <= (s) && (s) < hi)
#define SEAM(s) do { if (IN(s) && IN((s) + 1)) xcd_barrier(bar); } while (0)

    if (PH(0) && IN(0)) { PHASE_IDS(); if (bx == 0 && tid == 0) { const float** tw = (const float**)(args.ws + WS_PTRS);
#pragma unroll
            for (int i = 0; i < 24; ++i) tw[i] = args.in[i];
            tw[24] = (const float*)args.out; }
        step_prologue(args.in, args.ws, lds, tid, lane, wave, vcu, G); }
    SEAM(0);
    if (PH(1) && IN(1)) { PHASE_IDS(); step_modreduce(args.in[6], args.ws, gt, NTH); }
    SEAM(1);

    int it_lo = (lo - NSTEP_PRO) / NSTEP_IT; if (lo < NSTEP_PRO) it_lo = 0;
    int it_hi = (hi - NSTEP_PRO + NSTEP_IT - 1) / NSTEP_IT; if (hi <= NSTEP_PRO) it_hi = 0; if (it_hi > DEPTH * NPASS) it_hi = DEPTH * NPASS;
    for (int it = it_lo; it < it_hi; ++it) {
        const int l = it / NPASS, p = it % NPASS, s0 = NSTEP_PRO + it * NSTEP_IT;
        const int S = p < 2 ? 4096 : 2048, bbase = p < 2 ? p * 4 : 8;
        const size_t row0 = (size_t)p * TP;

        if (PH(2) && IN(s0 + 0)) { PHASE_PTRS(); const float* xin = (l == 0) ? (p < 2 ? tab[0] + row0 * DM : tab[1]) : (const float*)tab[24] + row0 * DM; float* xout = (float*)tab[24] + row0 * DM; (void)xout; step_norm(xin, Hb, tab[4] + (size_t)l * DM, mod_l, bbase, S, gw, NGW, lane); }
        SEAM(s0 + 0);
        if (PH(3) && IN(s0 + 1)) { PHASE_PTRS();
            pg8::Gemm g{Hb, WIN_T + (size_t)l * NINP * DM, TP, NINP, DM, DM, DM}; pg8::StaticOrder So; So.init(TP, NINP, G, bx);
            EpiInProj E{CQKV, Gb, AXb, WINb, MG};
            pg8::gemm_phase<EpiInProj, pg8::StaticOrder, true, true>(lds + RING_OFF, g, So, E);
        }
        SEAM(s0 + 1);
        if (PH(4) && IN(s0 + 2)) { PHASE_PTRS(); step_prep1(CQKV, AXb, WINb, tab[8] + (size_t)l * 512, tab[10] + (size_t)l * 256, tab[14] + (size_t)l * 128, tab[15] + (size_t)l * 128,
                                   tab[16] + (size_t)l * 128, tab[17] + (size_t)l * 128, rope, S, gw, NGW, lane); }
        SEAM(s0 + 2);
        if (PH(5) && IN(s0 + 3)) { PHASE_PTRS();
            { pg8::Gemm g{CQKV, WQ_T + (size_t)l * 1536 * 512, TP, 1536, 512, 1024, 512}; pg8::StaticOrder So; So.init(TP, 1536, G, bx);
              EpiPlain E{QM, 1536};
              pg8::gemm_phase<EpiPlain, pg8::StaticOrder, true, true>(lds + RING_OFF, g, So, E); }
            { pg8::Gemm g{CQKV + 512, WKV_T + (size_t)l * 2048 * 256, TP, 2048, 256, 1024, 256}; pg8::StaticOrder So; So.init(TP, 2048, G, G - 1 - bx);
              EpiKV E{KF, VM};
              pg8::gemm_phase<EpiKV, pg8::StaticOrder, true, true>(lds + RING_OFF, g, So, E); }
        }
        SEAM(s0 + 3);
        if (PH(6) && IN(s0 + 4)) { PHASE_PTRS(); step_prep2(QM, KF, CQKV, tab[12] + (size_t)l * 192, tab[13] + (size_t)l * 192, rope, S, gw, NGW, lane); }
        SEAM(s0 + 4);
        if (PH(7) && IN(s0 + 5)) { PHASE_PTRS();
            const int nqb = S / 256, nunits = (TP / 256) * 8; char* al = (char*)lds_raw + RING_OFF;
            for (int u = vcu; u < nunits; u += G) { const int qb = u % nqb, h = (u / nqb) % 8, b = u / (nqb * 8); const size_t t0 = (size_t)b * S, tq = t0 + (size_t)qb * 256;
                att::attn_unit<192, 1, 1536, 1536, 1024, 3072, false>(QM + tq * 1536 + h * 192, KF + t0 * 1536 + h * 192, VM + t0 * 1024 + h * 128, Gb + tq * 3072 + h * 128,
                                                                     S / 64, -1e30f, 0.f, tb, 0, al); }
            for (int u = vcu; u < nunits; u += G) { const int qb = u % nqb, h = (u / nqb) % 8, b = u / (nqb * 8); const size_t t0 = (size_t)b * S, tq = t0 + (size_t)qb * 256;
                att::attn_unit<128, 2, 1536, 1536, 1536, 3072, false>(AXb + tq * 1536 + h * 128, AXb + t0 * 1536 + 1024 + (h >> 2) * 128, AXb + t0 * 1536 + 1280 + (h >> 2) * 128,
                                                                     Gb + tq * 3072 + 1024 + h * 128, S / 64, -1e30f, 0.f, tb, 0, al); }
            const float* sink = tab[18] + l * 8;
            for (int u = vcu; u < nunits; u += G) { const int qb = u % nqb, h = (u / nqb) % 8, b = u / (nqb * 8); const size_t t0 = (size_t)b * S, tq = t0 + (size_t)qb * 256;
                const int q0 = qb * 256, ks = q0 >= 128 ? q0 - 128 : 0, ke = q0 + 384 <= S ? q0 + 384 : S; const size_t tk = t0 + ks;
                att::attn_unit<128, 1, 1536, 1536, 1536, 3072, true>(WINb + tq * 1536 + h * 128, WINb + tk * 1536 + 1024 + (h >> 2) * 128, WINb + tk * 1536 + 1280 + (h >> 2) * 128,
                                                                    Gb + tq * 3072 + 2048 + h * 128, (ke - ks) / 64, sink[h] * 1.4426950408889634f, 1.f, tb + h * 768, ks - q0 + 383, al); }
            __syncthreads();
        }
        SEAM(s0 + 5);
        if (PH(8) && IN(s0 + 6)) { PHASE_PTRS();
            pg8::StaticOrder So; So.init(TP, DM, G, bx);
            const bf16_t* wb = WBR_T + (size_t)l * DM * 3072;
            { pg8::Gemm g{Gb, wb, TP, DM, 1024, 3072, 3072}; EpiBranch<0> E{MG, Yf, Hb}; pg8::gemm_phase<EpiBranch<0>, pg8::StaticOrder, true, true>(lds + RING_OFF, g, So, E); }
            { pg8::Gemm g{Gb + 1024, wb + 1024, TP, DM, 1024, 3072, 3072}; EpiBranch<1> E{MG, Yf, Hb}; pg8::gemm_phase<EpiBranch<1>, pg8::StaticOrder, true, true>(lds + RING_OFF, g, So, E); }
            { pg8::Gemm g{Gb + 2048, wb + 2048, TP, DM, 1024, 3072, 3072}; EpiBranch<2> E{MG, Yf, Hb}; pg8::gemm_phase<EpiBranch<2>, pg8::StaticOrder, true, true>(lds + RING_OFF, g, So, E); }
        }
        SEAM(s0 + 6);
        if (PH(9) && IN(s0 + 7)) { PHASE_PTRS(); const float* xin = (l == 0) ? (p < 2 ? tab[0] + row0 * DM : tab[1]) : (const float*)tab[24] + row0 * DM; float* xout = (float*)tab[24] + row0 * DM; (void)xout;
            pg8::Gemm g{Hb, WOUT_T + (size_t)l * DM * DM, TP, DM, DM, DM, DM}; pg8::StaticOrder So; So.init(TP, DM, G, bx);
            EpiOut E{xin, xout, mod_l + 4096, bbase, S};
            pg8::gemm_phase<EpiOut, pg8::StaticOrder, true, true>(lds + RING_OFF, g, So, E);
        }
        SEAM(s0 + 7);
    }
#undef IN
#undef SEAM
}

extern "C" void kernel_launch(void* const* d_in, const int* in_sizes, int n_in, void* d_out, int out_size, void* d_ws, size_t ws_size, hipStream_t stream) {
    static int grid = 0;
    if (grid == 0) {
        if (n_in != 24 || in_sizes[0] != T_PROMPT * DM || in_sizes[1] != T_SAMPLE * DM || out_size != (T_PROMPT + T_SAMPLE) * DM || ws_size < WS_END) {
            fprintf(stderr, "kernel_launch: shape mismatch (n_in %d, in0 %d, in1 %d, out %d, ws %zu, need ws >= %zu); nothing launched\n", n_in, n_in > 0 ? in_sizes[0] : -1, n_in > 1 ? in_sizes[1] : -1, out_size, ws_size, (size_t)WS_END);
            grid = -1; return; }
        int dev = 0, cus = 0, per_cu = 0;
        if (hipGetDevice(&dev) != hipSuccess || hipDeviceGetAttribute(&cus, hipDeviceAttributeMultiprocessorCount, dev) != hipSuccess) { fprintf(stderr, "kernel_launch: device query failed\n"); grid = -1; return; }
        if (hipFuncSetAttribute((const void*)fwd, hipFuncAttributeMaxDynamicSharedMemorySize, LDS_BYTES) != hipSuccess) { fprintf(stderr, "kernel_launch: hipFuncSetAttribute failed\n"); grid = -1; return; }
        if (hipOccupancyMaxActiveBlocksPerMultiprocessor(&per_cu, (const void*)fwd, NWAVES * 64, LDS_BYTES) != hipSuccess || per_cu < 1)
            fprintf(stderr, "kernel_launch: note: occupancy query reports %d workgroups per CU\n", per_cu);
        (void)hipGetLastError();
        grid = cus;
    }
    if (grid < 0) return;
    if (hipMemsetAsync((char*)d_ws + WS_CTL, 0, CTL_ZERO_BYTES, stream) != hipSuccess) { fprintf(stderr, "kernel_launch: hipMemsetAsync failed\n"); return; }
    Args a{};
    for (int i = 0; i < 24; ++i) a.in[i] = (const float*)d_in[i];
    a.out = (float*)d_out; a.ws = (unsigned char*)d_ws; a.li = 0; a.pad = 0;
#if MK_ONE_LAUNCH
    a.step_lo = 0; a.step_hi = NSTEPS;
    hipLaunchKernelGGL(fwd, dim3(grid), dim3(NWAVES * 64), LDS_BYTES, stream, a);
#else
    for (int s = 0; s < NSTEPS; ++s) { a.step_lo = s; a.step_hi = s + 1;
        hipLaunchKernelGGL(fwd, dim3(grid), dim3(NWAVES * 64), LDS_BYTES, stream, a); }
#endif
    const hipError_t le = hipPeekAtLastError();
    if (le != hipSuccess) fprintf(stderr, "kernel_launch: launch failed: %s\n", hipGetErrorName(le));
}
```

```cpp
#include <hip/hip_runtime.h>
#include <cstdio>
#include <cstdint>

#ifndef MK_ONE_LAUNCH
#define MK_ONE_LAUNCH 1
#endif

#define LAS __attribute__((address_space(3)))
typedef unsigned short bf16_t;
typedef short bf16x8 __attribute__((ext_vector_type(8)));
typedef short s16x4 __attribute__((ext_vector_type(4)));
typedef float f32x2 __attribute__((ext_vector_type(2)));
typedef float f32x4 __attribute__((ext_vector_type(4)));
typedef float f32x16 __attribute__((ext_vector_type(16)));
typedef unsigned u32x2 __attribute__((ext_vector_type(2)));
typedef unsigned u32x4 __attribute__((ext_vector_type(4)));

__device__ __forceinline__ unsigned cvt_pk_bf16(float lo, float hi) { unsigned r; asm volatile("v_cvt_pk_bf16_f32 %0, %1, %2" : "=v"(r) : "v"(lo), "v"(hi)); return r; }
__device__ __forceinline__ float bf_lo(unsigned w) { return __builtin_bit_cast(float, w << 16); }
__device__ __forceinline__ float bf_hi(unsigned w) { return __builtin_bit_cast(float, w & 0xffff0000u); }
__device__ __forceinline__ float bf2f(bf16_t x) { return __builtin_bit_cast(float, (unsigned)x << 16); }
__device__ __forceinline__ bf16_t f2bf(float f) { return (bf16_t)(cvt_pk_bf16(f, 0.f) & 0xffffu); }
__device__ __forceinline__ float sigmoid_f(float v) { return __builtin_amdgcn_rcpf(1.0f + __builtin_amdgcn_exp2f(-1.4426950408889634f * v)); }
__device__ __forceinline__ float silu_f(float v) { return v * sigmoid_f(v); }

namespace pg8 {
#define PG8_LAS __attribute__((address_space(3)))
constexpr int BM = 256, BK = 64, HALF = 128, HTB = HALF * BK * 2  , STAGE_BYTES = 8 * HTB, NXCD = 8, WGM = 8;
__host__ __device__ __forceinline__ int lds_byte(int r, int c) { const int st = (r >> 4) * 2 + (c >> 5), rr = r & 15, cc = c & 31, ob = rr * 64 + cc * 2; return st * 1024 + (ob ^ (((ob >> 9) & 1) << 5)); }
__host__ __device__ __forceinline__ void stage_rc(int b, int& R, int& C) { const int st = b / 1024, sb = b % 1024, swz = sb ^ (((sb >> 9) & 1) << 5); R = (st >> 1) * 16 + swz / 64; C = (st & 1) * 32 + (swz % 64) / 2; }
__host__ __device__ __forceinline__ int perm32(int rho) { const int n = rho >> 4, i = rho & 15; return 8 * (i >> 2) + 4 * n + (i & 3); }

struct Unit { int pm, pn; };
struct Gemm { const bf16_t* A; const bf16_t* Bt; int M, N, K, lda, ldb; };

struct StaticOrder {
    int nM, nN, nwg, G, c, wgm;
    __host__ __device__ void init(int M, int N, int G_, int c_, int wgm_ = 4) { nM = M / BM; nN = N / BM; nwg = nM * nN; G = G_; c = c_; wgm = wgm_; }
    __host__ __device__ bool next(int i, Unit& u) const {
        const long L = (long)i * G + c; if (L >= nwg) return false;
        int wgid = (int)L; { const int q = nwg / NXCD, r = nwg % NXCD, xcd = wgid % NXCD, off = wgid / NXCD; wgid = (xcd < r ? xcd * (q + 1) : r * (q + 1) + (xcd - r) * q) + off; }
        const int nig = wgm * nN, gid = wgid / nig, fm = gid * wgm, gsz = (nM - fm) < wgm ? (nM - fm) : wgm;
        u.pm = fm + ((wgid % nig) % gsz); u.pn = (wgid % nig) / gsz; return true;
    }
};
template <class Epi, class Sched, bool ALIGN_EPI = false, bool SP2 = false>
__device__ __forceinline__ void gemm_phase(PG8_LAS unsigned char* lds, const Gemm g, const Sched& S, const Epi& E) {
    int tid_ = threadIdx.x; asm volatile("" : "+v"(tid_));
    const int tid = tid_, wid = __builtin_amdgcn_readfirstlane(tid >> 6), lane = tid & 63, wr = wid >> 2, wc = wid & 3, fr = lane & 15, fq = lane >> 4;
    int K_ = g.K; asm volatile("" : "+s"(K_));
    const int K = K_, nt = K / BK;
    unsigned voffA[2], voffB[2];
#pragma unroll
    for (int i = 0; i < 2; ++i) { int R, C; stage_rc(tid * 16 + i * 8192, R, C); const int Rb = Epi::PERM ? ((R & ~31) + perm32(R & 31)) : R;
        voffA[i] = (unsigned)(R * g.lda + C) * 2u; voffB[i] = (unsigned)(Rb * g.ldb + C) * 2u; }
    const size_t kstep = (size_t)(BK * 2);
    const size_t hstepA = (size_t)HALF * g.lda * 2, hstepB = (size_t)HALF * g.ldb * 2;
    const size_t tstepA = 2 * hstepA, tstepB = 2 * hstepB;
    const unsigned ldsw = (unsigned)wid * 1024u;
    const int aoff = lds_byte(wr * 64 + fr, fq * 8), boff = lds_byte(wc * 32 + fr, fq * 8);
#define PG8_SA(b, h) (((b) * 2 + (h)) * HTB)
#define PG8_SB(b, h) ((4 + (b) * 2 + (h)) * HTB)
#define PG8_STAGE(bufoff, gbase, voff) do { _Pragma("unroll") for (int _i = 0; _i < 2; ++_i) \
        __builtin_amdgcn_global_load_lds((const unsigned*)((const char*)(gbase) + (voff)[_i]), (PG8_LAS unsigned*)(lds + (bufoff) + ldsw + _i * 8192), 16, 0, 0); } while (0)
#define PG8_LDA(dst, b, h) do { _Pragma("unroll") for (int m = 0; m < 4; ++m) _Pragma("unroll") for (int k = 0; k < 2; ++k) dst[m][k] = *(const PG8_LAS bf16x8*)(lds + PG8_SA(b, h) + aoff + m * 2048 + k * 1024); } while (0)
#define PG8_LDB(dst, b, h) do { _Pragma("unroll") for (int n = 0; n < 2; ++n) _Pragma("unroll") for (int k = 0; k < 2; ++k) dst[n][k] = *(const PG8_LAS bf16x8*)(lds + PG8_SB(b, h) + boff + n * 2048 + k * 1024); } while (0)
#define PG8_MMA(ai, bj, At, Bt) do { __builtin_amdgcn_s_setprio(1); _Pragma("unroll") for (int m = 0; m < 4; ++m) _Pragma("unroll") for (int n = 0; n < 2; ++n) _Pragma("unroll") for (int k = 0; k < 2; ++k) \
        acc[ai][bj][m][n] = __builtin_amdgcn_mfma_f32_16x16x32_bf16(Bt[n][k], At[m][k], acc[ai][bj][m][n], 0, 0, 0); __builtin_amdgcn_s_setprio(0); } while (0)
#define PG8_WAIT_V(n) asm volatile("s_waitcnt vmcnt(" #n ")" ::: "memory")
#define PG8_WAIT_L(n) asm volatile("s_waitcnt lgkmcnt(" #n ")" ::: "memory")
#define PG8_BAR __builtin_amdgcn_s_barrier()
#define PG8_SCHED __builtin_amdgcn_sched_barrier(0)
    Unit cur, nxt; int ui = 0;
    if (!S.next(0, cur)) return;
    f32x4 acc[2][2][4][2];
#pragma unroll
    for (int a = 0; a < 2; ++a)
#pragma unroll
        for (int b = 0; b < 2; ++b)
#pragma unroll
            for (int m = 0; m < 4; ++m)
#pragma unroll
                for (int n = 0; n < 2; ++n) acc[a][b][m][n] = (f32x4){0.f, 0.f, 0.f, 0.f};
    bf16x8 At[4][2], B0[2][2], B1[2][2];
    const char* cA = (const char*)g.A + (size_t)cur.pm * tstepA; const char* cB = (const char*)g.Bt + (size_t)cur.pn * tstepB;

    if constexpr (SP2) {
        PG8_STAGE(PG8_SB(0, 0), cB, voffB); PG8_STAGE(PG8_SB(0, 1), cB + hstepB, voffB); PG8_STAGE(PG8_SA(0, 0), cA, voffA); PG8_STAGE(PG8_SA(0, 1), cA + hstepA, voffA);
        if (wr == 1) PG8_BAR;
        PG8_WAIT_V(2); PG8_BAR;
        PG8_STAGE(PG8_SB(1, 0), cB + kstep, voffB); PG8_STAGE(PG8_SA(1, 0), cA + kstep, voffA); PG8_STAGE(PG8_SB(1, 1), cB + hstepB + kstep, voffB);
        PG8_WAIT_V(6); PG8_BAR;
    } else {
        PG8_STAGE(PG8_SB(0, 0), cB, voffB); PG8_STAGE(PG8_SA(0, 0), cA, voffA); PG8_STAGE(PG8_SB(0, 1), cB + hstepB, voffB); PG8_STAGE(PG8_SA(0, 1), cA + hstepA, voffA);
        if (wr == 1) PG8_BAR;
        PG8_WAIT_V(4); PG8_BAR;
        PG8_STAGE(PG8_SB(1, 0), cB + kstep, voffB); PG8_STAGE(PG8_SA(1, 0), cA + kstep, voffA); PG8_STAGE(PG8_SB(1, 1), cB + hstepB + kstep, voffB);
        PG8_WAIT_V(6); PG8_BAR;
    }
    for (;;) {
        const bool has_next = S.next(ui + 1, nxt);
        const char* nA = has_next ? (const char*)g.A + (size_t)nxt.pm * tstepA : cA; const char* nB = has_next ? (const char*)g.Bt + (size_t)nxt.pn * tstepB : cB;
        for (int t = 0; t < nt; t += 2) {
            if constexpr (Epi::HAS_MID) { if (t == Epi::MID1 || t == Epi::MID2) E.mid(acc, cur, t, wr, wc, fr, fq); }
            const bool last = (t == nt - 2);
            const char* a1 = cA + (size_t)(t + 1) * kstep;
            const char* a2 = last ? nA : cA + (size_t)(t + 2) * kstep; const char* b2 = last ? nB : cB + (size_t)(t + 2) * kstep;
            const char* a3 = a2 + kstep; const char* b3 = b2 + kstep;

            if constexpr (SP2) {
            PG8_LDB(B0, 0, 0); PG8_LDB(B1, 0, 1); PG8_SCHED; PG8_LDA(At, 0, 0); PG8_STAGE(PG8_SA(1, 1), a1 + hstepA, voffA);
            PG8_WAIT_V(8); PG8_WAIT_L(0); PG8_BAR; PG8_MMA(0, 0, At, B0); PG8_MMA(0, 1, At, B1); PG8_BAR; PG8_SCHED;
            PG8_LDA(At, 0, 1); PG8_STAGE(PG8_SB(0, 0), b2, voffB); PG8_STAGE(PG8_SB(0, 1), b2 + hstepB, voffB); PG8_STAGE(PG8_SA(0, 0), a2, voffA);
            PG8_WAIT_V(8); PG8_WAIT_L(0); PG8_BAR; PG8_MMA(1, 0, At, B0); PG8_MMA(1, 1, At, B1); PG8_BAR; PG8_SCHED;
            PG8_LDB(B0, 1, 0); PG8_LDB(B1, 1, 1); PG8_SCHED; PG8_LDA(At, 1, 0); PG8_STAGE(PG8_SA(0, 1), a2 + hstepA, voffA);
            PG8_WAIT_V(8); PG8_WAIT_L(0); PG8_BAR; PG8_MMA(0, 0, At, B0); PG8_MMA(0, 1, At, B1); PG8_BAR; PG8_SCHED;
            PG8_LDA(At, 1, 1); PG8_STAGE(PG8_SB(1, 0), b3, voffB); PG8_STAGE(PG8_SB(1, 1), b3 + hstepB, voffB); PG8_STAGE(PG8_SA(1, 0), a3, voffA);
            PG8_WAIT_V(8); PG8_WAIT_L(0); PG8_BAR; PG8_MMA(1, 0, At, B0); PG8_MMA(1, 1, At, B1); PG8_BAR; PG8_SCHED;
            } else {
            PG8_LDB(B0, 0, 0); PG8_SCHED; PG8_LDA(At, 0, 0); PG8_STAGE(PG8_SA(1, 1), a1 + hstepA, voffA);
            PG8_WAIT_L(8); PG8_BAR; PG8_WAIT_L(0); PG8_MMA(0, 0, At, B0); PG8_BAR; PG8_SCHED;
            PG8_LDB(B1, 0, 1); PG8_STAGE(PG8_SB(0, 0), b2, voffB);
            PG8_BAR; PG8_WAIT_L(0); PG8_MMA(0, 1, At, B1); PG8_BAR;
            PG8_LDA(At, 0, 1); PG8_STAGE(PG8_SA(0, 0), a2, voffA);
            PG8_BAR; PG8_WAIT_L(0); PG8_MMA(1, 0, At, B0); PG8_BAR; PG8_SCHED;
            PG8_STAGE(PG8_SB(0, 1), b2 + hstepB, voffB);
            PG8_WAIT_V(6); PG8_BAR; PG8_MMA(1, 1, At, B1); PG8_BAR;
            PG8_LDB(B0, 1, 0); PG8_SCHED; PG8_LDA(At, 1, 0); PG8_STAGE(PG8_SA(0, 1), a2 + hstepA, voffA);
            PG8_WAIT_L(8); PG8_BAR; PG8_WAIT_L(0); PG8_MMA(0, 0, At, B0); PG8_BAR; PG8_SCHED;
            PG8_LDB(B1, 1, 1); PG8_STAGE(PG8_SB(1, 0), b3, voffB);
            PG8_BAR; PG8_WAIT_L(0); PG8_MMA(0, 1, At, B1); PG8_BAR;
            PG8_LDA(At, 1, 1); PG8_STAGE(PG8_SA(1, 0), a3, voffA);
            PG8_BAR; PG8_WAIT_L(0); PG8_MMA(1, 0, At, B0); PG8_BAR; PG8_SCHED;
            PG8_STAGE(PG8_SB(1, 1), b3 + hstepB, voffB);
            PG8_WAIT_V(6); PG8_BAR; PG8_MMA(1, 1, At, B1); PG8_BAR;
            }
        }
        if constexpr (ALIGN_EPI) { if (wr == 0) PG8_BAR; }
        E(acc, cur, wr, wc, fr, fq);
        if (!has_next) break;
#pragma unroll
        for (int a = 0; a < 2; ++a)
#pragma unroll
            for (int b = 0; b < 2; ++b)
#pragma unroll
                for (int m = 0; m < 4; ++m)
#pragma unroll
                    for (int n = 0; n < 2; ++n) acc[a][b][m][n] = (f32x4){0.f, 0.f, 0.f, 0.f};
        cur = nxt; cA = nA; cB = nB; ++ui;
        if constexpr (ALIGN_EPI) { if (wr == 1) PG8_BAR; }
    }
    PG8_WAIT_V(0);
    if constexpr (!ALIGN_EPI) { if (wr == 0) PG8_BAR; }
    PG8_BAR;
#undef PG8_SA
#undef PG8_SB
#undef PG8_STAGE
#undef PG8_LDA
#undef PG8_LDB
#undef PG8_MMA
#undef PG8_WAIT_V
#undef PG8_WAIT_L
#undef PG8_BAR
#undef PG8_SCHED
}
}

template <int ACT> __device__ __forceinline__ u32x4 act_pack8(f32x4 v0, f32x4 v1) {
    if (ACT == 1) {
#pragma unroll
        for (int j = 0; j < 4; ++j) { v0[j] = silu_f(v0[j]); v1[j] = silu_f(v1[j]); } }
    if (ACT == 2) {
#pragma unroll
        for (int j = 0; j < 4; ++j) { v0[j] = sigmoid_f(v0[j]); v1[j] = sigmoid_f(v1[j]); } }
    u32x4 w; w.x = cvt_pk_bf16(v0[0], v0[1]); w.y = cvt_pk_bf16(v0[2], v0[3]); w.z = cvt_pk_bf16(v1[0], v1[1]); w.w = cvt_pk_bf16(v1[2], v1[3]); return w;
}
template <int ACT> __device__ __forceinline__ void store_tile_bf16(const f32x4 (&acc)[2][2][4][2], bf16_t* p00  , bf16_t* p01  , int ldc) {
#pragma unroll
    for (int ai = 0; ai < 2; ++ai)
#pragma unroll
        for (int m = 0; m < 4; ++m) { const size_t ro = (size_t)(ai * 128 + m * 16) * ldc;
            *(u32x4*)(p00 + ro) = act_pack8<ACT>(acc[ai][0][m][0], acc[ai][0][m][1]);
            *(u32x4*)(p01 + ro) = act_pack8<ACT>(acc[ai][1][m][0], acc[ai][1][m][1]); }
}
struct EpiInProj {
    static constexpr bool PERM = true, HAS_MID = false; static constexpr int MID1 = -1, MID2 = -1;
    bf16_t *CQKV, *G, *AXb, *WINb, *MG; const float* const* tab; int lofs; const f32x2* rope; int S; PG8_LAS float* Pt; float* RS;
    __device__ __forceinline__ void operator()(const f32x4 (&acc)[2][2][4][2], const pg8::Unit& u, int wr, int wc, int fr, int fq) const {
        const int pn = u.pn; bf16_t* base; int ldc, colt, act;
        if (pn < 4)       { base = CQKV; ldc = 1024; colt = pn * 256;               act = 0; }
        else if (pn < 8)  { base = G;    ldc = 3072; colt = (pn - 4) * 256;         act = 1; }
        else if (pn < 14) { base = AXb;  ldc = 1536; colt = (pn - 8) * 256;         act = 0; }
        else if (pn < 18) { base = G;    ldc = 3072; colt = 1024 + (pn - 14) * 256; act = 1; }
        else if (pn < 24) { base = WINb; ldc = 1536; colt = (pn - 18) * 256;        act = 0; }
        else if (pn < 28) { base = G;    ldc = 3072; colt = 2048 + (pn - 24) * 256; act = 1; }
        else              { base = MG;   ldc = 6144; colt = (pn - 28) * 256;        act = 2; }
        bf16_t* p0 = base + (size_t)(u.pm * 256 + wr * 64 + fr) * ldc + colt + wc * 32 + 8 * fq;
        if (pn < 4) {
            float ss[2][4];
#pragma unroll
            for (int ai = 0; ai < 2; ++ai)
#pragma unroll
                for (int m = 0; m < 4; ++m) { float q = 0.f;
#pragma unroll
                    for (int bj = 0; bj < 2; ++bj) { const f32x4 a = acc[ai][bj][m][0], b = acc[ai][bj][m][1];
                        q += (a[0] * a[0] + a[1] * a[1]) + (a[2] * a[2] + a[3] * a[3]) + (b[0] * b[0] + b[1] * b[1]) + (b[2] * b[2] + b[3] * b[3]); }
                    q += __shfl_xor(q, 16); q += __shfl_xor(q, 32); ss[ai][m] = q; }
            if (fq == 0) {
#pragma unroll
                for (int ai = 0; ai < 2; ++ai)
#pragma unroll
                    for (int m = 0; m < 4; ++m) Pt[(ai * 128 + wr * 64 + m * 16 + fr) * 8 + wc] = ss[ai][m]; }
            asm volatile("s_waitcnt lgkmcnt(0)" ::: "memory"); __builtin_amdgcn_s_barrier(); asm volatile("" ::: "memory");
            if (wc == 0 && fq == 0) {
#pragma unroll
                for (int ai = 0; ai < 2; ++ai)
#pragma unroll
                    for (int m = 0; m < 4; ++m) { const int rt = ai * 128 + wr * 64 + m * 16 + fr; const f32x4 t = *(const PG8_LAS f32x4*)(Pt + rt * 8);
                        RS[(size_t)(u.pm * 256 + rt) * 4 + pn] = (t[0] + t[1]) + (t[2] + t[3]); } }
        }
        const bool isax = pn >= 8 && pn < 13;
        if (isax || (pn >= 18 && pn < 23)) {
            float ss[2][4][2];
#pragma unroll
            for (int ai = 0; ai < 2; ++ai)
#pragma unroll
                for (int m = 0; m < 4; ++m)
#pragma unroll
                    for (int bj = 0; bj < 2; ++bj) { const f32x4 a = acc[ai][bj][m][0], b = acc[ai][bj][m][1];
                        float q = (a[0] * a[0] + a[1] * a[1]) + (a[2] * a[2] + a[3] * a[3]) + (b[0] * b[0] + b[1] * b[1]) + (b[2] * b[2] + b[3] * b[3]);
                        q += __shfl_xor(q, 16); q += __shfl_xor(q, 32);
                        ss[ai][m][bj] = q; }
            if (fq == 0) {
#pragma unroll
                for (int ai = 0; ai < 2; ++ai)
#pragma unroll
                    for (int m = 0; m < 4; ++m)
#pragma unroll
                        for (int bj = 0; bj < 2; ++bj) Pt[(ai * 128 + wr * 64 + m * 16 + fr) * 8 + bj * 4 + wc] = ss[ai][m][bj]; }
            asm volatile("s_waitcnt lgkmcnt(0)" ::: "memory"); __builtin_amdgcn_s_barrier(); asm volatile("" ::: "memory");
            const int half = wc >> 1, f4 = ((wc & 1) * 4 + fq) * 4;
            const float* gv = tab[(isax ? 14 : 16) + ((pn == 12 || pn == 22) ? 1 : 0)] + lofs + (isax ? half * 64 + f4 : wc * 32 + 8 * fq);
            const float osc = (isax && pn < 12) ? 0.088388347648318440f * 1.4426950408889634f : 1.0f;
            const f32x4 g0 = *(const f32x4*)gv * osc, g1 = *(const f32x4*)(gv + (isax ? 32 : 4)) * osc;
#pragma unroll
            for (int ai = 0; ai < 2; ++ai)
#pragma unroll
                for (int m = 0; m < 4; ++m) { bf16_t* rp = p0 + (size_t)(ai * 128 + m * 16) * ldc;
                    f32x4 c01 = {1.f, 0.f, 1.f, 0.f}, c23 = c01;
                    if (isax) { const int sq = (u.pm * 256 + ai * 128 + wr * 64 + m * 16 + fr) & (S - 1), pos = half ? (sq & 63) : (sq >> 6);
                        c01 = *(const f32x4*)(rope + (size_t)pos * 32 + f4); c23 = *(const f32x4*)(rope + (size_t)pos * 32 + f4 + 2); }
#pragma unroll
                    for (int bj = 0; bj < 2; ++bj) { const f32x4 t = *(const PG8_LAS f32x4*)(Pt + (ai * 128 + wr * 64 + m * 16 + fr) * 8 + bj * 4);
                        const float rstd = __builtin_amdgcn_rsqf(((t[0] + t[1]) + (t[2] + t[3])) * (1.0f / 128) + 1e-6f);
                        const f32x4 x1 = acc[ai][bj][m][0] * rstd * g0, x2 = acc[ai][bj][m][1] * rstd * g1;
                        const f32x4 cs = {c01[0], c01[2], c23[0], c23[2]}, sn = {c01[1], c01[3], c23[1], c23[3]};
                        const f32x4 v0 = x1 * cs - x2 * sn, v1 = x2 * cs + x1 * sn;
                        u32x4 w; w.x = cvt_pk_bf16(v0[0], v0[1]); w.y = cvt_pk_bf16(v0[2], v0[3]); w.z = cvt_pk_bf16(v1[0], v1[1]); w.w = cvt_pk_bf16(v1[2], v1[3]);
                        *(u32x4*)(rp + bj * 128) = w; } }
            return;
        }
        const float ka = (act == 2) ? 0.f : 1.f, kb = (act == 2) ? 1.f : 0.f, kc = (act == 0) ? 0.f : 1.f, kd = (act == 0) ? 1.f : 0.f;
#pragma unroll
        for (int ai = 0; ai < 2; ++ai)
#pragma unroll
            for (int m = 0; m < 4; ++m) { bf16_t* rp = p0 + (size_t)(ai * 128 + m * 16) * ldc;
#pragma unroll
                for (int bj = 0; bj < 2; ++bj) { f32x4 v0 = acc[ai][bj][m][0], v1 = acc[ai][bj][m][1];
#pragma unroll
                    for (int j = 0; j < 4; ++j) { if (act != 0) { v0[j] = (ka * v0[j] + kb) * sigmoid_f(v0[j]); v1[j] = (ka * v1[j] + kb) * sigmoid_f(v1[j]); } }
                    u32x4 w; w.x = cvt_pk_bf16(v0[0], v0[1]); w.y = cvt_pk_bf16(v0[2], v0[3]); w.z = cvt_pk_bf16(v1[0], v1[1]); w.w = cvt_pk_bf16(v1[2], v1[3]);
                    *(u32x4*)(rp + bj * 128) = w; } }
    }
};
struct EpiPlain {
    static constexpr bool PERM = true, HAS_MID = false; static constexpr int MID1 = -1, MID2 = -1;
    bf16_t* O; int ldc;
    __device__ __forceinline__ void operator()(const f32x4 (&acc)[2][2][4][2], const pg8::Unit& u, int wr, int wc, int fr, int fq) const {
        bf16_t* p0 = O + (size_t)(u.pm * 256 + wr * 64 + fr) * ldc + u.pn * 256 + wc * 32 + 8 * fq;
        store_tile_bf16<0>(acc, p0, p0 + 128, ldc);
    }
};
template <int MODE> __device__ __forceinline__ void store_tile_rowscaled(const f32x4 (&acc)[2][2][4][2], bf16_t* p00, bf16_t* p01, int ldc, const float* rs  ) {
#pragma unroll
    for (int ai = 0; ai < 2; ++ai) { f32x4 t[4];
#pragma unroll
        for (int m = 0; m < 4; ++m) t[m] = *(const f32x4*)(rs + (size_t)(ai * 128 + m * 16) * 4);
#pragma unroll
        for (int m = 0; m < 4; ++m) { const size_t ro = (size_t)(ai * 128 + m * 16) * ldc;
            const float rstd = MODE == 0 ? __builtin_amdgcn_rsqf((t[m][0] + t[m][1]) * (1.0f / 512) + 1e-6f) : __builtin_amdgcn_rsqf(t[m][2] * (1.0f / 256) + 1e-6f);
            *(u32x4*)(p00 + ro) = act_pack8<0>(acc[ai][0][m][0] * rstd, acc[ai][0][m][1] * rstd);
            *(u32x4*)(p01 + ro) = act_pack8<0>(acc[ai][1][m][0] * rstd, acc[ai][1][m][1] * rstd); } }
}
#define ROW_SS8(q, A, B) const float q = ((A)[0] * (A)[0] + (A)[1] * (A)[1]) + ((A)[2] * (A)[2] + (A)[3] * (A)[3]) + ((B)[0] * (B)[0] + (B)[1] * (B)[1]) + ((B)[2] * (B)[2] + (B)[3] * (B)[3])
struct EpiQUp {
    static constexpr bool PERM = true, HAS_MID = false; static constexpr int MID1 = -1, MID2 = -1;
    bf16_t* O; const float* RS; const float* gain  ; const f32x2* rope; int S; PG8_LAS float* Pt;
    __device__ __forceinline__ void operator()(const f32x4 (&acc)[2][2][4][2], const pg8::Unit& u, int wr, int wc, int fr, int fq) const {
        const int row = u.pm * 256 + wr * 64 + fr, cn = wc * 32 + 8 * fq;
        float ss[2][4];
#pragma unroll
        for (int ai = 0; ai < 2; ++ai)
#pragma unroll
            for (int m = 0; m < 4; ++m) { ROW_SS8(q0, acc[ai][0][m][0], acc[ai][0][m][1]); ROW_SS8(q1, acc[ai][1][m][0], acc[ai][1][m][1]); float q = q0 + q1;
                q += __shfl_xor(q, 16); q += __shfl_xor(q, 32); ss[ai][m] = q; }
        if (fq == 0) {
#pragma unroll
            for (int ai = 0; ai < 2; ++ai)
#pragma unroll
                for (int m = 0; m < 4; ++m) Pt[(ai * 128 + wr * 64 + m * 16 + fr) * 8 + wc] = ss[ai][m]; }
        asm volatile("s_waitcnt lgkmcnt(0)" ::: "memory"); __builtin_amdgcn_s_barrier(); asm volatile("" ::: "memory");
        const float osc = 0.072168783648703220f * 1.4426950408889634f;
        const int f4 = ((wc & 1) * 4 + fq) * 4;
        const f32x4 gn0 = *(const f32x4*)(gain + cn) * osc, gn1 = *(const f32x4*)(gain + cn + 4) * osc, gr0 = *(const f32x4*)(gain + 128 + f4) * osc, gr1 = *(const f32x4*)(gain + 160 + f4) * osc;
        bf16_t* p0 = O + (size_t)row * 1536 + u.pn * 192 + cn;
#pragma unroll
        for (int ai = 0; ai < 2; ++ai) { f32x4 t[4];
#pragma unroll
            for (int m = 0; m < 4; ++m) t[m] = *(const f32x4*)(RS + (size_t)(row + ai * 128 + m * 16) * 4);
#pragma unroll
            for (int m = 0; m < 4; ++m) { const int rt = ai * 128 + wr * 64 + m * 16 + fr; const f32x4 pp = *(const PG8_LAS f32x4*)(Pt + rt * 8);
                const float rc = __builtin_amdgcn_rsqf((t[m][0] + t[m][1]) * (1.0f / 512) + 1e-6f);
                const float sc = rc * __builtin_amdgcn_rsqf(rc * rc * ((pp[0] + pp[1]) + (pp[2] + pp[3])) * (1.0f / 192) + 1e-6f);
                bf16_t* rp = p0 + (size_t)(ai * 128 + m * 16) * 1536;
                *(u32x4*)rp = act_pack8<0>(acc[ai][0][m][0] * sc * gn0, acc[ai][0][m][1] * sc * gn1);
                if (wc < 2) { const int sq = (row + ai * 128 + m * 16) & (S - 1);
                    const f32x4 c01 = *(const f32x4*)(rope + (size_t)sq * 32 + f4), c23 = *(const f32x4*)(rope + (size_t)sq * 32 + f4 + 2);
                    const f32x4 cs = {c01[0], c01[2], c23[0], c23[2]}, sn = {c01[1], c01[3], c23[1], c23[3]};
                    const f32x4 x1 = acc[ai][1][m][0] * sc * gr0, x2 = acc[ai][1][m][1] * sc * gr1;
                    *(u32x4*)(rp + 128) = act_pack8<0>(x1 * cs - x2 * sn, x2 * cs + x1 * sn); } } }
    }
};
struct EpiKV {
    static constexpr bool PERM = true, HAS_MID = false; static constexpr int MID1 = -1, MID2 = -1;
    bf16_t *KF, *VM; const float* RS; const bf16_t* CQKV; const float* gain  ; const f32x2* rope; int S; PG8_LAS float* Pt;
    __device__ __forceinline__ void operator()(const f32x4 (&acc)[2][2][4][2], const pg8::Unit& u, int wr, int wc, int fr, int fq) const {
        const int row = u.pm * 256 + wr * 64 + fr, cn = wc * 32 + 8 * fq;
        if (u.pn >= 4) { bf16_t* p0 = VM + (u.pn - 4) * 256 + (size_t)row * 1024 + cn; store_tile_rowscaled<1>(acc, p0, p0 + 128, 1024, RS + (size_t)row * 4); return; }
        float ss[2][4][2];
#pragma unroll
        for (int ai = 0; ai < 2; ++ai)
#pragma unroll
            for (int m = 0; m < 4; ++m)
#pragma unroll
                for (int bj = 0; bj < 2; ++bj) { ROW_SS8(q0, acc[ai][bj][m][0], acc[ai][bj][m][1]); float q = q0; q += __shfl_xor(q, 16); q += __shfl_xor(q, 32); ss[ai][m][bj] = q; }
        if (fq == 0) {
#pragma unroll
            for (int ai = 0; ai < 2; ++ai)
#pragma unroll
                for (int m = 0; m < 4; ++m)
#pragma unroll
                    for (int bj = 0; bj < 2; ++bj) Pt[(ai * 128 + wr * 64 + m * 16 + fr) * 8 + bj * 4 + wc] = ss[ai][m][bj]; }
        asm volatile("s_waitcnt lgkmcnt(0)" ::: "memory"); __builtin_amdgcn_s_barrier(); asm volatile("" ::: "memory");
        const int idx = wc * 4 + fq;
        const f32x4 g0 = *(const f32x4*)(gain + cn), g1 = *(const f32x4*)(gain + cn + 4); const f32x2 gx = *(const f32x2*)(gain + 128 + 2 * idx), gy = *(const f32x2*)(gain + 160 + 2 * idx);
        bf16_t* p0 = KF + (size_t)row * 1536 + (u.pn * 2) * 192 + cn;
        bf16_t* pr = KF + (size_t)row * 1536 + (u.pn * 2) * 192 + 128 + 8 * (idx >> 1) + 2 * (idx & 1);
#pragma unroll
        for (int ai = 0; ai < 2; ++ai) { f32x4 t[4]; unsigned k0[4], k1[4]; f32x4 cs[4];
#pragma unroll
            for (int m = 0; m < 4; ++m) { const size_t r = (size_t)(row + ai * 128 + m * 16); t[m] = *(const f32x4*)(RS + r * 4);
                k0[m] = *(const unsigned*)(CQKV + r * 1024 + 768 + 2 * idx); k1[m] = *(const unsigned*)(CQKV + r * 1024 + 800 + 2 * idx);
                cs[m] = *(const f32x4*)(rope + (size_t)((int)r & (S - 1)) * 32 + 2 * idx); }
#pragma unroll
            for (int m = 0; m < 4; ++m) { const int rt = ai * 128 + wr * 64 + m * 16 + fr;
                const float rc = __builtin_amdgcn_rsqf(t[m][2] * (1.0f / 256) + 1e-6f);
                const float x0 = bf_lo(k0[m]), x1 = bf_hi(k0[m]), y0 = bf_lo(k1[m]), y1 = bf_hi(k1[m]);
#pragma unroll
                for (int bj = 0; bj < 2; ++bj) { const f32x4 pp = *(const PG8_LAS f32x4*)(Pt + rt * 8 + bj * 4);
                    const float rk = __builtin_amdgcn_rsqf((rc * rc * ((pp[0] + pp[1]) + (pp[2] + pp[3])) + t[m][3]) * (1.0f / 192) + 1e-6f), sc = rc * rk;
                    const size_t ro = (size_t)(ai * 128 + m * 16) * 1536 + bj * 192;
                    *(u32x4*)(p0 + ro) = act_pack8<0>(acc[ai][bj][m][0] * sc * g0, acc[ai][bj][m][1] * sc * g1);
                    const float a0 = x0 * rk * gx.x, a1 = x1 * rk * gx.y, b0 = y0 * rk * gy.x, b1 = y1 * rk * gy.y;
                    *(unsigned*)(pr + ro) = cvt_pk_bf16(a0 * cs[m][0] - b0 * cs[m][1], a1 * cs[m][2] - b1 * cs[m][3]);
                    *(unsigned*)(pr + ro + 4) = cvt_pk_bf16(b0 * cs[m][0] + a0 * cs[m][1], b1 * cs[m][2] + a1 * cs[m][3]); } } }
    }
};
struct EpiBranchFused {
    static constexpr bool PERM = true, HAS_MID = true; static constexpr int MID1 = 16, MID2 = 32;
    const bf16_t* MG; bf16_t* YB;
    __device__ __forceinline__ void mid(f32x4 (&acc)[2][2][4][2], const pg8::Unit& u, int t, int wr, int wc, int fr, int fq) const {
        const int b = (t == MID1) ? 0 : 1; const bf16_t* g0 = MG + (size_t)(u.pm * 256 + wr * 64 + fr) * 6144 + b * 2048 + u.pn * 256 + wc * 32 + 8 * fq;
#pragma unroll
        for (int ai = 0; ai < 2; ++ai) {
            u32x4 a[4][2], d[4][2];
#pragma unroll
            for (int m = 0; m < 4; ++m)
#pragma unroll
                for (int bj = 0; bj < 2; ++bj) { const bf16_t* gp = g0 + (size_t)(ai * 128 + m * 16) * 6144 + bj * 128; a[m][bj] = *(const u32x4*)gp; d[m][bj] = *(const u32x4*)(gp + 2048); }
#define RAT(x, y) ((x) * __builtin_amdgcn_rcpf(fmaxf((y), 1e-20f)))
#pragma unroll
            for (int m = 0; m < 4; ++m)
#pragma unroll
                for (int bj = 0; bj < 2; ++bj) { const u32x4 A = a[m][bj], D = d[m][bj];
                    acc[ai][bj][m][0][0] *= RAT(bf_lo(A.x), bf_lo(D.x)); acc[ai][bj][m][0][1] *= RAT(bf_hi(A.x), bf_hi(D.x)); acc[ai][bj][m][0][2] *= RAT(bf_lo(A.y), bf_lo(D.y)); acc[ai][bj][m][0][3] *= RAT(bf_hi(A.y), bf_hi(D.y));
                    acc[ai][bj][m][1][0] *= RAT(bf_lo(A.z), bf_lo(D.z)); acc[ai][bj][m][1][1] *= RAT(bf_hi(A.z), bf_hi(D.z)); acc[ai][bj][m][1][2] *= RAT(bf_lo(A.w), bf_lo(D.w)); acc[ai][bj][m][1][3] *= RAT(bf_hi(A.w), bf_hi(D.w)); }
#undef RAT
            __builtin_amdgcn_sched_barrier(0); }
    }
    __device__ __forceinline__ void operator()(const f32x4 (&acc)[2][2][4][2], const pg8::Unit& u, int wr, int wc, int fr, int fq) const {
        const int row0 = u.pm * 256 + wr * 64 + fr, col0 = u.pn * 256 + wc * 32 + 8 * fq;
#pragma unroll
        for (int ai = 0; ai < 2; ++ai) {
            u32x4 gwv[4][2];
#pragma unroll
            for (int m = 0; m < 4; ++m)
#pragma unroll
                for (int bj = 0; bj < 2; ++bj) gwv[m][bj] = *(const u32x4*)(MG + (size_t)(row0 + ai * 128 + m * 16) * 6144 + 2 * 2048 + col0 + bj * 128);
#pragma unroll
            for (int m = 0; m < 4; ++m)
#pragma unroll
                for (int bj = 0; bj < 2; ++bj) { const size_t r = (size_t)(row0 + ai * 128 + m * 16); const int c = col0 + bj * 128; const u32x4 gw = gwv[m][bj];
                    f32x4 v0 = acc[ai][bj][m][0], v1 = acc[ai][bj][m][1];
                    v0[0] *= bf_lo(gw.x); v0[1] *= bf_hi(gw.x); v0[2] *= bf_lo(gw.y); v0[3] *= bf_hi(gw.y);
                    v1[0] *= bf_lo(gw.z); v1[1] *= bf_hi(gw.z); v1[2] *= bf_lo(gw.w); v1[3] *= bf_hi(gw.w);
                    u32x4 w; w.x = cvt_pk_bf16(v0[0], v0[1]); w.y = cvt_pk_bf16(v0[2], v0[3]); w.z = cvt_pk_bf16(v1[0], v1[1]); w.w = cvt_pk_bf16(v1[2], v1[3]); *(u32x4*)(YB + r * 2048 + c) = w; }
            __builtin_amdgcn_sched_barrier(0); }
    }
};
struct EpiOut {
    static constexpr bool PERM = false, HAS_MID = false; static constexpr int MID1 = -1, MID2 = -1;
    const float* X; float* O; const float* gate0  ; int bbase, S;
    __device__ __forceinline__ void operator()(const f32x4 (&acc)[2][2][4][2], const pg8::Unit& u, int wr, int wc, int fr, int fq) const {
        const int row0 = u.pm * 256 + wr * 64 + fr, col0 = u.pn * 256 + wc * 32 + 4 * fq;
        const float* gp = gate0 + (size_t)(bbase + (u.pm * 256) / S) * 6144 + col0;
        f32x4 gv[2][2];
#pragma unroll
        for (int bj = 0; bj < 2; ++bj)
#pragma unroll
            for (int n = 0; n < 2; ++n) gv[bj][n] = *(const f32x4*)(gp + bj * 128 + n * 16);
#pragma unroll
        for (int ai = 0; ai < 2; ++ai) {
            f32x4 xv[4][2][2];
#pragma unroll
            for (int m = 0; m < 4; ++m)
#pragma unroll
                for (int bj = 0; bj < 2; ++bj)
#pragma unroll
                    for (int n = 0; n < 2; ++n) xv[m][bj][n] = *(const f32x4*)(X + (size_t)(row0 + ai * 128 + m * 16) * 2048 + col0 + bj * 128 + n * 16);
#pragma unroll
            for (int m = 0; m < 4; ++m)
#pragma unroll
                for (int bj = 0; bj < 2; ++bj)
#pragma unroll
                    for (int n = 0; n < 2; ++n) *(f32x4*)(O + (size_t)(row0 + ai * 128 + m * 16) * 2048 + col0 + bj * 128 + n * 16) = xv[m][bj][n] + gv[bj][n] * acc[ai][bj][m][n];
            __builtin_amdgcn_sched_barrier(0); }
    }
};
namespace att {
constexpr int NW = 8, QBLK = 32, KVBLK = 64;
constexpr float THR = 8.f;
constexpr size_t SHM_V = KVBLK * 128 * 2;
#define KSWZ(row, colB) ((row) * 256 + ((colB) ^ (((row) & 15) << 4)))
#define KSWZ192(row, colB) ((row) * 384 + ((colB) ^ ((((row) >> 1) & 7) << 4)))
#define SBAR() __builtin_amdgcn_sched_barrier(0)
__device__ __forceinline__ int crow(int r, int hi) { return (r & 3) + 8 * (r >> 2) + 4 * hi; }
__device__ __forceinline__ unsigned cvtpk(float lo, float hi) { unsigned r; asm volatile("v_cvt_pk_bf16_f32 %0, %1, %2" : "=v"(r) : "v"(lo), "v"(hi)); return r; }
__device__ __forceinline__ bf16x8 ld8(const bf16_t* p) { return *reinterpret_cast<const bf16x8*>(p); }

template <bool WIN, int PRESC = 0> __device__ __forceinline__ void partialSM(f32x16& p0, f32x16& p1, float& m_reg, float& mn, float& alpha, const float C, const float* tl) {
  if constexpr (!WIN && (PRESC == 1 || PRESC == 2)) {
    alpha = 1.f; mn = 0.f;
#pragma unroll
    for (int r = 0; r < 16; ++r) p0[r] = __builtin_amdgcn_exp2f(p0[r]);
    return;
  }
  if constexpr (!WIN) {
    const float mneg = m_reg;
    alpha = 1.f; mn = 0.f; const float Cq = (PRESC == 3) ? 1.0f : C;
#pragma unroll
    for (int r = 0; r < 16; ++r) { p0[r] = __builtin_amdgcn_exp2f(fmaf(p0[r], Cq, mneg)); p1[r] = fmaf(p1[r], Cq, mneg); }
    return;
  }
  if constexpr (WIN) {
#pragma unroll
    for (int r = 0; r < 16; ++r) { p0[r] = fmaf(p0[r], C, tl[(r & 3) + 8 * (r >> 2)]); p1[r] = fmaf(p1[r], C, tl[32 + (r & 3) + 8 * (r >> 2)]); }
  }
  float pmax = p0[0];
#pragma unroll
  for (int r = 1; r < 16; ++r) pmax = fmaxf(pmax, p0[r]);
#pragma unroll
  for (int r = 0; r < 16; ++r) pmax = fmaxf(pmax, p1[r]);
  { auto rr = __builtin_amdgcn_permlane32_swap(__float_as_uint(pmax), __float_as_uint(pmax), false, false);
    pmax = fmaxf(__uint_as_float(rr[0]), __uint_as_float(rr[1])); }
  if constexpr (WIN) {
    if (__builtin_expect(__all(pmax - m_reg <= THR * 1.4426950408889634f), 1)) { mn = m_reg; alpha = 1.f; }
    else { mn = fmaxf(m_reg, pmax); alpha = __builtin_amdgcn_exp2f(m_reg - mn); m_reg = mn; }
#pragma unroll
    for (int r = 0; r < 16; ++r) { p0[r] -= mn; p1[r] -= mn; }
  } else {
    if (__builtin_expect(__all((pmax - m_reg) * C <= THR * 1.4426950408889634f), 1)) { mn = m_reg; alpha = 1.f; }
    else { mn = fmaxf(m_reg, pmax); alpha = __builtin_amdgcn_exp2f((m_reg - mn) * C); m_reg = mn; }
    const float mnC = -mn * C;
#pragma unroll
    for (int r = 0; r < 16; ++r) { p0[r] = fmaf(p0[r], C, mnC); p1[r] = fmaf(p1[r], C, mnC); }
  }
#pragma unroll
  for (int r = 0; r < 16; ++r) p0[r] = __builtin_amdgcn_exp2f(p0[r]);
}
__device__ __forceinline__ void finishSM(f32x16& p0, f32x16& p1, float alpha, float& l_reg, bf16x8& pa0, bf16x8& pa1, bf16x8& pa2, bf16x8& pa3) {
#pragma unroll
  for (int r = 0; r < 16; ++r) p1[r] = __builtin_amdgcn_exp2f(p1[r]);
  float ps = 0;
#pragma unroll
  for (int r = 0; r < 16; ++r) ps += p0[r];
#pragma unroll
  for (int r = 0; r < 16; ++r) ps += p1[r];
  { auto rr = __builtin_amdgcn_permlane32_swap(__float_as_uint(ps), __float_as_uint(ps), false, false);
    ps = __uint_as_float(rr[0]) + __uint_as_float(rr[1]); }
  l_reg = l_reg * alpha + ps;
#define PK4(P, BASE, OUT) do { unsigned a0 = cvtpk(P[BASE + 0], P[BASE + 1]), a1 = cvtpk(P[BASE + 2], P[BASE + 3]);   \
    unsigned b0 = cvtpk(P[BASE + 4], P[BASE + 5]), b1 = cvtpk(P[BASE + 6], P[BASE + 7]);                              \
    auto r0 = __builtin_amdgcn_permlane32_swap(a0, b0, false, false); auto r1 = __builtin_amdgcn_permlane32_swap(a1, b1, false, false); \
    u32x4 w = {r0[0], r1[0], r0[1], r1[1]}; OUT = *reinterpret_cast<bf16x8*>(&w); } while (0)
  PK4(p0, 0, pa0); PK4(p0, 8, pa1); PK4(p1, 0, pa2); PK4(p1, 8, pa3);
#undef PK4
}
template <int DK> __device__ __forceinline__ void qkt(f32x16& p0, f32x16& p1, const char* Ks, const bf16x8* qr, int r32, int hi, const float init = 0.f) {
#pragma unroll
  for (int r = 0; r < 16; ++r) { p0[r] = init; p1[r] = init; }
#pragma unroll
  for (int d0 = 0; d0 < DK / 16; ++d0) { const int cb = (d0 * 16 + hi * 8) * 2;
    const bf16x8 b0 = *reinterpret_cast<const bf16x8*>(Ks + (DK == 128 ? KSWZ(r32, cb) : KSWZ192(r32, cb)));
    const bf16x8 b1 = *reinterpret_cast<const bf16x8*>(Ks + (DK == 128 ? KSWZ(32 + r32, cb) : KSWZ192(32 + r32, cb)));
    p0 = __builtin_amdgcn_mfma_f32_32x32x16_bf16(b0, qr[d0], p0, 0, 0, 0);
    p1 = __builtin_amdgcn_mfma_f32_32x32x16_bf16(b1, qr[d0], p1, 0, 0, 0); }
}
__device__ __forceinline__ int v_st(int k, int c) { const int kk = (k & ~0xC) | ((k & 4) << 1) | ((k & 8) >> 1); return ((kk >> 3) * 4 + (c >> 5)) * 512 + ((kk & 7) * 32 + (c & 31)) * 2; }
__device__ __forceinline__ int v_rd_base(int lane) { return ((lane & 3) << 3) | (((lane >> 2) & 3) << 6) | (((lane >> 4) & 1) << 5) | (((lane >> 5) & 1) << 8); }
constexpr int v_rd_off(int d0, int ks, int half) { return d0 * 512 + ks * 4096 + half * 2048; }
template <int OFF> __device__ __forceinline__ s16x4 tr_read(int vb) {
  s16x4 r; asm volatile("ds_read_b64_tr_b16 %0, %1 offset:%2" : "=&v"(r) : "v"(vb), "i"(OFF) : "memory"); return r;
}
template <int D0> __device__ __forceinline__ void pv_one(f32x16& od, int vb, bf16x8 pa0, bf16x8 pa1, bf16x8 pa2, bf16x8 pa3) {
  const s16x4 l0 = tr_read<v_rd_off(D0, 0, 0)>(vb), h0 = tr_read<v_rd_off(D0, 0, 1)>(vb), l1 = tr_read<v_rd_off(D0, 1, 0)>(vb), h1 = tr_read<v_rd_off(D0, 1, 1)>(vb);
  const s16x4 l2 = tr_read<v_rd_off(D0, 2, 0)>(vb), h2 = tr_read<v_rd_off(D0, 2, 1)>(vb), l3 = tr_read<v_rd_off(D0, 3, 0)>(vb), h3 = tr_read<v_rd_off(D0, 3, 1)>(vb);
  asm volatile("s_waitcnt lgkmcnt(0)" ::: "memory"); SBAR();
#define PK(L, H) (bf16x8){L[0], L[1], L[2], L[3], H[0], H[1], H[2], H[3]}
  od = __builtin_amdgcn_mfma_f32_32x32x16_bf16(pa0, PK(l0, h0), od, 0, 0, 0);
  od = __builtin_amdgcn_mfma_f32_32x32x16_bf16(pa1, PK(l1, h1), od, 0, 0, 0);
  od = __builtin_amdgcn_mfma_f32_32x32x16_bf16(pa2, PK(l2, h2), od, 0, 0, 0);
  od = __builtin_amdgcn_mfma_f32_32x32x16_bf16(pa3, PK(l3, h3), od, 0, 0, 0);
#undef PK
}
__device__ __forceinline__ void pv_d0(f32x16* o, int vb, bf16x8 pa0, bf16x8 pa1, bf16x8 pa2, bf16x8 pa3) {
  pv_one<0>(o[0], vb, pa0, pa1, pa2, pa3); pv_one<1>(o[1], vb, pa0, pa1, pa2, pa3); pv_one<2>(o[2], vb, pa0, pa1, pa2, pa3); pv_one<3>(o[3], vb, pa0, pa1, pa2, pa3);
}
constexpr size_t lds_bytes(int DK) { return 2 * SHM_V + 2 * (size_t)KVBLK * DK * 2 + NW * 64 * 4 + 768 * 4; }

template <int DK, int SD, int LDQ, int LDK, int LDV, int LDO, bool WIN, int PRESC = 0>
__device__ __forceinline__ void attn_unit(const bf16_t* __restrict__ Qb, const bf16_t* __restrict__ Kh, const bf16_t* __restrict__ Vh, bf16_t* __restrict__ Ob,
                                          const int NT, const float m_init, const float l_init, const float* __restrict__ tbg, const int tb0, char* lds) {
  constexpr int ND = DK / 16;
  constexpr size_t SHM_K = (size_t)KVBLK * DK * 2;
  constexpr float SCALE = (DK == 128) ? 0.088388347648318440f : 0.072168783648703220f;
  constexpr float C = SCALE * 1.4426950408889634f;
  int tid_ = threadIdx.x; asm volatile("" : "+v"(tid_));
  const int tid = tid_, wid = tid >> 6, lane = tid & 63, r32 = lane & 31, hi = lane >> 5;
  char* V_lds = lds; char* K_lds = lds + 2 * SHM_V;
  float* ws = (float*)(lds + 2 * SHM_V + 2 * SHM_K) + wid * 64; float* li_l = ws; float* al_l = ws + 32;
  float* tbl = (float*)(lds + 2 * SHM_V + 2 * SHM_K + NW * 64 * 4);
  const float* tlw = tbl + (tb0 - wid * 32 - r32 + 4 * hi);
  float m_reg = m_init, l_reg = l_init; f32x16 o[4] = {}; bf16x8 qr[ND];
  const bf16_t* Qw = Qb + (long)(wid * QBLK + r32) * LDQ + hi * 8;
#pragma unroll
  for (int d0 = 0; d0 < ND; ++d0) qr[d0] = ld8(Qw + d0 * 16);
  const int sr = tid >> 4, sc = (tid & 15) * 8, vst0 = v_st(sr, sc), vst1 = v_st(32 + sr, sc);
  const int kr0 = tid >> 3, kc0 = tid & 7;
  const int vb0 = (int)(uintptr_t)V_lds + v_rd_base(lane);
  struct Slot { bf16x8 vs0, vs1, ks0, ks1, ks2; } sr_[SD];
#define SLOAD(i, k0) do { sr_[i].vs0 = ld8(&Vh[(long)((k0) + sr) * LDV + sc]); sr_[i].vs1 = ld8(&Vh[(long)((k0) + 32 + sr) * LDV + sc]); \
    if constexpr (DK == 128) { sr_[i].ks0 = ld8(&Kh[(long)((k0) + sr) * LDK + sc]); sr_[i].ks1 = ld8(&Kh[(long)((k0) + 32 + sr) * LDK + sc]); } \
    else { const bf16_t* kp_ = &Kh[(long)((k0) + kr0) * LDK + kc0 * 8]; sr_[i].ks0 = ld8(kp_); sr_[i].ks1 = ld8(kp_ + 64); sr_[i].ks2 = ld8(kp_ + 128); } } while (0)
#define SWRITE(b, i) do { *(bf16x8*)(V_lds + (b) * SHM_V + vst0) = sr_[i].vs0; *(bf16x8*)(V_lds + (b) * SHM_V + vst1) = sr_[i].vs1; \
    if constexpr (DK == 128) { const int kc = sc * 2; *(bf16x8*)(K_lds + (b) * SHM_K + KSWZ(sr, kc)) = sr_[i].ks0; *(bf16x8*)(K_lds + (b) * SHM_K + KSWZ(32 + sr, kc)) = sr_[i].ks1; } \
    else { char* kw_ = K_lds + (b) * SHM_K + KSWZ192(kr0, kc0 * 16); *(bf16x8*)kw_ = sr_[i].ks0; *(bf16x8*)(kw_ + 128) = sr_[i].ks1; *(bf16x8*)(kw_ + 256) = sr_[i].ks2; } } while (0)
#define SWAIT() do { if constexpr (SD == 2) { if constexpr (DK == 128) asm volatile("s_waitcnt vmcnt(4)" ::: "memory"); else asm volatile("s_waitcnt vmcnt(5)" ::: "memory"); } \
    else asm volatile("s_waitcnt vmcnt(0)" ::: "memory"); } while (0)
#define RESC(a) do { if constexpr (WIN) if (__any((a) < 1.f)) { if (hi == 0) al_l[r32] = (a); asm volatile("s_waitcnt lgkmcnt(0)" ::: "memory"); \
    _Pragma("unroll") for (int d = 0; d < 4; ++d) _Pragma("unroll") for (int r = 0; r < 16; ++r) o[d][r] *= al_l[crow(r, hi)]; } } while (0)
  f32x16 pA0, pA1, pB0, pB1; float mnA, mnB, alA, alB; bf16x8 pa0, pa1, pa2, pa3;
  constexpr int SE = 0, SO = SD - 1;
  SLOAD(SE, 0);
  __syncthreads();
  if constexpr (WIN) { for (int i = tid; i < 768; i += 512) tbl[i] = tbg[i]; }
  asm volatile("s_waitcnt vmcnt(0)" ::: "memory"); SWRITE(0, SE); __syncthreads();
  qkt<DK>(pA0, pA1, K_lds, qr, r32, hi, (PRESC == 1) ? m_init : 0.f); partialSM<WIN, PRESC>(pA0, pA1, m_reg, mnA, alA, C, tlw);
  SLOAD(SO, KVBLK); if constexpr (SD == 2) { if (2 < NT) SLOAD(SE, 2 * KVBLK); }
  SWAIT(); SWRITE(1, SO); __syncthreads();
  for (int j = 1; j + 1 < NT; j += 2) {
    SBAR(); qkt<DK>(pB0, pB1, K_lds + SHM_K, qr, r32, hi, (PRESC == 1) ? m_init : 0.f);
    finishSM(pA0, pA1, alA, l_reg, pa0, pa1, pa2, pa3); SBAR();
    SLOAD(SO, (j + SD) * KVBLK); SBAR();
    pv_d0(o, vb0, pa0, pa1, pa2, pa3); partialSM<WIN, PRESC>(pB0, pB1, m_reg, mnB, alB, C, tlw + 64 * j);
    __syncthreads(); SWAIT(); SWRITE(0, SE);
    RESC(alB); __syncthreads();
    SBAR(); qkt<DK>(pA0, pA1, K_lds, qr, r32, hi, (PRESC == 1) ? m_init : 0.f);
    finishSM(pB0, pB1, alB, l_reg, pa0, pa1, pa2, pa3); SBAR();
    if (SD == 1 || j + 3 < NT) SLOAD(SE, (j + 1 + SD) * KVBLK); SBAR();
    pv_d0(o, vb0 + (int)SHM_V, pa0, pa1, pa2, pa3); partialSM<WIN, PRESC>(pA0, pA1, m_reg, mnA, alA, C, tlw + 64 * (j + 1));
    __syncthreads(); SWAIT(); SWRITE(1, SO);
    RESC(alA); __syncthreads();
  }
  SBAR(); qkt<DK>(pB0, pB1, K_lds + SHM_K, qr, r32, hi, (PRESC == 1) ? m_init : 0.f);
  finishSM(pA0, pA1, alA, l_reg, pa0, pa1, pa2, pa3); SBAR();
  pv_d0(o, vb0, pa0, pa1, pa2, pa3); partialSM<WIN, PRESC>(pB0, pB1, m_reg, mnB, alB, C, tlw + 64 * (NT - 1));
  __syncthreads(); RESC(alB);
  finishSM(pB0, pB1, alB, l_reg, pa0, pa1, pa2, pa3); SBAR();
  pv_d0(o, vb0 + (int)SHM_V, pa0, pa1, pa2, pa3);
  if (hi == 0) li_l[r32] = l_reg; asm volatile("s_waitcnt lgkmcnt(0)" ::: "memory");
  __syncthreads();
  const int widu = __builtin_amdgcn_readfirstlane(wid);
  bf16_t* stg = (bf16_t*)(lds + widu * 8192);
#pragma unroll
  for (int r = 0; r < 16; ++r) { const int orow = crow(r, hi); const float rl = __builtin_amdgcn_rcpf(li_l[orow]);
#pragma unroll
    for (int d0 = 0; d0 < 4; ++d0) stg[orow * 128 + d0 * 32 + r32] = f2bf(o[d0][r] * rl); }
  asm volatile("s_waitcnt lgkmcnt(0)" ::: "memory");
  bf16_t* Og = Ob + (long)(widu * QBLK) * LDO;
#pragma unroll
  for (int ib = 0; ib < 8; ib += 4) {
    u32x4 gv[4];
#pragma unroll
    for (int i = 0; i < 4; ++i) { const int q = (ib + i) * 64 + lane; gv[i] = *(const u32x4*)(Og + (long)(q >> 4) * LDO + (q & 15) * 8); }
#pragma unroll
    for (int i = 0; i < 4; ++i) { const int q = (ib + i) * 64 + lane; const u32x4 ov = *(const u32x4*)(stg + (q >> 4) * 128 + (q & 15) * 8); const u32x4 g = gv[i]; u32x4 w;
      w.x = cvtpk(bf_lo(ov.x) * bf_lo(g.x), bf_hi(ov.x) * bf_hi(g.x)); w.y = cvtpk(bf_lo(ov.y) * bf_lo(g.y), bf_hi(ov.y) * bf_hi(g.y));
      w.z = cvtpk(bf_lo(ov.z) * bf_lo(g.z), bf_hi(ov.z) * bf_hi(g.z)); w.w = cvtpk(bf_lo(ov.w) * bf_lo(g.w), bf_hi(ov.w) * bf_hi(g.w));
      *(u32x4*)(Og + (long)(q >> 4) * LDO + (q & 15) * 8) = w; }
  }
#undef SLOAD
#undef SWRITE
#undef SWAIT
#undef RESC
}
}
constexpr int DM = 2048, DEPTH = 4, NPASS = 2, TPMAX = 32768, NIN = 13120, NINP = 13312, NWAVES = 8;
constexpr int T_PROMPT = 32768, T_SAMPLE = 16384;
constexpr float RMS_EPS = 1e-6f;
constexpr int KS_ADA = 32;
constexpr int NSTEP_PRO = 2, NSTEP_IT = 8, NSTEPS = NSTEP_PRO + DEPTH * NPASS * NSTEP_IT;
constexpr size_t MiB = 1u << 20;
constexpr size_t WS_CTL = 0, CTL_ZERO_BYTES = 1 * MiB;
constexpr size_t WS_PTRS = 512 * 1024;
constexpr size_t WS_MOD = 1 * MiB;
constexpr size_t WS_ROPE = 3 * MiB;
constexpr size_t WS_TB = 4 * MiB;
constexpr size_t WS_MODP = 5 * MiB;
constexpr size_t WS_RS = 54 * MiB;
constexpr size_t WS_WIN_T = 64 * MiB;
constexpr size_t WS_WQ_T = 55 * MiB;
constexpr size_t WS_WKV_T = 278 * MiB;
constexpr size_t WS_WBR_T = 282 * MiB;
constexpr size_t WS_WOUT_T = 330 * MiB;
constexpr size_t WS_H = 362 * MiB;
constexpr size_t WS_CQKV = 490 * MiB;
constexpr size_t WS_QM = 554 * MiB;
constexpr size_t WS_KF = 650 * MiB;
constexpr size_t WS_VM = 746 * MiB;
constexpr size_t WS_AX = 810 * MiB;
constexpr size_t WS_WINB = 906 * MiB;
constexpr size_t WS_G = 1002 * MiB;
constexpr size_t WS_MG = 1194 * MiB;
constexpr size_t WS_END = 1578 * MiB;
static_assert(WS_WIN_T + (size_t)4 * NINP * DM * 2 <= WS_WKV_T - 6 * MiB && WS_RS + (size_t)TPMAX * 16 <= WS_WQ_T && WS_WQ_T + (size_t)4 * 2048 * 512 * 2 <= WS_WIN_T && WS_MODP + (size_t)KS_ADA * 4 * 16 * 6144 * 4 <= WS_WIN_T && WS_MG + (size_t)TPMAX * 6144 * 2 <= WS_END && WS_H + (size_t)TPMAX * 2048 * 2 <= WS_CQKV, "d_ws map");
constexpr int RING_OFF = 0, RING_BYTES = 131072;
constexpr int LDSCTL_OFF = RING_BYTES;
constexpr int LDS_BYTES = 147456;
static_assert(att::lds_bytes(192) <= RING_BYTES, "attention LDS");

#define LDS_WAIT() asm volatile("s_waitcnt lgkmcnt(0)" ::: "memory")
#define VM_WAIT() asm volatile("s_waitcnt vmcnt(0)" ::: "memory")

#define XB_TMO      128
#define XB_XCNT(j)  (256  + 64 * (j))
#define XB_XSUB(j)  (1280 + 64 * (j))
#define XB_XGEN(j)  (2304 + 64 * (j))
#define XB_TOP      3328
#define XB_TOPGEN   3392
#define XCD_BAR_WORDS 3456
#define XB_SPIN_CAP (1u << 22)

__device__ __forceinline__ unsigned xb_ld(unsigned* p)              { return __hip_atomic_load(p, __ATOMIC_RELAXED, __HIP_MEMORY_SCOPE_AGENT); }
__device__ __forceinline__ unsigned xb_add(unsigned* p, unsigned v) { return __hip_atomic_fetch_add(p, v, __ATOMIC_RELAXED, __HIP_MEMORY_SCOPE_AGENT); }
__device__ __forceinline__ unsigned xb_xcc_id() { return (unsigned)__builtin_amdgcn_s_getreg((3 << 11) | 20) & 0xFu; }
#define XB_SPIN(cond, bar) do { unsigned _sp = 0; while (cond) { __builtin_amdgcn_s_sleep(1); \
    if ((++_sp & 255u) == 0u) { if (xb_ld(&(bar)[XB_TMO])) break; if (_sp > XB_SPIN_CAP) { atomicAdd(&(bar)[XB_TMO], 1u); break; } } } } while (0)

struct XcdBarrier {
    unsigned* bar; unsigned x;
    volatile LAS unsigned* st;
};
__device__ __forceinline__ XcdBarrier xcd_barrier_post(unsigned* bar, volatile LAS unsigned* st) {
    XcdBarrier b; b.bar = bar; b.x = xb_xcc_id(); b.st = st;
    if (threadIdx.x == 0) (void)xb_add(&bar[XB_XCNT(b.x)], 1u);
    return b;
}
__device__ __forceinline__ void xcd_barrier_complete(unsigned* bar, unsigned x, unsigned& nloc, unsigned& nx) {
    const unsigned G = gridDim.x * gridDim.y * gridDim.z;
    unsigned sum, cnt, mine, sp = 0u;
    for (;;) {
        sum = 0u; cnt = 0u; mine = 0u;
#pragma unroll
        for (unsigned j = 0; j < 16; ++j) { const unsigned c = xb_ld(&bar[XB_XCNT(j)]); sum += c; cnt += (c > 0u) ? 1u : 0u; }
        mine = xb_ld(&bar[XB_XCNT(x)]);
        if (sum == G) break;
        __builtin_amdgcn_s_sleep(1);
        if ((++sp & 255u) == 0u) { if (xb_ld(&bar[XB_TMO])) break; if (sp > XB_SPIN_CAP) { atomicAdd(&bar[XB_TMO], 1u); break; } }
    }
    nloc = mine > 0u ? mine : 1u; nx = cnt > 0u ? cnt : 1u;
}
__device__ __forceinline__ void xcd_barrier(const XcdBarrier& b) {
    asm volatile("s_waitcnt vmcnt(0)" ::: "memory");
    __syncthreads();
    if (threadIdx.x == 0) {
        unsigned* bar = b.bar;
        __builtin_amdgcn_s_waitcnt(0);
        unsigned nloc = b.st[0], nx = b.st[1];
        if (nloc == 0u) { xcd_barrier_complete(bar, b.x, nloc, nx); b.st[0] = nloc; b.st[1] = nx; }
        const unsigned old = xb_add(&bar[XB_XSUB(b.x)], 1u);
        const unsigned gen = old / nloc;
        if (old + 1u == (gen + 1u) * nloc) {
            __builtin_amdgcn_fence(__ATOMIC_RELEASE, "agent");
            asm volatile("s_waitcnt vmcnt(0)" ::: "memory");
            const unsigned og = xb_add(&bar[XB_TOP], 1u);
            const unsigned tg = og / nx;
            if (og + 1u == (tg + 1u) * nx) xb_add(&bar[XB_TOPGEN], 1u);
            else XB_SPIN(xb_ld(&bar[XB_TOPGEN]) == tg, bar);
            __builtin_amdgcn_fence(__ATOMIC_ACQUIRE, "agent");
            xb_add(&bar[XB_XGEN(b.x)], 1u);
            asm volatile("s_waitcnt vmcnt(0)" ::: "memory");
        } else {
            XB_SPIN(xb_ld(&bar[XB_XGEN(b.x)]) == gen, bar);
            __builtin_amdgcn_fence(__ATOMIC_ACQUIRE, "agent");
            asm volatile("s_waitcnt vmcnt(0)" ::: "memory");
        }
    }
    __syncthreads();
}

template <int CTRL> __device__ __forceinline__ float dpp_f(float v) { return __builtin_bit_cast(float, __builtin_amdgcn_update_dpp(0, __builtin_bit_cast(int, v), CTRL, 0xf, 0xf, true)); }
__device__ __forceinline__ float sum16(float v) {
    v += dpp_f<0xB1>(v); v += dpp_f<0x4E>(v); v += dpp_f<0x141>(v); v += dpp_f<0x140>(v); return v;
}
__device__ __forceinline__ float wave_sum(float v) {
    v = sum16(v);
    const int b = __builtin_bit_cast(int, v);
    return (__builtin_bit_cast(float, __builtin_amdgcn_readlane(b, 0)) + __builtin_bit_cast(float, __builtin_amdgcn_readlane(b, 16)))
         + (__builtin_bit_cast(float, __builtin_amdgcn_readlane(b, 32)) + __builtin_bit_cast(float, __builtin_amdgcn_readlane(b, 48)));
}
__device__ __forceinline__ float wave_maxabs(const float* g, int n, int lane) {
    float v = 0.f;
    for (int i = lane; i < n; i += 64) v = fmaxf(v, fabsf(g[i]));
    v = fmaxf(v, dpp_f<0xB1>(v)); v = fmaxf(v, dpp_f<0x4E>(v)); v = fmaxf(v, dpp_f<0x141>(v)); v = fmaxf(v, dpp_f<0x140>(v));
    const int b = __builtin_bit_cast(int, v);
    return fmaxf(fmaxf(__builtin_bit_cast(float, __builtin_amdgcn_readlane(b, 0)), __builtin_bit_cast(float, __builtin_amdgcn_readlane(b, 16))),
                 fmaxf(__builtin_bit_cast(float, __builtin_amdgcn_readlane(b, 32)), __builtin_bit_cast(float, __builtin_amdgcn_readlane(b, 48))));
}
__device__ __forceinline__ void tr_item(const float* W, int N, int k0, int n0, bf16_t* dst, int ldd, LAS float* scr, int lane, int perm = -1, const float* gk = nullptr) {
#pragma unroll 8
    for (int i = 0; i < 32; ++i) { const int kk = 2 * i + (lane >> 5); scr[kk * 33 + (lane & 31)] = W[(size_t)(k0 + kk) * N + n0 + (lane & 31)] * (gk ? gk[k0 + kk] : 1.0f); }
    LDS_WAIT(); asm volatile("" ::: "memory");
    const int c = lane & 7;
#pragma unroll
    for (int j = 0; j < 4; ++j) { const int ns = (lane >> 3) + 8 * j, n = perm < 0 ? ns : 8 * (ns >> 2) + (ns & 3) + perm; const LAS float* s = scr + (8 * c) * 33 + ns;
        u32x4 o; o.x = cvt_pk_bf16(s[0 * 33], s[1 * 33]); o.y = cvt_pk_bf16(s[2 * 33], s[3 * 33]); o.z = cvt_pk_bf16(s[4 * 33], s[5 * 33]); o.w = cvt_pk_bf16(s[6 * 33], s[7 * 33]);
        *(u32x4*)(dst + (size_t)n * ldd + 8 * c) = o; }
    LDS_WAIT(); asm volatile("" ::: "memory");
}
__device__ __forceinline__ void sincos_acc(float ang, float& co, float& si) {
    const double a = (double)ang; const double k = __builtin_rint(a * 0.63661977236758134308);
    const double r = (a - k * 1.5707963267948966192) - k * 6.123233995736766e-17, r2 = r * r;
    const double s = r * (1.0 + r2 * (-1.0 / 6 + r2 * (1.0 / 120 + r2 * (-1.0 / 5040 + r2 * (1.0 / 362880 + r2 * (-1.0 / 39916800 + r2 * (1.0 / 6227020800.0)))))));
    const double c = 1.0 + r2 * (-0.5 + r2 * (1.0 / 24 + r2 * (-1.0 / 720 + r2 * (1.0 / 40320 + r2 * (-1.0 / 3628800 + r2 * (1.0 / 479001600.0 + r2 * (-1.0 / 87178291200.0)))))));
    const int q = (int)(long long)k & 3;
    const double cc = (q == 0) ? c : (q == 1) ? -s : (q == 2) ? -c : s;
    const double ss = (q == 0) ? s : (q == 1) ? c : (q == 2) ? -s : -c;
    co = (float)cc; si = (float)ss;
}
__device__ const float ROPE_FREQ[32] = {1.f, 0.749894261f, 0.562341332f, 0.421696514f, 0.316227764f, 0.237137377f, 0.177827939f, 0.133352131f, 0.100000001f, 0.0749894157f, 0.0562341325f,
    0.0421696529f, 0.0316227749f, 0.0237137377f, 0.0177827943f, 0.0133352149f, 0.00999999978f, 0.00749894185f, 0.00562341325f, 0.00421696482f, 0.00316227763f, 0.00237137359f, 0.00177827943f,
    0.00133352145f, 0.00100000005f, 0.000749894243f, 0.000562341302f, 0.000421696517f, 0.000316227757f, 0.00023713737f, 0.00017782794f, 0.00013335215f};

struct Frame {
    LAS unsigned char* lds; unsigned char* ws;
    int tid, lane, wave, vcu, G;
    const float* const* in;
};
__device__ __forceinline__ void step_prologue(const float* const (&in)[24], unsigned char* ws, LAS unsigned char* lds, int tid, int lane, int wave, int vcu, int G) {
    LAS float* scr = (LAS float*)(lds + RING_OFF + wave * 16384);
    const int gw = vcu * NWAVES + wave, NGW = G * NWAVES;
    const int gt = (vcu * NWAVES + wave) * 64 + lane, NT = G * NWAVES * 64;
    bf16_t* WIN_T = (bf16_t*)(ws + WS_WIN_T); bf16_t* WQ_T = (bf16_t*)(ws + WS_WQ_T); bf16_t* WKV_T = (bf16_t*)(ws + WS_WKV_T);
    bf16_t* WBR_T = (bf16_t*)(ws + WS_WBR_T); bf16_t* WOUT_T = (bf16_t*)(ws + WS_WOUT_T);
    {
        const float* cP = in[2]; const float* cS = in[3]; const float* w_ada = in[5]; float* modp = (float*)(ws + WS_MODP);
        for (int u = gw; u < DEPTH * 48 * KS_ADA; u += NGW) {
            const int ks = u % KS_ADA, cc = (u / KS_ADA) % 48, l = u / (KS_ADA * 48);
#pragma unroll 1
            for (int b = 0; b < 16; ++b) scr[b * 64 + lane] = (b < 8 ? cP + (size_t)b * DM : cS + (size_t)(b - 8) * DM)[ks * 64 + lane];
            LDS_WAIT(); asm volatile("" ::: "memory");
            f32x2 acc[16];
#pragma unroll
            for (int b = 0; b < 16; ++b) acc[b] = (f32x2){0.f, 0.f};
            const float* wp = w_ada + ((size_t)l * DM + ks * 64) * 6144 + cc * 128 + lane * 2;
#pragma unroll 1
            for (int k4 = 0; k4 < 16; ++k4) {
                f32x2 w[4];
#pragma unroll
                for (int q = 0; q < 4; ++q) w[q] = *(const f32x2*)(wp + (size_t)(k4 * 4 + q) * 6144);
#pragma unroll
                for (int b = 0; b < 16; ++b) { const f32x4 cv = *(const LAS f32x4*)(scr + b * 64 + k4 * 4);
                    acc[b] += w[0] * cv[0]; acc[b] += w[1] * cv[1]; acc[b] += w[2] * cv[2]; acc[b] += w[3] * cv[3]; }
            }
#pragma unroll
            for (int b = 0; b < 16; ++b) *(f32x2*)(modp + ((size_t)(ks * DEPTH + l) * 16 + b) * 6144 + cc * 128 + lane * 2) = acc[b];
            LDS_WAIT(); asm volatile("" ::: "memory");
        }
    }
    {
        constexpr int I_IN = (DM / 64) * (NIN / 32), I_Q = (512 / 64) * (1536 / 32), I_KV = (256 / 64) * (2048 / 32), I_BR = (1024 / 64) * (2048 / 32), I_OUT = (DM / 64) * (DM / 32);
        constexpr int I_L = I_IN + I_Q + I_KV + 3 * I_BR + I_OUT;
        for (int it = gw; it < DEPTH * I_L; it += NGW) {
            const int l = it / I_L; int r = it % I_L;
            if (r < I_IN) { const int nblk = NIN / 32, kb = r / nblk, nb = r % nblk, n0 = nb * 32; int dn = n0 + (n0 >= 832 ? 192 : 0), perm = -1;
                if (dn >= 2048 && dn < 2048 + 1280) { perm = (dn & 32) ? 4 : 0; dn &= ~63; }
                tr_item(in[7] + (size_t)l * DM * NIN, NIN, kb * 64, n0, WIN_T + ((size_t)l * NINP + dn) * DM + kb * 64, DM, scr, lane, perm); continue; }
            r -= I_IN;
            if (r < I_Q) { const int nblk = 1536 / 32, kb = r / nblk, nb = r % nblk, n0 = nb * 32, hq = n0 / 192, d0 = n0 % 192;
                const int dn = hq * 256 + (d0 < 128 ? d0 : 128), perm = d0 < 128 ? -1 : (d0 == 128 ? 0 : 4);
                tr_item(in[9] + (size_t)l * 512 * 1536, 1536, kb * 64, n0, WQ_T + ((size_t)l * 2048 + dn) * 512 + kb * 64, 512, scr, lane, perm, in[8] + (size_t)l * 512); continue; }
            r -= I_Q;
            if (r < I_KV) { const int nblk = 2048 / 32, kb = r / nblk, nb = r % nblk, n0 = nb * 32, hh = n0 >> 8, wi = n0 & 255, dn = wi < 128 ? hh * 128 + wi : 1024 + hh * 128 + (wi - 128);
                tr_item(in[11] + (size_t)l * 256 * 2048, 2048, kb * 64, n0, WKV_T + ((size_t)l * 2048 + dn) * 256 + kb * 64, 256, scr, lane, -1, in[10] + (size_t)l * 256); continue; }
            r -= I_KV;
            if (r < 3 * I_BR) { const int br = r / I_BR, rr = r % I_BR, nblk = 2048 / 32, kb = rr / nblk, nb = rr % nblk;
                const float* src = (br == 0 ? in[20] : br == 1 ? in[21] : in[22]) + (size_t)l * 1024 * 2048;
                tr_item(src, 2048, kb * 64, nb * 32, WBR_T + ((size_t)l * 2048 + nb * 32) * 3072 + br * 1024 + kb * 64, 3072, scr, lane); continue; }
            r -= 3 * I_BR;
            { const int nblk = DM / 32, kb = r / nblk, nb = r % nblk;
                tr_item(in[23] + (size_t)l * DM * DM, DM, kb * 64, nb * 32, WOUT_T + ((size_t)l * DM + nb * 32) * DM + kb * 64, DM, scr, lane); }
        }
    }
    for (int e = gt; e < DEPTH * 192 * (DM / 8); e += NT) { const int l = e / (192 * (DM / 8)), r = e % (192 * (DM / 8));
        *(u32x4*)(WIN_T + ((size_t)l * NINP + 832) * DM + (size_t)r * 8) = (u32x4){0u, 0u, 0u, 0u}; }
    for (int e = gt; e < DEPTH * 8 * 64 * (512 / 8); e += NT) { const int hh = e / (64 * 64), r = e % (64 * 64);
        *(u32x4*)(WQ_T + ((size_t)hh * 256 + 192) * 512 + (size_t)r * 8) = (u32x4){0u, 0u, 0u, 0u}; }
    { f32x2* rope = (f32x2*)(ws + WS_ROPE);
      for (int e = gt; e < 4096 * 32; e += NT) { const float ang = (float)(e >> 5) * ROPE_FREQ[e & 31]; float c, s; sincos_acc(ang, c, s); rope[e] = (f32x2){c, s}; } }
    { float* tb = (float*)(ws + WS_TB); const float* rel_bias = in[19];
      for (int e = gt; e < 8 * 768; e += NT) { const int h = e / 768, rel = (e % 768) - 383, n = rel < 0 ? -rel : rel; float v = -1e30f;
          if (n <= 128) { int bk = rel > 0 ? 16 : 0;
              if (n < 8) bk += n; else bk += 8 + (n >= 12) + (n >= 16) + (n >= 23) + (n >= 32) + (n >= 46) + (n >= 64) + (n >= 91);
              v = rel_bias[bk * 8 + h] * 1.4426950408889634f; }
          tb[e] = v; } }
}
__device__ __forceinline__ void step_modreduce(const float* b_ada, unsigned char* ws, int gt, int NT) {
    const float* modp = (const float*)(ws + WS_MODP); float* mod = (float*)(ws + WS_MOD);
    for (int e = gt; e < DEPTH * 16 * 6144; e += NT) { const int l = e / (16 * 6144), j = e % 6144; float s = b_ada[l * 6144 + j];
#pragma unroll 8
        for (int ks = 0; ks < KS_ADA; ++ks) s += modp[(size_t)ks * (DEPTH * 16 * 6144) + e];
        mod[e] = s; }
}
__device__ __forceinline__ void step_norm(const float* x, bf16_t* H, const float* ln_g, const float* mod_l, int bbase, int S, int TP, int gw, int NGW, int lane) {
    for (int ch = gw; ch < TP / 8; ch += NGW) {
        const float* mb = mod_l + (size_t)(bbase + (ch * 8) / S) * 6144;
        f32x4 gs[8], sh[8];
#pragma unroll
        for (int j = 0; j < 8; ++j) { const int c = (64 * j + lane) * 4; const f32x4 g = *(const f32x4*)(ln_g + c), sc = *(const f32x4*)(mb + 2048 + c); gs[j] = g * (sc + 1.0f); sh[j] = *(const f32x4*)(mb + c); }
        for (int rr = 0; rr < 8; rr += 2) { const size_t row = (size_t)ch * 8 + rr;
            const f32x4* xr = (const f32x4*)(x + row * DM) + lane; f32x4 v[8], w[8]; float ss = 0.f, st = 0.f;
#pragma unroll
            for (int j = 0; j < 8; ++j) { v[j] = xr[64 * j]; w[j] = xr[64 * j + DM / 4]; }
#pragma unroll
            for (int j = 0; j < 8; ++j) { ss += (v[j].x * v[j].x + v[j].y * v[j].y) + (v[j].z * v[j].z + v[j].w * v[j].w); st += (w[j].x * w[j].x + w[j].y * w[j].y) + (w[j].z * w[j].z + w[j].w * w[j].w); }
            const float rstd = 1.0f / sqrtf(wave_sum(ss) * (1.0f / DM) + RMS_EPS), rstt = 1.0f / sqrtf(wave_sum(st) * (1.0f / DM) + RMS_EPS);
            u32x2* o8 = (u32x2*)(H + row * DM) + lane;
#pragma unroll
            for (int j = 0; j < 8; ++j) { const f32x4 y = v[j] * rstd * gs[j] + sh[j], z = w[j] * rstt * gs[j] + sh[j];
                o8[64 * j] = (u32x2){cvt_pk_bf16(y.x, y.y), cvt_pk_bf16(y.z, y.w)}; o8[64 * j + DM / 4] = (u32x2){cvt_pk_bf16(z.x, z.y), cvt_pk_bf16(z.z, z.w)}; }
        }
    }
}
__device__ __forceinline__ void head128_load(const bf16_t* base, int j, unsigned (&w)[4]) {
#pragma unroll
    for (int q = 0; q < 4; ++q) w[q] = *(const unsigned*)(base + 32 * q + 2 * j);
}
__device__ __forceinline__ void head128_finish(bf16_t* base, const unsigned (&w)[4], const float* gain, bool do_rope, const f32x4 ca, const f32x4 cb, int j, const float oscale) {
    float v[8];
#pragma unroll
    for (int q = 0; q < 4; ++q) { v[2 * q] = bf_lo(w[q]); v[2 * q + 1] = bf_hi(w[q]); }
    float ss = 0.f;
#pragma unroll
    for (int e = 0; e < 8; ++e) ss += v[e] * v[e];
    const float rstd = oscale / sqrtf(sum16(ss) * (1.0f / 128) + RMS_EPS);
#pragma unroll
    for (int q = 0; q < 4; ++q) { const f32x2 g = *(const f32x2*)(gain + 32 * q + 2 * j); v[2 * q] *= rstd * g.x; v[2 * q + 1] *= rstd * g.y; }
    if (do_rope) {
        const float a0 = v[0], a1 = v[1], a2 = v[2], a3 = v[3], b0 = v[4], b1 = v[5], b2 = v[6], b3 = v[7];
        v[0] = a0 * ca.x - a2 * ca.y; v[1] = a1 * ca.z - a3 * ca.w; v[2] = a2 * ca.x + a0 * ca.y; v[3] = a3 * ca.z + a1 * ca.w;
        v[4] = b0 * cb.x - b2 * cb.y; v[5] = b1 * cb.z - b3 * cb.w; v[6] = b2 * cb.x + b0 * cb.y; v[7] = b3 * cb.z + b1 * cb.w;
    }
#pragma unroll
    for (int q = 0; q < 4; ++q) *(unsigned*)(base + 32 * q + 2 * j) = cvt_pk_bf16(v[2 * q], v[2 * q + 1]);
}
struct P1Row { u32x4 wq; u32x2 wk; };
__device__ __forceinline__ void p1_load(P1Row& R, const bf16_t* CQKV, const bf16_t* AXb, const bf16_t* WINb, const f32x2* rope, size_t row, int s, int lane) {
    const int j = lane & 15, grp = lane >> 4;
    R.wq = *(const u32x4*)(CQKV + row * 1024 + lane * 8); R.wk = *(const u32x2*)(CQKV + row * 1024 + 512 + lane * 4);
}
__device__ __forceinline__ void p1_finish(const P1Row& R, bf16_t* CQKV, bf16_t* AXb, bf16_t* WINb, const float* q_a_norm, const float* kv_a_norm, const float* ax_qn, const float* ax_kn,
                                          const float* win_qn, const float* win_kn, size_t row, int lane) {
    const int j = lane & 15, grp = lane >> 4;
    { float v[8] = {bf_lo(R.wq.x), bf_hi(R.wq.x), bf_lo(R.wq.y), bf_hi(R.wq.y), bf_lo(R.wq.z), bf_hi(R.wq.z), bf_lo(R.wq.w), bf_hi(R.wq.w)};
      float ss = 0.f;
#pragma unroll
      for (int e = 0; e < 8; ++e) ss += v[e] * v[e];
      const float rstd = 1.0f / sqrtf(wave_sum(ss) * (1.0f / 512) + RMS_EPS);
      const f32x4 g0 = *(const f32x4*)(q_a_norm + lane * 8), g1 = *(const f32x4*)(q_a_norm + lane * 8 + 4);
      u32x4 o; o.x = cvt_pk_bf16(v[0] * rstd * g0.x, v[1] * rstd * g0.y); o.y = cvt_pk_bf16(v[2] * rstd * g0.z, v[3] * rstd * g0.w);
      o.z = cvt_pk_bf16(v[4] * rstd * g1.x, v[5] * rstd * g1.y); o.w = cvt_pk_bf16(v[6] * rstd * g1.z, v[7] * rstd * g1.w); *(u32x4*)(CQKV + row * 1024 + lane * 8) = o; }
    { float v[4] = {bf_lo(R.wk.x), bf_hi(R.wk.x), bf_lo(R.wk.y), bf_hi(R.wk.y)};
      const float ss = (v[0] * v[0] + v[1] * v[1]) + (v[2] * v[2] + v[3] * v[3]);
      const float rstd = 1.0f / sqrtf(wave_sum(ss) * (1.0f / 256) + RMS_EPS);
      const f32x4 g = *(const f32x4*)(kv_a_norm + lane * 4);
      *(u32x2*)(CQKV + row * 1024 + 512 + lane * 4) = (u32x2){cvt_pk_bf16(v[0] * rstd * g.x, v[1] * rstd * g.y), cvt_pk_bf16(v[2] * rstd * g.z, v[3] * rstd * g.w)}; }
}
__device__ __forceinline__ void step_prep1(bf16_t* CQKV, bf16_t* AXb, bf16_t* WINb, const float* q_a_norm, const float* kv_a_norm, const float* ax_qn, const float* ax_kn,
                                           const float* win_qn, const float* win_kn, const f32x2* rope, int S, int TP, int gw, int NGW, int lane) {
    for (int ch = gw; ch < TP / 8; ch += NGW)
        for (int rr = 0; rr < 8; rr += 2) { const size_t row = (size_t)ch * 8 + rr; const int s = (int)(row % (size_t)S);
            P1Row A, B; p1_load(A, CQKV, AXb, WINb, rope, row, s, lane); p1_load(B, CQKV, AXb, WINb, rope, row + 1, s + 1, lane);
            p1_finish(A, CQKV, AXb, WINb, q_a_norm, kv_a_norm, ax_qn, ax_kn, win_qn, win_kn, row, lane);
            p1_finish(B, CQKV, AXb, WINb, q_a_norm, kv_a_norm, ax_qn, ax_kn, win_qn, win_kn, row + 1, lane); }
}
struct P2Row { u32x4 wn[4]; unsigned r0[4], r1[4]; f32x4 cs; };
__device__ __forceinline__ void p2_load(P2Row& R, const bf16_t* QM, const bf16_t* KF, const bf16_t* CQKV, const f32x2* rope, size_t row, int s, int lane) {
    const int j = lane & 15, grp = lane >> 4;
    const unsigned kr0 = *(const unsigned*)(CQKV + row * 1024 + 768 + 2 * j), kr1 = *(const unsigned*)(CQKV + row * 1024 + 800 + 2 * j);
#pragma unroll
    for (int it = 0; it < 4; ++it) { const int h = (it & 1) * 4 + grp; const bool isq = it < 2; const bf16_t* hb = (isq ? QM : KF) + row * 1536 + h * 192;
        R.wn[it] = *(const u32x4*)(hb + 8 * j);
        if (isq) { R.r0[it] = *(const unsigned*)(hb + 128 + 2 * j); R.r1[it] = *(const unsigned*)(hb + 160 + 2 * j); } else { R.r0[it] = kr0; R.r1[it] = kr1; } }
    R.cs = *(const f32x4*)(rope + (size_t)s * 32 + 2 * j);
}
__device__ __forceinline__ void p2_finish(const P2Row& R, bf16_t* QM, bf16_t* KF, const float* mla_qn, const float* mla_kn, size_t row, int lane) {
    const int j = lane & 15, grp = lane >> 4; const f32x4 cs = R.cs;
#pragma unroll
    for (int it = 0; it < 4; ++it) { const int h = (it & 1) * 4 + grp; const bool isq = it < 2; const float* gain = isq ? mla_qn : mla_kn; bf16_t* base = (isq ? QM : KF) + row * 1536 + h * 192;
        float v[8] = {bf_lo(R.wn[it].x), bf_hi(R.wn[it].x), bf_lo(R.wn[it].y), bf_hi(R.wn[it].y), bf_lo(R.wn[it].z), bf_hi(R.wn[it].z), bf_lo(R.wn[it].w), bf_hi(R.wn[it].w)};
        float x0 = bf_lo(R.r0[it]), x1 = bf_hi(R.r0[it]), y0 = bf_lo(R.r1[it]), y1 = bf_hi(R.r1[it]);
        float ss = (x0 * x0 + x1 * x1) + (y0 * y0 + y1 * y1);
#pragma unroll
        for (int e = 0; e < 8; ++e) ss += v[e] * v[e];
        const float rstd = (isq ? 0.072168783648703220f * 1.4426950408889634f : 1.0f) / sqrtf(sum16(ss) * (1.0f / 192) + RMS_EPS);
        const f32x4 g0 = *(const f32x4*)(gain + 8 * j), g1 = *(const f32x4*)(gain + 8 * j + 4); const f32x2 gx = *(const f32x2*)(gain + 128 + 2 * j), gy = *(const f32x2*)(gain + 160 + 2 * j);
        u32x4 o; o.x = cvt_pk_bf16(v[0] * rstd * g0.x, v[1] * rstd * g0.y); o.y = cvt_pk_bf16(v[2] * rstd * g0.z, v[3] * rstd * g0.w);
        o.z = cvt_pk_bf16(v[4] * rstd * g1.x, v[5] * rstd * g1.y); o.w = cvt_pk_bf16(v[6] * rstd * g1.z, v[7] * rstd * g1.w);
        x0 *= rstd * gx.x; x1 *= rstd * gx.y; y0 *= rstd * gy.x; y1 *= rstd * gy.y;
        *(u32x4*)(base + 8 * j) = o;
        *(unsigned*)(base + 128 + 2 * j) = cvt_pk_bf16(x0 * cs.x - y0 * cs.y, x1 * cs.z - y1 * cs.w);
        *(unsigned*)(base + 160 + 2 * j) = cvt_pk_bf16(y0 * cs.x + x0 * cs.y, y1 * cs.z + x1 * cs.w); }
}
__device__ __forceinline__ void step_prep2(bf16_t* QM, bf16_t* KF, const bf16_t* CQKV, const float* mla_qn, const float* mla_kn, const f32x2* rope, int S, int TP, int gw, int NGW, int lane) {
    for (int ch = gw; ch < TP / 8; ch += NGW)
        for (int rr = 0; rr < 8; rr += 2) { const size_t row = (size_t)ch * 8 + rr; const int s = (int)(row % (size_t)S);
            P2Row A, B; p2_load(A, QM, KF, CQKV, rope, row, s, lane); p2_load(B, QM, KF, CQKV, rope, row + 1, s + 1, lane);
            p2_finish(A, QM, KF, mla_qn, mla_kn, row, lane); p2_finish(B, QM, KF, mla_qn, mla_kn, row + 1, lane); }
}
struct Args { const float* in[24]; float* out; unsigned char* ws; int step_lo, step_hi, li, pad; };
__global__ void __launch_bounds__(NWAVES * 64, 2) fwd(Args args) {
    extern __shared__ __attribute__((aligned(16))) unsigned char lds_raw[];
    LAS unsigned char* lds = (LAS unsigned char*)lds_raw;
    const int G = gridDim.x, bx = blockIdx.x, vcu = (G % 8 == 0) ? (bx % 8) * (G / 8) + bx / 8 : bx;
    const int NGW = G * NWAVES, NTH = NGW * 64;
    { const int tid = threadIdx.x; if (tid < 64) ((LAS unsigned*)(lds + LDSCTL_OFF))[tid] = 0u; }
    __syncthreads();
    const int lo = args.step_lo, hi = args.step_hi;
    XcdBarrier bar; bar.bar = (unsigned*)(args.ws + WS_CTL) + args.li * XCD_BAR_WORDS; bar.x = 0; bar.st = (volatile LAS unsigned*)(lds + LDSCTL_OFF) + 8;
    if (hi - lo > 1) bar = xcd_barrier_post((unsigned*)(args.ws + WS_CTL) + args.li * XCD_BAR_WORDS, (volatile LAS unsigned*)(lds + LDSCTL_OFF) + 8);
#ifndef PH_MASK
#define PH_MASK 0x3ff
#endif
#define PH(k) (((PH_MASK) >> (k)) & 1)
#define PHASE_IDS() int tid_ = threadIdx.x; asm volatile("" : "+v"(tid_)); const int tid = tid_, lane = tid & 63, wave = __builtin_amdgcn_readfirstlane(tid >> 6), gw = vcu * NWAVES + wave, gt = gw * 64 + lane; (void)gt; (void)gw; (void)lane
#define GAS __attribute__((address_space(1)))
#define GP(T, p) ((T*)(p))
#define TABP(k) GP(const float, tab[k])
#define PHASE_PTRS() PHASE_IDS(); size_t wz_ = 0; asm volatile("" : "+s"(wz_)); unsigned char* ws = args.ws + wz_; const float* const* tab = (const float* const*)(ws + WS_PTRS); \
    bf16_t* WIN_T = GP(bf16_t, ws + WS_WIN_T); bf16_t* WQ_T = GP(bf16_t, ws + WS_WQ_T); bf16_t* WKV_T = GP(bf16_t, ws + WS_WKV_T); \
    bf16_t* WBR_T = GP(bf16_t, ws + WS_WBR_T); bf16_t* WOUT_T = GP(bf16_t, ws + WS_WOUT_T); \
    bf16_t* Hb = GP(bf16_t, ws + WS_H); bf16_t* CQKV = GP(bf16_t, ws + WS_CQKV); bf16_t* QM = GP(bf16_t, ws + WS_QM); bf16_t* KF = GP(bf16_t, ws + WS_KF); bf16_t* VM = GP(bf16_t, ws + WS_VM); \
    bf16_t* AXb = GP(bf16_t, ws + WS_AX); bf16_t* WINb = GP(bf16_t, ws + WS_WINB); bf16_t* Gb = GP(bf16_t, ws + WS_G); bf16_t* MG = GP(bf16_t, ws + WS_MG); \
    const float* mod_l = GP(const float, ws + WS_MOD) + (size_t)l * 16 * 6144; const f32x2* rope = GP(const f32x2, ws + WS_ROPE); const float* tb = GP(const float, ws + WS_TB); \
    (void)tab; (void)WIN_T; (void)WQ_T; (void)WKV_T; (void)WBR_T; (void)WOUT_T; (void)Hb; (void)CQKV; (void)QM; (void)KF; (void)VM; (void)AXb; (void)WINb; (void)Gb; (void)MG; (void)mod_l; (void)rope; (void)tb
#ifndef MK_TPROBE
#define MK_TPROBE -1
#endif
#ifndef MK_TSCALE
#define MK_TSCALE 4.0f
#endif
#define TP_BEGIN(k) do { if (MK_TPROBE == (k)) tp0 = __builtin_amdgcn_s_memrealtime(); } while (0)
#define TP_END(k) do { if (MK_TPROBE == (k)) tpacc += __builtin_amdgcn_s_memrealtime() - tp0; } while (0)
#define IN(s) (lo <= (s) && (s) < hi)
#define SEAM(s) do { if (IN(s) && IN((s) + 1)) xcd_barrier(bar); } while (0)

    unsigned long long tp0 = 0, tpacc = 0; (void)tp0; (void)tpacc;
    TP_BEGIN(8);
    if (PH(0) && IN(0)) { PHASE_IDS(); if (bx == 0 && tid == 0) { const float** tw = (const float**)(args.ws + WS_PTRS);
#pragma unroll
            for (int i = 0; i < 24; ++i) tw[i] = args.in[i];
            tw[24] = (const float*)args.out; }
        step_prologue(args.in, args.ws, lds, tid, lane, wave, vcu, G); }
    SEAM(0);
    if (PH(1) && IN(1)) { PHASE_IDS(); step_modreduce(args.in[6], args.ws, gt, NTH); }
    SEAM(1);
    TP_END(8);

    int it_lo = (lo - NSTEP_PRO) / NSTEP_IT; if (lo < NSTEP_PRO) it_lo = 0;
    int it_hi = (hi - NSTEP_PRO + NSTEP_IT - 1) / NSTEP_IT; if (hi <= NSTEP_PRO) it_hi = 0; if (it_hi > DEPTH * NPASS) it_hi = DEPTH * NPASS;
    for (int it = it_lo; it < it_hi; ++it) {
        const int l = it / NPASS, p = it % NPASS, s0 = NSTEP_PRO + it * NSTEP_IT;
        const int S = p == 0 ? 4096 : 2048, bbase = p == 0 ? 0 : 8, TP = p == 0 ? 32768 : 16384;
        const size_t row0 = p == 0 ? 0 : 32768;

        TP_BEGIN(0);
        if (PH(2) && IN(s0 + 0)) { PHASE_PTRS(); const float* xin = ((l == 0) ? (p == 0 ? args.in[0] : args.in[1]) : args.out + row0 * DM) + wz_; float* xout = args.out + row0 * DM + wz_; (void)xout; step_norm(xin, Hb, TABP(4) + (size_t)l * DM, mod_l, bbase, S, TP, gw, NGW, lane); }
        TP_BEGIN(20);
        SEAM(s0 + 0);
        TP_END(20);
        TP_END(0);
        TP_BEGIN(1);
        if (PH(3) && IN(s0 + 1)) { PHASE_PTRS();
            pg8::Gemm g{Hb, WIN_T + (size_t)l * NINP * DM, TP, NINP, DM, DM, DM}; pg8::StaticOrder So; So.init(TP, NINP, G, bx);
            EpiInProj E{CQKV, Gb, AXb, WINb, MG, tab, l * 128, rope, S, (PG8_LAS float*)(lds + LDSCTL_OFF + 1024), (float*)(ws + WS_RS)};
            pg8::gemm_phase<EpiInProj, pg8::StaticOrder, true, true>(lds + RING_OFF, g, So, E);
        }
        TP_BEGIN(21);
        SEAM(s0 + 1);
        TP_END(21);
        TP_END(1);
        TP_BEGIN(2);
        TP_END(22);
        TP_END(2);
        TP_BEGIN(3);
        if (PH(5) && IN(s0 + 3)) { PHASE_PTRS();
            { pg8::Gemm g{CQKV, WQ_T + (size_t)l * 2048 * 512, TP, 2048, 512, 1024, 512}; pg8::StaticOrder So; So.init(TP, 2048, G, bx);
              EpiQUp E{QM, (const float*)(ws + WS_RS), TABP(12) + (size_t)l * 192, rope, S, (PG8_LAS float*)(lds + LDSCTL_OFF + 1024)};
              pg8::gemm_phase<EpiQUp, pg8::StaticOrder, true, true>(lds + RING_OFF, g, So, E); }
            { pg8::Gemm g{CQKV + 512, WKV_T + (size_t)l * 2048 * 256, TP, 2048, 256, 1024, 256}; pg8::StaticOrder So; So.init(TP, 2048, G, G - 1 - bx);
              EpiKV E{KF, VM, (const float*)(ws + WS_RS), CQKV, TABP(13) + (size_t)l * 192, rope, S, (PG8_LAS float*)(lds + LDSCTL_OFF + 1024)};
              pg8::gemm_phase<EpiKV, pg8::StaticOrder, true, true>(lds + RING_OFF, g, So, E); }
        }
        TP_BEGIN(23);
        SEAM(s0 + 3);
        TP_END(23);
        TP_END(3);
        TP_BEGIN(4);
        TP_END(24);
        TP_END(4);
        TP_BEGIN(5);
        if (PH(7) && IN(s0 + 5)) { PHASE_PTRS();
            const int nqb = S / 256, nper = TP / 256; char* al = (char*)lds_raw + RING_OFF; const long dbgoff = 0; (void)dbgoff;
#define UNIF_F(x) __builtin_bit_cast(float, __builtin_amdgcn_readfirstlane(__builtin_bit_cast(int, (float)(x))))
            const float mneg_mla = UNIF_F(-1.02f * 13.856406f * 1.4426950408889634f * wave_maxabs(TABP(12) + (size_t)l * 192, 192, lane) * wave_maxabs(TABP(13) + (size_t)l * 192, 192, lane));
            const float mneg_ax = UNIF_F(-1.02f * 11.313708f * 1.4426950408889634f * wave_maxabs(TABP(14) + (size_t)l * 128, 128, lane) * wave_maxabs(TABP(15) + (size_t)l * 128, 128, lane));
#undef UNIF_F
            const bool mla_small = mneg_mla > -100.f;
            const unsigned myx = xb_xcc_id() & 7u; unsigned* qbase = (unsigned*)(ws + WS_CTL) + 4096 + (size_t)it * (3 * 8 * 64);
            volatile LAS int* tick = (volatile LAS int*)(lds + LDSCTL_OFF) + 16;
#define Q_RAW(cls, r_) do { r_ = -1; while (qi < 8) { const unsigned x_ = (myx + (unsigned)qi) & 7u; \
                const unsigned k_ = __hip_atomic_fetch_add(qbase + ((cls) * 8 + x_) * 64, 1u, __ATOMIC_RELAXED, __HIP_MEMORY_SCOPE_AGENT); if ((int)k_ < nper) { r_ = (int)((x_ << 16) | k_); break; } ++qi; } } while (0)
#define Q_FIRST(cls, r) do { __syncthreads(); if (tid == 0) { int r_; Q_RAW(cls, r_); tick[0] = r_; } __syncthreads(); r = tick[0]; par = 1; } while (0)
#define Q_NEXT_ISSUE(cls) do { nxt = -1; if (tid == 0) { Q_RAW(cls, nxt); } } while (0)
#define Q_NEXT_TAKE(r) do { if (tid == 0) tick[par] = nxt; __syncthreads(); r = tick[par]; par ^= 1; } while (0)
            TP_BEGIN(10);
            { int qi = 0, r, nxt, par;
              Q_FIRST(0, r);
              while (r >= 0) { Q_NEXT_ISSUE(0); const int h = r >> 16, k = r & 0xffff, b = k / nqb, qb = k % nqb; const size_t t0 = (size_t)b * S, tq = t0 + (size_t)qb * 256;
                if (mla_small) att::attn_unit<192, 1, 1536, 1536, 1024, 3072, false, 2>(QM + tq * 1536 + h * 192, KF + t0 * 1536 + h * 192, VM + t0 * 1024 + h * 128, Gb + tq * 3072 + h * 128,
                                                                                        S / 64, 0.f, 0.f, tb, 0, al);
                else att::attn_unit<192, 1, 1536, 1536, 1024, 3072, false, 3>(QM + tq * 1536 + h * 192, KF + t0 * 1536 + h * 192, VM + t0 * 1024 + h * 128, Gb + tq * 3072 + h * 128,
                                                                             S / 64, mneg_mla, 0.f, tb, 0, al);
                Q_NEXT_TAKE(r); } }
            TP_END(10); TP_BEGIN(11);
            { int qi = 0, r, nxt, par;
              Q_FIRST(1, r);
              while (r >= 0) { Q_NEXT_ISSUE(1); const int x = r >> 16, k = r & 0xffff, g = x + 8 * (k / (4 * nqb)), w = k % (4 * nqb), b = g >> 1, h = (g & 1) * 4 + w / nqb, qb = w % nqb;
                const size_t t0 = (size_t)b * S, tq = t0 + (size_t)qb * 256;
                att::attn_unit<128, 2, 1536, 1536, 1536, 3072, false, 1>(AXb + tq * 1536 + h * 128, AXb + t0 * 1536 + 1024 + (h >> 2) * 128, AXb + t0 * 1536 + 1280 + (h >> 2) * 128,
                                                                     Gb + tq * 3072 + 1024 + h * 128, S / 64, mneg_ax, 0.f, tb, 0, al);
                Q_NEXT_TAKE(r); } }
            TP_END(11); TP_BEGIN(12);
            const float* sink = TABP(18) + l * 8;
            { int qi = 0, r, nxt, par;
              Q_FIRST(2, r);
              while (r >= 0) { Q_NEXT_ISSUE(2); const int x = r >> 16, k = r & 0xffff, g = x + 8 * (k / (4 * nqb)), w = k % (4 * nqb), b = g >> 1, h = (g & 1) * 4 + w / nqb, qb = w % nqb;
                const size_t t0 = (size_t)b * S, tq = t0 + (size_t)qb * 256;
                const int q0 = qb * 256, ks = q0 >= 128 ? q0 - 128 : 0, ke = q0 + 384 <= S ? q0 + 384 : S; const size_t tk = t0 + ks;
                att::attn_unit<128, 1, 1536, 1536, 1536, 3072, true>(WINb + tq * 1536 + h * 128, WINb + tk * 1536 + 1024 + (h >> 2) * 128, WINb + tk * 1536 + 1280 + (h >> 2) * 128,
                                                                    Gb + tq * 3072 + 2048 + h * 128, (ke - ks) / 64, sink[h] * 1.4426950408889634f, 1.f, tb + h * 768, ks - q0 + 383, al);
                Q_NEXT_TAKE(r); } }
#undef Q_RAW
#undef Q_FIRST
#undef Q_NEXT_ISSUE
#undef Q_NEXT_TAKE
            __syncthreads(); TP_END(12); TP_BEGIN(13);
        }
        SEAM(s0 + 5);
        TP_END(13);
        TP_END(5);
        TP_BEGIN(6);
        if (PH(8) && IN(s0 + 6)) { PHASE_PTRS();
            pg8::Gemm g{Gb, WBR_T + (size_t)l * DM * 3072, TP, DM, 3072, 3072, 3072}; pg8::StaticOrder So; So.init(TP, DM, G, bx);
            EpiBranchFused E{MG, Hb};
            pg8::gemm_phase<EpiBranchFused, pg8::StaticOrder, true, true>(lds + RING_OFF, g, So, E);
        }
        TP_BEGIN(26);
        SEAM(s0 + 6);
        TP_END(26);
        TP_END(6);
        TP_BEGIN(7);
        if (PH(9) && IN(s0 + 7)) { PHASE_PTRS(); const float* xin = ((l == 0) ? (p == 0 ? args.in[0] : args.in[1]) : args.out + row0 * DM) + wz_; float* xout = args.out + row0 * DM + wz_; (void)xout;
            pg8::Gemm g{Hb, WOUT_T + (size_t)l * DM * DM, TP, DM, DM, DM, DM}; pg8::StaticOrder So; So.init(TP, DM, G, bx);
            EpiOut E{xin, xout, mod_l + 4096, bbase, S};
            pg8::gemm_phase<EpiOut, pg8::StaticOrder, true, true>(lds + RING_OFF, g, So, E);
        }
        TP_BEGIN(27);
        SEAM(s0 + 7);
        TP_END(27);
        TP_END(7);
    }
    if (MK_TPROBE >= 0 && hi == NSTEPS) { xcd_barrier(bar);
        if (bx == 0 && threadIdx.x == 0) args.out[0] += (float)tpacc * 1e-5f * MK_TSCALE; }
#undef IN
#undef SEAM
}

extern "C" void kernel_launch(void* const* d_in, const int* in_sizes, int n_in, void* d_out, int out_size, void* d_ws, size_t ws_size, hipStream_t stream) {
    static int grid = 0;
    if (grid == 0) {
        if (n_in != 24 || in_sizes[0] != T_PROMPT * DM || in_sizes[1] != T_SAMPLE * DM || out_size != (T_PROMPT + T_SAMPLE) * DM || ws_size < WS_END) {
            fprintf(stderr, "kernel_launch: shape mismatch (n_in %d, in0 %d, in1 %d, out %d, ws %zu, need ws >= %zu); nothing launched\n", n_in, n_in > 0 ? in_sizes[0] : -1, n_in > 1 ? in_sizes[1] : -1, out_size, ws_size, (size_t)WS_END);
            grid = -1; return; }
        int dev = 0, cus = 0, per_cu = 0;
        if (hipGetDevice(&dev) != hipSuccess || hipDeviceGetAttribute(&cus, hipDeviceAttributeMultiprocessorCount, dev) != hipSuccess) { fprintf(stderr, "kernel_launch: device query failed\n"); grid = -1; return; }
        if (hipFuncSetAttribute((const void*)fwd, hipFuncAttributeMaxDynamicSharedMemorySize, LDS_BYTES) != hipSuccess) { fprintf(stderr, "kernel_launch: hipFuncSetAttribute failed\n"); grid = -1; return; }
        if (hipOccupancyMaxActiveBlocksPerMultiprocessor(&per_cu, (const void*)fwd, NWAVES * 64, LDS_BYTES) != hipSuccess || per_cu < 1)
            fprintf(stderr, "kernel_launch: note: occupancy query reports %d workgroups per CU\n", per_cu);
        (void)hipGetLastError();
        grid = cus;
    }
    if (grid < 0) return;
    if (hipMemsetAsync((char*)d_ws + WS_CTL, 0, CTL_ZERO_BYTES, stream) != hipSuccess) { fprintf(stderr, "kernel_launch: hipMemsetAsync failed\n"); return; }
    Args a{};
    for (int i = 0; i < 24; ++i) a.in[i] = (const float*)d_in[i];
    a.out = (float*)d_out; a.ws = (unsigned char*)d_ws; a.li = 0; a.pad = 0;
#if MK_ONE_LAUNCH
    a.step_lo = 0; a.step_hi = NSTEPS;
    hipLaunchKernelGGL(fwd, dim3(grid), dim3(NWAVES * 64), LDS_BYTES, stream, a);
#else
    for (int s = 0; s < NSTEPS; ++s) { a.step_lo = s; a.step_hi = s + 1;
        hipLaunchKernelGGL(fwd, dim3(grid), dim3(NWAVES * 64), LDS_BYTES, stream, a); }
#endif
    const hipError_t le = hipPeekAtLastError();
    if (le != hipSuccess) fprintf(stderr, "kernel_launch: launch failed: %s\n", hipGetErrorName(le));
}
```

```cpp
#include <hip/hip_runtime.h>
#include <cstdio>
#include <cstdint>

#ifndef MK_ONE_LAUNCH
#define MK_ONE_LAUNCH 1
#endif

#define LAS __attribute__((address_space(3)))
typedef unsigned short bf16_t;
typedef short bf16x8 __attribute__((ext_vector_type(8)));
typedef short s16x4 __attribute__((ext_vector_type(4)));
typedef float f32x2 __attribute__((ext_vector_type(2)));
typedef float f32x4 __attribute__((ext_vector_type(4)));
typedef float f32x16 __attribute__((ext_vector_type(16)));
typedef unsigned u32x2 __attribute__((ext_vector_type(2)));
typedef unsigned u32x4 __attribute__((ext_vector_type(4)));

__device__ __forceinline__ unsigned cvt_pk_bf16(float lo, float hi) { unsigned r; asm volatile("v_cvt_pk_bf16_f32 %0, %1, %2" : "=v"(r) : "v"(lo), "v"(hi)); return r; }
__device__ __forceinline__ float bf_lo(unsigned w) { return __builtin_bit_cast(float, w << 16); }
__device__ __forceinline__ float bf_hi(unsigned w) { return __builtin_bit_cast(float, w & 0xffff0000u); }
__device__ __forceinline__ float bf2f(bf16_t x) { return __builtin_bit_cast(float, (unsigned)x << 16); }
__device__ __forceinline__ bf16_t f2bf(float f) { return (bf16_t)(cvt_pk_bf16(f, 0.f) & 0xffffu); }
__device__ __forceinline__ float sigmoid_f(float v) { return __builtin_amdgcn_rcpf(1.0f + __builtin_amdgcn_exp2f(-1.4426950408889634f * v)); }
__device__ __forceinline__ float silu_f(float v) { return v * sigmoid_f(v); }

namespace pg8 {
#define PG8_LAS __attribute__((address_space(3)))
constexpr int BM = 256, BK = 64, HALF = 128, HTB = HALF * BK * 2  , STAGE_BYTES = 8 * HTB, NXCD = 8, WGM = 8;
__host__ __device__ __forceinline__ int lds_byte(int r, int c) { const int st = (r >> 4) * 2 + (c >> 5), rr = r & 15, cc = c & 31, ob = rr * 64 + cc * 2; return st * 1024 + (ob ^ (((ob >> 9) & 1) << 5)); }
__host__ __device__ __forceinline__ void stage_rc(int b, int& R, int& C) { const int st = b / 1024, sb = b % 1024, swz = sb ^ (((sb >> 9) & 1) << 5); R = (st >> 1) * 16 + swz / 64; C = (st & 1) * 32 + (swz % 64) / 2; }
__host__ __device__ __forceinline__ int perm32(int rho) { const int n = rho >> 4, i = rho & 15; return 8 * (i >> 2) + 4 * n + (i & 3); }

struct Unit { int pm, pn; };
struct Gemm { const bf16_t* A; const bf16_t* Bt; int M, N, K, lda, ldb; };

struct StaticOrder {
    int nM, nN, nwg, G, c, wgm;
    __host__ __device__ void init(int M, int N, int G_, int c_, int wgm_ = 4) { nM = M / BM; nN = N / BM; nwg = nM * nN; G = G_; c = c_; wgm = wgm_; }
    __host__ __device__ bool next(int i, Unit& u) const {
        const long L = (long)i * G + c; if (L >= nwg) return false;
        int wgid = (int)L; { const int q = nwg / NXCD, r = nwg % NXCD, xcd = wgid % NXCD, off = wgid / NXCD; wgid = (xcd < r ? xcd * (q + 1) : r * (q + 1) + (xcd - r) * q) + off; }
        const int nig = wgm * nN, gid = wgid / nig, fm = gid * wgm, gsz = (nM - fm) < wgm ? (nM - fm) : wgm;
        u.pm = fm + ((wgid % nig) % gsz); u.pn = (wgid % nig) / gsz; return true;
    }
};
template <class Epi, class Sched, bool ALIGN_EPI = false, bool SP2 = false>
__device__ __forceinline__ void gemm_phase(PG8_LAS unsigned char* lds, const Gemm g, const Sched& S, const Epi& E) {
    int tid_ = threadIdx.x; asm volatile("" : "+v"(tid_));
    const int tid = tid_, wid = __builtin_amdgcn_readfirstlane(tid >> 6), lane = tid & 63, wr = wid >> 2, wc = wid & 3, fr = lane & 15, fq = lane >> 4;
    int K_ = g.K; asm volatile("" : "+s"(K_));
    const int K = K_, nt = K / BK;
    unsigned voffA[2], voffB[2];
#pragma unroll
    for (int i = 0; i < 2; ++i) { int R, C; stage_rc(tid * 16 + i * 8192, R, C); const int Rb = Epi::PERM ? ((R & ~31) + perm32(R & 31)) : R;
        voffA[i] = (unsigned)(R * g.lda + C) * 2u; voffB[i] = (unsigned)(Rb * g.ldb + C) * 2u; }
    const size_t kstep = (size_t)(BK * 2);
    const size_t hstepA = (size_t)HALF * g.lda * 2, hstepB = (size_t)HALF * g.ldb * 2;
    const size_t tstepA = 2 * hstepA, tstepB = 2 * hstepB;
    const unsigned ldsw = (unsigned)wid * 1024u;
    const int aoff = lds_byte(wr * 64 + fr, fq * 8), boff = lds_byte(wc * 32 + fr, fq * 8);
#define PG8_SA(b, h) (((b) * 2 + (h)) * HTB)
#define PG8_SB(b, h) ((4 + (b) * 2 + (h)) * HTB)
#define PG8_STAGE(bufoff, gbase, voff) do { _Pragma("unroll") for (int _i = 0; _i < 2; ++_i) \
        __builtin_amdgcn_global_load_lds((const unsigned*)((const char*)(gbase) + (voff)[_i]), (PG8_LAS unsigned*)(lds + (bufoff) + ldsw + _i * 8192), 16, 0, 0); } while (0)
#define PG8_LDA(dst, b, h) do { _Pragma("unroll") for (int m = 0; m < 4; ++m) _Pragma("unroll") for (int k = 0; k < 2; ++k) dst[m][k] = *(const PG8_LAS bf16x8*)(lds + PG8_SA(b, h) + aoff + m * 2048 + k * 1024); } while (0)
#define PG8_LDB(dst, b, h) do { _Pragma("unroll") for (int n = 0; n < 2; ++n) _Pragma("unroll") for (int k = 0; k < 2; ++k) dst[n][k] = *(const PG8_LAS bf16x8*)(lds + PG8_SB(b, h) + boff + n * 2048 + k * 1024); } while (0)
#define PG8_MMA(ai, bj, At, Bt) do { __builtin_amdgcn_s_setprio(1); _Pragma("unroll") for (int m = 0; m < 4; ++m) _Pragma("unroll") for (int n = 0; n < 2; ++n) _Pragma("unroll") for (int k = 0; k < 2; ++k) \
        acc[ai][bj][m][n] = __builtin_amdgcn_mfma_f32_16x16x32_bf16(Bt[n][k], At[m][k], acc[ai][bj][m][n], 0, 0, 0); __builtin_amdgcn_s_setprio(0); } while (0)
#define PG8_WAIT_V(n) asm volatile("s_waitcnt vmcnt(" #n ")" ::: "memory")
#define PG8_WAIT_L(n) asm volatile("s_waitcnt lgkmcnt(" #n ")" ::: "memory")
#define PG8_BAR __builtin_amdgcn_s_barrier()
#define PG8_SCHED __builtin_amdgcn_sched_barrier(0)
    Unit cur, nxt; int ui = 0;
    if (!S.next(0, cur)) return;
    f32x4 acc[2][2][4][2];
#pragma unroll
    for (int a = 0; a < 2; ++a)
#pragma unroll
        for (int b = 0; b < 2; ++b)
#pragma unroll
            for (int m = 0; m < 4; ++m)
#pragma unroll
                for (int n = 0; n < 2; ++n) acc[a][b][m][n] = (f32x4){0.f, 0.f, 0.f, 0.f};
    bf16x8 At[4][2], B0[2][2], B1[2][2];
    const char* cA = (const char*)g.A + (size_t)cur.pm * tstepA; const char* cB = (const char*)g.Bt + (size_t)cur.pn * tstepB;

    if constexpr (SP2) {
        PG8_STAGE(PG8_SB(0, 0), cB, voffB); PG8_STAGE(PG8_SB(0, 1), cB + hstepB, voffB); PG8_STAGE(PG8_SA(0, 0), cA, voffA); PG8_STAGE(PG8_SA(0, 1), cA + hstepA, voffA);
        if (wr == 1) PG8_BAR;
        PG8_WAIT_V(2); PG8_BAR;
        PG8_STAGE(PG8_SB(1, 0), cB + kstep, voffB); PG8_STAGE(PG8_SA(1, 0), cA + kstep, voffA); PG8_STAGE(PG8_SB(1, 1), cB + hstepB + kstep, voffB);
        PG8_WAIT_V(6); PG8_BAR;
    } else {
        PG8_STAGE(PG8_SB(0, 0), cB, voffB); PG8_STAGE(PG8_SA(0, 0), cA, voffA); PG8_STAGE(PG8_SB(0, 1), cB + hstepB, voffB); PG8_STAGE(PG8_SA(0, 1), cA + hstepA, voffA);
        if (wr == 1) PG8_BAR;
        PG8_WAIT_V(4); PG8_BAR;
        PG8_STAGE(PG8_SB(1, 0), cB + kstep, voffB); PG8_STAGE(PG8_SA(1, 0), cA + kstep, voffA); PG8_STAGE(PG8_SB(1, 1), cB + hstepB + kstep, voffB);
        PG8_WAIT_V(6); PG8_BAR;
    }
    for (;;) {
        const bool has_next = S.next(ui + 1, nxt);
        const char* nA = has_next ? (const char*)g.A + (size_t)nxt.pm * tstepA : cA; const char* nB = has_next ? (const char*)g.Bt + (size_t)nxt.pn * tstepB : cB;
        for (int t = 0; t < nt; t += 2) {
            if constexpr (Epi::HAS_MID) { if (t == Epi::MID1 || t == Epi::MID2) E.mid(acc, cur, t, wr, wc, fr, fq); }
            const bool last = (t == nt - 2);
            const char* a1 = cA + (size_t)(t + 1) * kstep;
            const char* a2 = last ? nA : cA + (size_t)(t + 2) * kstep; const char* b2 = last ? nB : cB + (size_t)(t + 2) * kstep;
            const char* a3 = a2 + kstep; const char* b3 = b2 + kstep;

            if constexpr (SP2) {
            PG8_LDB(B0, 0, 0); PG8_LDB(B1, 0, 1); PG8_SCHED; PG8_LDA(At, 0, 0); PG8_STAGE(PG8_SA(1, 1), a1 + hstepA, voffA);
            PG8_WAIT_V(8); PG8_WAIT_L(0); PG8_BAR; PG8_MMA(0, 0, At, B0); PG8_MMA(0, 1, At, B1); PG8_BAR; PG8_SCHED;
            PG8_LDA(At, 0, 1); PG8_STAGE(PG8_SB(0, 0), b2, voffB); PG8_STAGE(PG8_SB(0, 1), b2 + hstepB, voffB); PG8_STAGE(PG8_SA(0, 0), a2, voffA);
            PG8_WAIT_V(8); PG8_WAIT_L(0); PG8_BAR; PG8_MMA(1, 0, At, B0); PG8_MMA(1, 1, At, B1); PG8_BAR; PG8_SCHED;
            PG8_LDB(B0, 1, 0); PG8_LDB(B1, 1, 1); PG8_SCHED; PG8_LDA(At, 1, 0); PG8_STAGE(PG8_SA(0, 1), a2 + hstepA, voffA);
            PG8_WAIT_V(8); PG8_WAIT_L(0); PG8_BAR; PG8_MMA(0, 0, At, B0); PG8_MMA(0, 1, At, B1); PG8_BAR; PG8_SCHED;
            PG8_LDA(At, 1, 1); PG8_STAGE(PG8_SB(1, 0), b3, voffB); PG8_STAGE(PG8_SB(1, 1), b3 + hstepB, voffB); PG8_STAGE(PG8_SA(1, 0), a3, voffA);
            PG8_WAIT_V(8); PG8_WAIT_L(0); PG8_BAR; PG8_MMA(1, 0, At, B0); PG8_MMA(1, 1, At, B1); PG8_BAR; PG8_SCHED;
            } else {
            PG8_LDB(B0, 0, 0); PG8_SCHED; PG8_LDA(At, 0, 0); PG8_STAGE(PG8_SA(1, 1), a1 + hstepA, voffA);
            PG8_WAIT_L(8); PG8_BAR; PG8_WAIT_L(0); PG8_MMA(0, 0, At, B0); PG8_BAR; PG8_SCHED;
            PG8_LDB(B1, 0, 1); PG8_STAGE(PG8_SB(0, 0), b2, voffB);
            PG8_BAR; PG8_WAIT_L(0); PG8_MMA(0, 1, At, B1); PG8_BAR;
            PG8_LDA(At, 0, 1); PG8_STAGE(PG8_SA(0, 0), a2, voffA);
            PG8_BAR; PG8_WAIT_L(0); PG8_MMA(1, 0, At, B0); PG8_BAR; PG8_SCHED;
            PG8_STAGE(PG8_SB(0, 1), b2 + hstepB, voffB);
            PG8_WAIT_V(6); PG8_BAR; PG8_MMA(1, 1, At, B1); PG8_BAR;
            PG8_LDB(B0, 1, 0); PG8_SCHED; PG8_LDA(At, 1, 0); PG8_STAGE(PG8_SA(0, 1), a2 + hstepA, voffA);
            PG8_WAIT_L(8); PG8_BAR; PG8_WAIT_L(0); PG8_MMA(0, 0, At, B0); PG8_BAR; PG8_SCHED;
            PG8_LDB(B1, 1, 1); PG8_STAGE(PG8_SB(1, 0), b3, voffB);
            PG8_BAR; PG8_WAIT_L(0); PG8_MMA(0, 1, At, B1); PG8_BAR;
            PG8_LDA(At, 1, 1); PG8_STAGE(PG8_SA(1, 0), a3, voffA);
            PG8_BAR; PG8_WAIT_L(0); PG8_MMA(1, 0, At, B0); PG8_BAR; PG8_SCHED;
            PG8_STAGE(PG8_SB(1, 1), b3 + hstepB, voffB);
            PG8_WAIT_V(6); PG8_BAR; PG8_MMA(1, 1, At, B1); PG8_BAR;
            }
        }
        if constexpr (ALIGN_EPI) { if (wr == 0) PG8_BAR; }
        E(acc, cur, wr, wc, fr, fq);
        if (!has_next) break;
#pragma unroll
        for (int a = 0; a < 2; ++a)
#pragma unroll
            for (int b = 0; b < 2; ++b)
#pragma unroll
                for (int m = 0; m < 4; ++m)
#pragma unroll
                    for (int n = 0; n < 2; ++n) acc[a][b][m][n] = (f32x4){0.f, 0.f, 0.f, 0.f};
        cur = nxt; cA = nA; cB = nB; ++ui;
        if constexpr (ALIGN_EPI) { if (wr == 1) PG8_BAR; }
    }
    PG8_WAIT_V(0);
    if constexpr (!ALIGN_EPI) { if (wr == 0) PG8_BAR; }
    PG8_BAR;
#undef PG8_SA
#undef PG8_SB
#undef PG8_STAGE
#undef PG8_LDA
#undef PG8_LDB
#undef PG8_MMA
#undef PG8_WAIT_V
#undef PG8_WAIT_L
#undef PG8_BAR
#undef PG8_SCHED
}
}

template <int ACT> __device__ __forceinline__ u32x4 act_pack8(f32x4 v0, f32x4 v1) {
    if (ACT == 1) {
#pragma unroll
        for (int j = 0; j < 4; ++j) { v0[j] = silu_f(v0[j]); v1[j] = silu_f(v1[j]); } }
    if (ACT == 2) {
#pragma unroll
        for (int j = 0; j < 4; ++j) { v0[j] = sigmoid_f(v0[j]); v1[j] = sigmoid_f(v1[j]); } }
    u32x4 w; w.x = cvt_pk_bf16(v0[0], v0[1]); w.y = cvt_pk_bf16(v0[2], v0[3]); w.z = cvt_pk_bf16(v1[0], v1[1]); w.w = cvt_pk_bf16(v1[2], v1[3]); return w;
}
template <int ACT> __device__ __forceinline__ void store_tile_bf16(const f32x4 (&acc)[2][2][4][2], bf16_t* p00  , bf16_t* p01  , int ldc) {
#pragma unroll
    for (int ai = 0; ai < 2; ++ai)
#pragma unroll
        for (int m = 0; m < 4; ++m) { const size_t ro = (size_t)(ai * 128 + m * 16) * ldc;
            *(u32x4*)(p00 + ro) = act_pack8<ACT>(acc[ai][0][m][0], acc[ai][0][m][1]);
            *(u32x4*)(p01 + ro) = act_pack8<ACT>(acc[ai][1][m][0], acc[ai][1][m][1]); }
}
struct EpiInProj {
    static constexpr bool PERM = true, HAS_MID = false; static constexpr int MID1 = -1, MID2 = -1;
    bf16_t *CQKV, *G, *AXb, *WINb, *MG; const float* const* tab; int lofs; const f32x2* rope; int S; PG8_LAS float* Pt; float* RS;
    __device__ __forceinline__ void operator()(const f32x4 (&acc)[2][2][4][2], const pg8::Unit& u, int wr, int wc, int fr, int fq) const {
        const int pn = u.pn; bf16_t* base; int ldc, colt, act;
        if (pn < 4)       { base = CQKV; ldc = 1024; colt = pn * 256;               act = 0; }
        else if (pn < 8)  { base = G;    ldc = 3072; colt = (pn - 4) * 256;         act = 1; }
        else if (pn < 14) { base = AXb;  ldc = 1536; colt = (pn - 8) * 256;         act = 0; }
        else if (pn < 18) { base = G;    ldc = 3072; colt = 1024 + (pn - 14) * 256; act = 1; }
        else if (pn < 24) { base = WINb; ldc = 1536; colt = (pn - 18) * 256;        act = 0; }
        else if (pn < 28) { base = G;    ldc = 3072; colt = 2048 + (pn - 24) * 256; act = 1; }
        else              { base = MG;   ldc = 6144; colt = (pn - 28) * 256;        act = 2; }
        bf16_t* p0 = base + (size_t)(u.pm * 256 + wr * 64 + fr) * ldc + colt + wc * 32 + 8 * fq;
        if (pn < 4) {
            float ss[2][4];
#pragma unroll
            for (int ai = 0; ai < 2; ++ai)
#pragma unroll
                for (int m = 0; m < 4; ++m) { float q = 0.f;
#pragma unroll
                    for (int bj = 0; bj < 2; ++bj) { const f32x4 a = acc[ai][bj][m][0], b = acc[ai][bj][m][1];
                        q += (a[0] * a[0] + a[1] * a[1]) + (a[2] * a[2] + a[3] * a[3]) + (b[0] * b[0] + b[1] * b[1]) + (b[2] * b[2] + b[3] * b[3]); }
                    q += __shfl_xor(q, 16); q += __shfl_xor(q, 32); ss[ai][m] = q; }
            if (fq == 0) {
#pragma unroll
                for (int ai = 0; ai < 2; ++ai)
#pragma unroll
                    for (int m = 0; m < 4; ++m) Pt[(ai * 128 + wr * 64 + m * 16 + fr) * 8 + wc] = ss[ai][m]; }
            asm volatile("s_waitcnt lgkmcnt(0)" ::: "memory"); __builtin_amdgcn_s_barrier(); asm volatile("" ::: "memory");
            if (wc == 0 && fq == 0) {
#pragma unroll
                for (int ai = 0; ai < 2; ++ai)
#pragma unroll
                    for (int m = 0; m < 4; ++m) { const int rt = ai * 128 + wr * 64 + m * 16 + fr; const f32x4 t = *(const PG8_LAS f32x4*)(Pt + rt * 8);
                        RS[(size_t)(u.pm * 256 + rt) * 4 + pn] = (t[0] + t[1]) + (t[2] + t[3]); } }
        }
        const bool isax = pn >= 8 && pn < 13;
        if (isax || (pn >= 18 && pn < 23)) {
            float ss[2][4][2];
#pragma unroll
            for (int ai = 0; ai < 2; ++ai)
#pragma unroll
                for (int m = 0; m < 4; ++m)
#pragma unroll
                    for (int bj = 0; bj < 2; ++bj) { const f32x4 a = acc[ai][bj][m][0], b = acc[ai][bj][m][1];
                        float q = (a[0] * a[0] + a[1] * a[1]) + (a[2] * a[2] + a[3] * a[3]) + (b[0] * b[0] + b[1] * b[1]) + (b[2] * b[2] + b[3] * b[3]);
                        q += __shfl_xor(q, 16); q += __shfl_xor(q, 32);
                        ss[ai][m][bj] = q; }
            if (fq == 0) {
#pragma unroll
                for (int ai = 0; ai < 2; ++ai)
#pragma unroll
                    for (int m = 0; m < 4; ++m)
#pragma unroll
                        for (int bj = 0; bj < 2; ++bj) Pt[(ai * 128 + wr * 64 + m * 16 + fr) * 8 + bj * 4 + wc] = ss[ai][m][bj]; }
            asm volatile("s_waitcnt lgkmcnt(0)" ::: "memory"); __builtin_amdgcn_s_barrier(); asm volatile("" ::: "memory");
            const int half = wc >> 1, f4 = ((wc & 1) * 4 + fq) * 4;
            const float* gv = tab[(isax ? 14 : 16) + ((pn == 12 || pn == 22) ? 1 : 0)] + lofs + (isax ? half * 64 + f4 : wc * 32 + 8 * fq);
            const float osc = (isax && pn < 12) ? 0.088388347648318440f * 1.4426950408889634f : 1.0f;
            const f32x4 g0 = *(const f32x4*)gv * osc, g1 = *(const f32x4*)(gv + (isax ? 32 : 4)) * osc;
#pragma unroll
            for (int ai = 0; ai < 2; ++ai) { f32x4 ca[4], cb[4];
#pragma unroll
                for (int m = 0; m < 4; ++m) { ca[m] = (f32x4){1.f, 0.f, 1.f, 0.f}; cb[m] = ca[m];
                    if (isax) { const int sq = (u.pm * 256 + ai * 128 + wr * 64 + m * 16 + fr) & (S - 1), pos = half ? (sq & 63) : (sq >> 6);
                        ca[m] = *(const f32x4*)(rope + (size_t)pos * 32 + f4); cb[m] = *(const f32x4*)(rope + (size_t)pos * 32 + f4 + 2); } }
#pragma unroll
                for (int m = 0; m < 4; ++m) { bf16_t* rp = p0 + (size_t)(ai * 128 + m * 16) * ldc; const f32x4 c01 = ca[m], c23 = cb[m];
#pragma unroll
                    for (int bj = 0; bj < 2; ++bj) { const f32x4 t = *(const PG8_LAS f32x4*)(Pt + (ai * 128 + wr * 64 + m * 16 + fr) * 8 + bj * 4);
                        const float rstd = __builtin_amdgcn_rsqf(((t[0] + t[1]) + (t[2] + t[3])) * (1.0f / 128) + 1e-6f);
                        const f32x4 x1 = acc[ai][bj][m][0] * rstd * g0, x2 = acc[ai][bj][m][1] * rstd * g1;
                        const f32x4 cs = {c01[0], c01[2], c23[0], c23[2]}, sn = {c01[1], c01[3], c23[1], c23[3]};
                        const f32x4 v0 = x1 * cs - x2 * sn, v1 = x2 * cs + x1 * sn;
                        u32x4 w; w.x = cvt_pk_bf16(v0[0], v0[1]); w.y = cvt_pk_bf16(v0[2], v0[3]); w.z = cvt_pk_bf16(v1[0], v1[1]); w.w = cvt_pk_bf16(v1[2], v1[3]);
                        *(u32x4*)(rp + bj * 128) = w; } } }
            return;
        }
        const float ka = (act == 2) ? 0.f : 1.f, kb = (act == 2) ? 1.f : 0.f, kc = (act == 0) ? 0.f : 1.f, kd = (act == 0) ? 1.f : 0.f;
#pragma unroll
        for (int ai = 0; ai < 2; ++ai)
#pragma unroll
            for (int m = 0; m < 4; ++m) { bf16_t* rp = p0 + (size_t)(ai * 128 + m * 16) * ldc;
#pragma unroll
                for (int bj = 0; bj < 2; ++bj) { f32x4 v0 = acc[ai][bj][m][0], v1 = acc[ai][bj][m][1];
#pragma unroll
                    for (int j = 0; j < 4; ++j) { if (act != 0) { v0[j] = (ka * v0[j] + kb) * sigmoid_f(v0[j]); v1[j] = (ka * v1[j] + kb) * sigmoid_f(v1[j]); } }
                    u32x4 w; w.x = cvt_pk_bf16(v0[0], v0[1]); w.y = cvt_pk_bf16(v0[2], v0[3]); w.z = cvt_pk_bf16(v1[0], v1[1]); w.w = cvt_pk_bf16(v1[2], v1[3]);
                    *(u32x4*)(rp + bj * 128) = w; } }
    }
};
struct EpiPlain {
    static constexpr bool PERM = true, HAS_MID = false; static constexpr int MID1 = -1, MID2 = -1;
    bf16_t* O; int ldc;
    __device__ __forceinline__ void operator()(const f32x4 (&acc)[2][2][4][2], const pg8::Unit& u, int wr, int wc, int fr, int fq) const {
        bf16_t* p0 = O + (size_t)(u.pm * 256 + wr * 64 + fr) * ldc + u.pn * 256 + wc * 32 + 8 * fq;
        store_tile_bf16<0>(acc, p0, p0 + 128, ldc);
    }
};
template <int MODE> __device__ __forceinline__ void store_tile_rowscaled(const f32x4 (&acc)[2][2][4][2], bf16_t* p00, bf16_t* p01, int ldc, const float* rs  ) {
#pragma unroll
    for (int ai = 0; ai < 2; ++ai) { f32x4 t[4];
#pragma unroll
        for (int m = 0; m < 4; ++m) t[m] = *(const f32x4*)(rs + (size_t)(ai * 128 + m * 16) * 4);
#pragma unroll
        for (int m = 0; m < 4; ++m) { const size_t ro = (size_t)(ai * 128 + m * 16) * ldc;
            const float rstd = MODE == 0 ? __builtin_amdgcn_rsqf((t[m][0] + t[m][1]) * (1.0f / 512) + 1e-6f) : __builtin_amdgcn_rsqf(t[m][2] * (1.0f / 256) + 1e-6f);
            *(u32x4*)(p00 + ro) = act_pack8<0>(acc[ai][0][m][0] * rstd, acc[ai][0][m][1] * rstd);
            *(u32x4*)(p01 + ro) = act_pack8<0>(acc[ai][1][m][0] * rstd, acc[ai][1][m][1] * rstd); } }
}
#define ROW_SS8(q, A, B) const float q = ((A)[0] * (A)[0] + (A)[1] * (A)[1]) + ((A)[2] * (A)[2] + (A)[3] * (A)[3]) + ((B)[0] * (B)[0] + (B)[1] * (B)[1]) + ((B)[2] * (B)[2] + (B)[3] * (B)[3])
struct EpiQUp {
    static constexpr bool PERM = true, HAS_MID = false; static constexpr int MID1 = -1, MID2 = -1;
    bf16_t* O; const float* RS; const float* gain  ; const f32x2* rope; int S; PG8_LAS float* Pt;
    __device__ __forceinline__ void operator()(const f32x4 (&acc)[2][2][4][2], const pg8::Unit& u, int wr, int wc, int fr, int fq) const {
        const int row = u.pm * 256 + wr * 64 + fr, cn = wc * 32 + 8 * fq;
        float ss[2][4];
#pragma unroll
        for (int ai = 0; ai < 2; ++ai)
#pragma unroll
            for (int m = 0; m < 4; ++m) { ROW_SS8(q0, acc[ai][0][m][0], acc[ai][0][m][1]); ROW_SS8(q1, acc[ai][1][m][0], acc[ai][1][m][1]); float q = q0 + q1;
                q += __shfl_xor(q, 16); q += __shfl_xor(q, 32); ss[ai][m] = q; }
        if (fq == 0) {
#pragma unroll
            for (int ai = 0; ai < 2; ++ai)
#pragma unroll
                for (int m = 0; m < 4; ++m) Pt[(ai * 128 + wr * 64 + m * 16 + fr) * 8 + wc] = ss[ai][m]; }
        asm volatile("s_waitcnt lgkmcnt(0)" ::: "memory"); __builtin_amdgcn_s_barrier(); asm volatile("" ::: "memory");
        const float osc = 0.072168783648703220f * 1.4426950408889634f;
        const int f4 = ((wc & 1) * 4 + fq) * 4;
        const f32x4 gn0 = *(const f32x4*)(gain + cn) * osc, gn1 = *(const f32x4*)(gain + cn + 4) * osc, gr0 = *(const f32x4*)(gain + 128 + f4) * osc, gr1 = *(const f32x4*)(gain + 160 + f4) * osc;
        bf16_t* p0 = O + (size_t)row * 1536 + u.pn * 192 + cn;
#pragma unroll
        for (int ai = 0; ai < 2; ++ai) { f32x4 t[4], ca[4], cb[4];
#pragma unroll
            for (int m = 0; m < 4; ++m) { t[m] = *(const f32x4*)(RS + (size_t)(row + ai * 128 + m * 16) * 4);
                const int sq = (row + ai * 128 + m * 16) & (S - 1); ca[m] = *(const f32x4*)(rope + (size_t)sq * 32 + f4); cb[m] = *(const f32x4*)(rope + (size_t)sq * 32 + f4 + 2); }
#pragma unroll
            for (int m = 0; m < 4; ++m) { const int rt = ai * 128 + wr * 64 + m * 16 + fr; const f32x4 pp = *(const PG8_LAS f32x4*)(Pt + rt * 8);
                const float rc = __builtin_amdgcn_rsqf((t[m][0] + t[m][1]) * (1.0f / 512) + 1e-6f);
                const float sc = rc * __builtin_amdgcn_rsqf(rc * rc * ((pp[0] + pp[1]) + (pp[2] + pp[3])) * (1.0f / 192) + 1e-6f);
                bf16_t* rp = p0 + (size_t)(ai * 128 + m * 16) * 1536;
                *(u32x4*)rp = act_pack8<0>(acc[ai][0][m][0] * sc * gn0, acc[ai][0][m][1] * sc * gn1);
                if (wc < 2) { const f32x4 c01 = ca[m], c23 = cb[m];
                    const f32x4 cs = {c01[0], c01[2], c23[0], c23[2]}, sn = {c01[1], c01[3], c23[1], c23[3]};
                    const f32x4 x1 = acc[ai][1][m][0] * sc * gr0, x2 = acc[ai][1][m][1] * sc * gr1;
                    *(u32x4*)(rp + 128) = act_pack8<0>(x1 * cs - x2 * sn, x2 * cs + x1 * sn); } } }
    }
};
struct EpiKV {
    static constexpr bool PERM = true, HAS_MID = false; static constexpr int MID1 = -1, MID2 = -1;
    bf16_t *KF, *VM; const float* RS; const bf16_t* CQKV; const float* gain  ; const f32x2* rope; int S; PG8_LAS float* Pt;
    __device__ __forceinline__ void operator()(const f32x4 (&acc)[2][2][4][2], const pg8::Unit& u, int wr, int wc, int fr, int fq) const {
        const int row = u.pm * 256 + wr * 64 + fr, cn = wc * 32 + 8 * fq;
        if (u.pn >= 4) { bf16_t* p0 = VM + (u.pn - 4) * 256 + (size_t)row * 1024 + cn; store_tile_rowscaled<1>(acc, p0, p0 + 128, 1024, RS + (size_t)row * 4); return; }
        float ss[2][4][2];
#pragma unroll
        for (int ai = 0; ai < 2; ++ai)
#pragma unroll
            for (int m = 0; m < 4; ++m)
#pragma unroll
                for (int bj = 0; bj < 2; ++bj) { ROW_SS8(q0, acc[ai][bj][m][0], acc[ai][bj][m][1]); float q = q0; q += __shfl_xor(q, 16); q += __shfl_xor(q, 32); ss[ai][m][bj] = q; }
        if (fq == 0) {
#pragma unroll
            for (int ai = 0; ai < 2; ++ai)
#pragma unroll
                for (int m = 0; m < 4; ++m)
#pragma unroll
                    for (int bj = 0; bj < 2; ++bj) Pt[(ai * 128 + wr * 64 + m * 16 + fr) * 8 + bj * 4 + wc] = ss[ai][m][bj]; }
        asm volatile("s_waitcnt lgkmcnt(0)" ::: "memory"); __builtin_amdgcn_s_barrier(); asm volatile("" ::: "memory");
        const int idx = wc * 4 + fq;
        const f32x4 g0 = *(const f32x4*)(gain + cn), g1 = *(const f32x4*)(gain + cn + 4); const f32x2 gx = *(const f32x2*)(gain + 128 + 2 * idx), gy = *(const f32x2*)(gain + 160 + 2 * idx);
        bf16_t* p0 = KF + (size_t)row * 1536 + (u.pn * 2) * 192 + cn;
        bf16_t* pr = KF + (size_t)row * 1536 + (u.pn * 2) * 192 + 128 + 8 * (idx >> 1) + 2 * (idx & 1);
#pragma unroll
        for (int ai = 0; ai < 2; ++ai) { f32x4 t[4]; unsigned k0[4], k1[4]; f32x4 cs[4];
#pragma unroll
            for (int m = 0; m < 4; ++m) { const size_t r = (size_t)(row + ai * 128 + m * 16); t[m] = *(const f32x4*)(RS + r * 4);
                k0[m] = *(const unsigned*)(CQKV + r * 1024 + 768 + 2 * idx); k1[m] = *(const unsigned*)(CQKV + r * 1024 + 800 + 2 * idx);
                cs[m] = *(const f32x4*)(rope + (size_t)((int)r & (S - 1)) * 32 + 2 * idx); }
#pragma unroll
            for (int m = 0; m < 4; ++m) { const int rt = ai * 128 + wr * 64 + m * 16 + fr;
                const float rc = __builtin_amdgcn_rsqf(t[m][2] * (1.0f / 256) + 1e-6f);
                const float x0 = bf_lo(k0[m]), x1 = bf_hi(k0[m]), y0 = bf_lo(k1[m]), y1 = bf_hi(k1[m]);
#pragma unroll
                for (int bj = 0; bj < 2; ++bj) { const f32x4 pp = *(const PG8_LAS f32x4*)(Pt + rt * 8 + bj * 4);
                    const float rk = __builtin_amdgcn_rsqf((rc * rc * ((pp[0] + pp[1]) + (pp[2] + pp[3])) + t[m][3]) * (1.0f / 192) + 1e-6f), sc = rc * rk;
                    const size_t ro = (size_t)(ai * 128 + m * 16) * 1536 + bj * 192;
                    *(u32x4*)(p0 + ro) = act_pack8<0>(acc[ai][bj][m][0] * sc * g0, acc[ai][bj][m][1] * sc * g1);
                    const float a0 = x0 * rk * gx.x, a1 = x1 * rk * gx.y, b0 = y0 * rk * gy.x, b1 = y1 * rk * gy.y;
                    *(unsigned*)(pr + ro) = cvt_pk_bf16(a0 * cs[m][0] - b0 * cs[m][1], a1 * cs[m][2] - b1 * cs[m][3]);
                    *(unsigned*)(pr + ro + 4) = cvt_pk_bf16(b0 * cs[m][0] + a0 * cs[m][1], b1 * cs[m][2] + a1 * cs[m][3]); } } }
    }
};
struct EpiBranchFused {
    static constexpr bool PERM = true, HAS_MID = true; static constexpr int MID1 = 16, MID2 = 32;
    const bf16_t* MG; bf16_t* YB;
    __device__ __forceinline__ void mid(f32x4 (&acc)[2][2][4][2], const pg8::Unit& u, int t, int wr, int wc, int fr, int fq) const {
        const int b = (t == MID1) ? 0 : 1; const bf16_t* g0 = MG + (size_t)(u.pm * 256 + wr * 64 + fr) * 6144 + b * 2048 + u.pn * 256 + wc * 32 + 8 * fq;
#pragma unroll
        for (int ai = 0; ai < 2; ++ai) {
            u32x4 a[4][2], d[4][2];
#pragma unroll
            for (int m = 0; m < 4; ++m)
#pragma unroll
                for (int bj = 0; bj < 2; ++bj) { const bf16_t* gp = g0 + (size_t)(ai * 128 + m * 16) * 6144 + bj * 128; a[m][bj] = *(const u32x4*)gp; d[m][bj] = *(const u32x4*)(gp + 2048); }
#define RAT(x, y) ((x) * __builtin_amdgcn_rcpf(fmaxf((y), 1e-20f)))
#pragma unroll
            for (int m = 0; m < 4; ++m)
#pragma unroll
                for (int bj = 0; bj < 2; ++bj) { const u32x4 A = a[m][bj], D = d[m][bj];
                    acc[ai][bj][m][0][0] *= RAT(bf_lo(A.x), bf_lo(D.x)); acc[ai][bj][m][0][1] *= RAT(bf_hi(A.x), bf_hi(D.x)); acc[ai][bj][m][0][2] *= RAT(bf_lo(A.y), bf_lo(D.y)); acc[ai][bj][m][0][3] *= RAT(bf_hi(A.y), bf_hi(D.y));
                    acc[ai][bj][m][1][0] *= RAT(bf_lo(A.z), bf_lo(D.z)); acc[ai][bj][m][1][1] *= RAT(bf_hi(A.z), bf_hi(D.z)); acc[ai][bj][m][1][2] *= RAT(bf_lo(A.w), bf_lo(D.w)); acc[ai][bj][m][1][3] *= RAT(bf_hi(A.w), bf_hi(D.w)); }
#undef RAT
            __builtin_amdgcn_sched_barrier(0); }
    }
    __device__ __forceinline__ void operator()(const f32x4 (&acc)[2][2][4][2], const pg8::Unit& u, int wr, int wc, int fr, int fq) const {
        const int row0 = u.pm * 256 + wr * 64 + fr, col0 = u.pn * 256 + wc * 32 + 8 * fq;
#pragma unroll
        for (int ai = 0; ai < 2; ++ai) {
            u32x4 gwv[4][2];
#pragma unroll
            for (int m = 0; m < 4; ++m)
#pragma unroll
                for (int bj = 0; bj < 2; ++bj) gwv[m][bj] = *(const u32x4*)(MG + (size_t)(row0 + ai * 128 + m * 16) * 6144 + 2 * 2048 + col0 + bj * 128);
#pragma unroll
            for (int m = 0; m < 4; ++m)
#pragma unroll
                for (int bj = 0; bj < 2; ++bj) { const size_t r = (size_t)(row0 + ai * 128 + m * 16); const int c = col0 + bj * 128; const u32x4 gw = gwv[m][bj];
                    f32x4 v0 = acc[ai][bj][m][0], v1 = acc[ai][bj][m][1];
                    v0[0] *= bf_lo(gw.x); v0[1] *= bf_hi(gw.x); v0[2] *= bf_lo(gw.y); v0[3] *= bf_hi(gw.y);
                    v1[0] *= bf_lo(gw.z); v1[1] *= bf_hi(gw.z); v1[2] *= bf_lo(gw.w); v1[3] *= bf_hi(gw.w);
                    u32x4 w; w.x = cvt_pk_bf16(v0[0], v0[1]); w.y = cvt_pk_bf16(v0[2], v0[3]); w.z = cvt_pk_bf16(v1[0], v1[1]); w.w = cvt_pk_bf16(v1[2], v1[3]); *(u32x4*)(YB + r * 2048 + c) = w; }
            __builtin_amdgcn_sched_barrier(0); }
    }
};
struct EpiOut {
    static constexpr bool PERM = false, HAS_MID = false; static constexpr int MID1 = -1, MID2 = -1;
    const float* X; float* O; const float* gate0  ; int bbase, S;
    __device__ __forceinline__ void operator()(const f32x4 (&acc)[2][2][4][2], const pg8::Unit& u, int wr, int wc, int fr, int fq) const {
        const int row0 = u.pm * 256 + wr * 64 + fr, col0 = u.pn * 256 + wc * 32 + 4 * fq;
        const float* gp = gate0 + (size_t)(bbase + (u.pm * 256) / S) * 6144 + col0;
        f32x4 gv[2][2];
#pragma unroll
        for (int bj = 0; bj < 2; ++bj)
#pragma unroll
            for (int n = 0; n < 2; ++n) gv[bj][n] = *(const f32x4*)(gp + bj * 128 + n * 16);
#pragma unroll
        for (int ai = 0; ai < 2; ++ai) {
            f32x4 xv[4][2][2];
#pragma unroll
            for (int m = 0; m < 4; ++m)
#pragma unroll
                for (int bj = 0; bj < 2; ++bj)
#pragma unroll
                    for (int n = 0; n < 2; ++n) xv[m][bj][n] = *(const f32x4*)(X + (size_t)(row0 + ai * 128 + m * 16) * 2048 + col0 + bj * 128 + n * 16);
#pragma unroll
            for (int m = 0; m < 4; ++m)
#pragma unroll
                for (int bj = 0; bj < 2; ++bj)
#pragma unroll
                    for (int n = 0; n < 2; ++n) *(f32x4*)(O + (size_t)(row0 + ai * 128 + m * 16) * 2048 + col0 + bj * 128 + n * 16) = xv[m][bj][n] + gv[bj][n] * acc[ai][bj][m][n];
            __builtin_amdgcn_sched_barrier(0); }
    }
};
namespace att {
constexpr int NW = 8, QBLK = 32, KVBLK = 64;
constexpr float THR = 8.f;
constexpr size_t SHM_V = KVBLK * 128 * 2;
#define KSWZ(row, colB) ((row) * 256 + ((colB) ^ (((row) & 15) << 4)))
#define KSWZ192(row, colB) ((row) * 384 + ((colB) ^ ((((row) >> 1) & 7) << 4)))
#define SBAR() __builtin_amdgcn_sched_barrier(0)
__device__ __forceinline__ int crow(int r, int hi) { return (r & 3) + 8 * (r >> 2) + 4 * hi; }
__device__ __forceinline__ unsigned cvtpk(float lo, float hi) { unsigned r; asm volatile("v_cvt_pk_bf16_f32 %0, %1, %2" : "=v"(r) : "v"(lo), "v"(hi)); return r; }
__device__ __forceinline__ bf16x8 ld8(const bf16_t* p) { return *reinterpret_cast<const bf16x8*>(p); }

template <bool WIN, int PRESC = 0> __device__ __forceinline__ void partialSM(f32x16& p0, f32x16& p1, float& m_reg, float& mn, float& alpha, const float C, const float* tl) {
  if constexpr (!WIN && (PRESC == 1 || PRESC == 2)) {
    alpha = 1.f; mn = 0.f;
#pragma unroll
    for (int r = 0; r < 16; ++r) p0[r] = __builtin_amdgcn_exp2f(p0[r]);
    return;
  }
  if constexpr (!WIN) {
    const float mneg = m_reg;
    alpha = 1.f; mn = 0.f; const float Cq = (PRESC == 3) ? 1.0f : C;
#pragma unroll
    for (int r = 0; r < 16; ++r) { p0[r] = __builtin_amdgcn_exp2f(fmaf(p0[r], Cq, mneg)); p1[r] = fmaf(p1[r], Cq, mneg); }
    return;
  }
  if constexpr (WIN) {
#pragma unroll
    for (int r = 0; r < 16; ++r) { p0[r] = fmaf(p0[r], C, tl[(r & 3) + 8 * (r >> 2)]); p1[r] = fmaf(p1[r], C, tl[32 + (r & 3) + 8 * (r >> 2)]); }
  }
  float pmax = p0[0];
#pragma unroll
  for (int r = 1; r < 16; ++r) pmax = fmaxf(pmax, p0[r]);
#pragma unroll
  for (int r = 0; r < 16; ++r) pmax = fmaxf(pmax, p1[r]);
  { auto rr = __builtin_amdgcn_permlane32_swap(__float_as_uint(pmax), __float_as_uint(pmax), false, false);
    pmax = fmaxf(__uint_as_float(rr[0]), __uint_as_float(rr[1])); }
  if constexpr (WIN) {
    if (__builtin_expect(__all(pmax - m_reg <= THR * 1.4426950408889634f), 1)) { mn = m_reg; alpha = 1.f; }
    else { mn = fmaxf(m_reg, pmax); alpha = __builtin_amdgcn_exp2f(m_reg - mn); m_reg = mn; }
#pragma unroll
    for (int r = 0; r < 16; ++r) { p0[r] -= mn; p1[r] -= mn; }
  } else {
    if (__builtin_expect(__all((pmax - m_reg) * C <= THR * 1.4426950408889634f), 1)) { mn = m_reg; alpha = 1.f; }
    else { mn = fmaxf(m_reg, pmax); alpha = __builtin_amdgcn_exp2f((m_reg - mn) * C); m_reg = mn; }
    const float mnC = -mn * C;
#pragma unroll
    for (int r = 0; r < 16; ++r) { p0[r] = fmaf(p0[r], C, mnC); p1[r] = fmaf(p1[r], C, mnC); }
  }
#pragma unroll
  for (int r = 0; r < 16; ++r) p0[r] = __builtin_amdgcn_exp2f(p0[r]);
}
__device__ __forceinline__ void finishSM(f32x16& p0, f32x16& p1, float alpha, float& l_reg, bf16x8& pa0, bf16x8& pa1, bf16x8& pa2, bf16x8& pa3) {
#pragma unroll
  for (int r = 0; r < 16; ++r) p1[r] = __builtin_amdgcn_exp2f(p1[r]);
  float ps = 0;
#pragma unroll
  for (int r = 0; r < 16; ++r) ps += p0[r];
#pragma unroll
  for (int r = 0; r < 16; ++r) ps += p1[r];
  { auto rr = __builtin_amdgcn_permlane32_swap(__float_as_uint(ps), __float_as_uint(ps), false, false);
    ps = __uint_as_float(rr[0]) + __uint_as_float(rr[1]); }
  l_reg = l_reg * alpha + ps;
#define PK4(P, BASE, OUT) do { unsigned a0 = cvtpk(P[BASE + 0], P[BASE + 1]), a1 = cvtpk(P[BASE + 2], P[BASE + 3]);   \
    unsigned b0 = cvtpk(P[BASE + 4], P[BASE + 5]), b1 = cvtpk(P[BASE + 6], P[BASE + 7]);                              \
    auto r0 = __builtin_amdgcn_permlane32_swap(a0, b0, false, false); auto r1 = __builtin_amdgcn_permlane32_swap(a1, b1, false, false); \
    u32x4 w = {r0[0], r1[0], r0[1], r1[1]}; OUT = *reinterpret_cast<bf16x8*>(&w); } while (0)
  PK4(p0, 0, pa0); PK4(p0, 8, pa1); PK4(p1, 0, pa2); PK4(p1, 8, pa3);
#undef PK4
}
template <int DK> __device__ __forceinline__ void qkt(f32x16& p0, f32x16& p1, const char* Ks, const bf16x8* qr, int r32, int hi, const float init = 0.f) {
#pragma unroll
  for (int r = 0; r < 16; ++r) { p0[r] = init; p1[r] = init; }
#pragma unroll
  for (int d0 = 0; d0 < DK / 16; ++d0) { const int cb = (d0 * 16 + hi * 8) * 2;
    const bf16x8 b0 = *reinterpret_cast<const bf16x8*>(Ks + (DK == 128 ? KSWZ(r32, cb) : KSWZ192(r32, cb)));
    const bf16x8 b1 = *reinterpret_cast<const bf16x8*>(Ks + (DK == 128 ? KSWZ(32 + r32, cb) : KSWZ192(32 + r32, cb)));
    p0 = __builtin_amdgcn_mfma_f32_32x32x16_bf16(b0, qr[d0], p0, 0, 0, 0);
    p1 = __builtin_amdgcn_mfma_f32_32x32x16_bf16(b1, qr[d0], p1, 0, 0, 0); }
}
__device__ __forceinline__ int v_st(int k, int c) { const int kk = (k & ~0xC) | ((k & 4) << 1) | ((k & 8) >> 1); return ((kk >> 3) * 4 + (c >> 5)) * 512 + ((kk & 7) * 32 + (c & 31)) * 2; }
__device__ __forceinline__ int v_rd_base(int lane) { return ((lane & 3) << 3) | (((lane >> 2) & 3) << 6) | (((lane >> 4) & 1) << 5) | (((lane >> 5) & 1) << 8); }
constexpr int v_rd_off(int d0, int ks, int half) { return d0 * 512 + ks * 4096 + half * 2048; }
template <int OFF> __device__ __forceinline__ s16x4 tr_read(int vb) {
  s16x4 r; asm volatile("ds_read_b64_tr_b16 %0, %1 offset:%2" : "=&v"(r) : "v"(vb), "i"(OFF) : "memory"); return r;
}
template <int D0> __device__ __forceinline__ void pv_one(f32x16& od, int vb, bf16x8 pa0, bf16x8 pa1, bf16x8 pa2, bf16x8 pa3) {
  const s16x4 l0 = tr_read<v_rd_off(D0, 0, 0)>(vb), h0 = tr_read<v_rd_off(D0, 0, 1)>(vb), l1 = tr_read<v_rd_off(D0, 1, 0)>(vb), h1 = tr_read<v_rd_off(D0, 1, 1)>(vb);
  const s16x4 l2 = tr_read<v_rd_off(D0, 2, 0)>(vb), h2 = tr_read<v_rd_off(D0, 2, 1)>(vb), l3 = tr_read<v_rd_off(D0, 3, 0)>(vb), h3 = tr_read<v_rd_off(D0, 3, 1)>(vb);
  asm volatile("s_waitcnt lgkmcnt(0)" ::: "memory"); SBAR();
#define PK(L, H) (bf16x8){L[0], L[1], L[2], L[3], H[0], H[1], H[2], H[3]}
  od = __builtin_amdgcn_mfma_f32_32x32x16_bf16(pa0, PK(l0, h0), od, 0, 0, 0);
  od = __builtin_amdgcn_mfma_f32_32x32x16_bf16(pa1, PK(l1, h1), od, 0, 0, 0);
  od = __builtin_amdgcn_mfma_f32_32x32x16_bf16(pa2, PK(l2, h2), od, 0, 0, 0);
  od = __builtin_amdgcn_mfma_f32_32x32x16_bf16(pa3, PK(l3, h3), od, 0, 0, 0);
#undef PK
}
__device__ __forceinline__ void pv_d0(f32x16* o, int vb, bf16x8 pa0, bf16x8 pa1, bf16x8 pa2, bf16x8 pa3) {
  pv_one<0>(o[0], vb, pa0, pa1, pa2, pa3); pv_one<1>(o[1], vb, pa0, pa1, pa2, pa3); pv_one<2>(o[2], vb, pa0, pa1, pa2, pa3); pv_one<3>(o[3], vb, pa0, pa1, pa2, pa3);
}
constexpr size_t lds_bytes(int DK) { return 2 * SHM_V + 2 * (size_t)KVBLK * DK * 2 + NW * 64 * 4 + 768 * 4; }

template <int DK, int SD, int LDQ, int LDK, int LDV, int LDO, bool WIN, int PRESC = 0>
__device__ __forceinline__ void attn_unit(const bf16_t* __restrict__ Qb, const bf16_t* __restrict__ Kh, const bf16_t* __restrict__ Vh, bf16_t* __restrict__ Ob,
                                          const int NT, const float m_init, const float l_init, const float* __restrict__ tbg, const int tb0, char* lds) {
  constexpr int ND = DK / 16;
  constexpr size_t SHM_K = (size_t)KVBLK * DK * 2;
  constexpr float SCALE = (DK == 128) ? 0.088388347648318440f : 0.072168783648703220f;
  constexpr float C = SCALE * 1.4426950408889634f;
  int tid_ = threadIdx.x; asm volatile("" : "+v"(tid_));
  const int tid = tid_, wid = tid >> 6, lane = tid & 63, r32 = lane & 31, hi = lane >> 5;
  char* V_lds = lds; char* K_lds = lds + 2 * SHM_V;
  float* ws = (float*)(lds + 2 * SHM_V + 2 * SHM_K) + wid * 64; float* li_l = ws; float* al_l = ws + 32;
  float* tbl = (float*)(lds + 2 * SHM_V + 2 * SHM_K + NW * 64 * 4);
  const float* tlw = tbl + (tb0 - wid * 32 - r32 + 4 * hi);
  float m_reg = m_init, l_reg = l_init; f32x16 o[4] = {}; bf16x8 qr[ND];
  const bf16_t* Qw = Qb + (long)(wid * QBLK + r32) * LDQ + hi * 8;
#pragma unroll
  for (int d0 = 0; d0 < ND; ++d0) qr[d0] = ld8(Qw + d0 * 16);
  const int sr = tid >> 4, sc = (tid & 15) * 8, vst0 = v_st(sr, sc), vst1 = v_st(32 + sr, sc);
  const int kr0 = tid >> 3, kc0 = tid & 7;
  const int vb0 = (int)(uintptr_t)V_lds + v_rd_base(lane);
  struct Slot { bf16x8 vs0, vs1, ks0, ks1, ks2; } sr_[SD];
#define SLOAD(i, k0) do { sr_[i].vs0 = ld8(&Vh[(long)((k0) + sr) * LDV + sc]); sr_[i].vs1 = ld8(&Vh[(long)((k0) + 32 + sr) * LDV + sc]); \
    if constexpr (DK == 128) { sr_[i].ks0 = ld8(&Kh[(long)((k0) + sr) * LDK + sc]); sr_[i].ks1 = ld8(&Kh[(long)((k0) + 32 + sr) * LDK + sc]); } \
    else { const bf16_t* kp_ = &Kh[(long)((k0) + kr0) * LDK + kc0 * 8]; sr_[i].ks0 = ld8(kp_); sr_[i].ks1 = ld8(kp_ + 64); sr_[i].ks2 = ld8(kp_ + 128); } } while (0)
#define SWRITE(b, i) do { *(bf16x8*)(V_lds + (b) * SHM_V + vst0) = sr_[i].vs0; *(bf16x8*)(V_lds + (b) * SHM_V + vst1) = sr_[i].vs1; \
    if constexpr (DK == 128) { const int kc = sc * 2; *(bf16x8*)(K_lds + (b) * SHM_K + KSWZ(sr, kc)) = sr_[i].ks0; *(bf16x8*)(K_lds + (b) * SHM_K + KSWZ(32 + sr, kc)) = sr_[i].ks1; } \
    else { char* kw_ = K_lds + (b) * SHM_K + KSWZ192(kr0, kc0 * 16); *(bf16x8*)kw_ = sr_[i].ks0; *(bf16x8*)(kw_ + 128) = sr_[i].ks1; *(bf16x8*)(kw_ + 256) = sr_[i].ks2; } } while (0)
#define SWAIT() do { if constexpr (SD == 2) { if constexpr (DK == 128) asm volatile("s_waitcnt vmcnt(4)" ::: "memory"); else asm volatile("s_waitcnt vmcnt(5)" ::: "memory"); } \
    else asm volatile("s_waitcnt vmcnt(0)" ::: "memory"); } while (0)
#define RESC(a) do { if constexpr (WIN) if (__any((a) < 1.f)) { if (hi == 0) al_l[r32] = (a); asm volatile("s_waitcnt lgkmcnt(0)" ::: "memory"); \
    _Pragma("unroll") for (int d = 0; d < 4; ++d) _Pragma("unroll") for (int r = 0; r < 16; ++r) o[d][r] *= al_l[crow(r, hi)]; } } while (0)
  f32x16 pA0, pA1, pB0, pB1; float mnA, mnB, alA, alB; bf16x8 pa0, pa1, pa2, pa3;
  constexpr int SE = 0, SO = SD - 1;
  SLOAD(SE, 0);
  __syncthreads();
  if constexpr (WIN) { for (int i = tid; i < 768; i += 512) tbl[i] = tbg[i]; }
  asm volatile("s_waitcnt vmcnt(0)" ::: "memory"); SWRITE(0, SE); __syncthreads();
  qkt<DK>(pA0, pA1, K_lds, qr, r32, hi, (PRESC == 1) ? m_init : 0.f); partialSM<WIN, PRESC>(pA0, pA1, m_reg, mnA, alA, C, tlw);
  SLOAD(SO, KVBLK); if constexpr (SD == 2) { if (2 < NT) SLOAD(SE, 2 * KVBLK); }
  SWAIT(); SWRITE(1, SO); __syncthreads();
  for (int j = 1; j + 1 < NT; j += 2) {
    SBAR(); qkt<DK>(pB0, pB1, K_lds + SHM_K, qr, r32, hi, (PRESC == 1) ? m_init : 0.f);
    finishSM(pA0, pA1, alA, l_reg, pa0, pa1, pa2, pa3); SBAR();
    SLOAD(SO, (j + SD) * KVBLK); SBAR();
    pv_d0(o, vb0, pa0, pa1, pa2, pa3); partialSM<WIN, PRESC>(pB0, pB1, m_reg, mnB, alB, C, tlw + 64 * j);
    __syncthreads(); SWAIT(); SWRITE(0, SE);
    RESC(alB); __syncthreads();
    SBAR(); qkt<DK>(pA0, pA1, K_lds, qr, r32, hi, (PRESC == 1) ? m_init : 0.f);
    finishSM(pB0, pB1, alB, l_reg, pa0, pa1, pa2, pa3); SBAR();
    if (SD == 1 || j + 3 < NT) SLOAD(SE, (j + 1 + SD) * KVBLK); SBAR();
    pv_d0(o, vb0 + (int)SHM_V, pa0, pa1, pa2, pa3); partialSM<WIN, PRESC>(pA0, pA1, m_reg, mnA, alA, C, tlw + 64 * (j + 1));
    __syncthreads(); SWAIT(); SWRITE(1, SO);
    RESC(alA); __syncthreads();
  }
  SBAR(); qkt<DK>(pB0, pB1, K_lds + SHM_K, qr, r32, hi, (PRESC == 1) ? m_init : 0.f);
  finishSM(pA0, pA1, alA, l_reg, pa0, pa1, pa2, pa3); SBAR();
  pv_d0(o, vb0, pa0, pa1, pa2, pa3); partialSM<WIN, PRESC>(pB0, pB1, m_reg, mnB, alB, C, tlw + 64 * (NT - 1));
  __syncthreads(); RESC(alB);
  finishSM(pB0, pB1, alB, l_reg, pa0, pa1, pa2, pa3); SBAR();
  pv_d0(o, vb0 + (int)SHM_V, pa0, pa1, pa2, pa3);
  if (hi == 0) li_l[r32] = l_reg; asm volatile("s_waitcnt lgkmcnt(0)" ::: "memory");
  __syncthreads();
  const int widu = __builtin_amdgcn_readfirstlane(wid);
  bf16_t* stg = (bf16_t*)(lds + widu * 8192);
#pragma unroll
  for (int r = 0; r < 16; ++r) { const int orow = crow(r, hi); const float rl = __builtin_amdgcn_rcpf(li_l[orow]);
#pragma unroll
    for (int d0 = 0; d0 < 4; ++d0) stg[orow * 128 + d0 * 32 + r32] = f2bf(o[d0][r] * rl); }
  asm volatile("s_waitcnt lgkmcnt(0)" ::: "memory");
  bf16_t* Og = Ob + (long)(widu * QBLK) * LDO;
#pragma unroll
  for (int ib = 0; ib < 8; ib += 4) {
    u32x4 gv[4];
#pragma unroll
    for (int i = 0; i < 4; ++i) { const int q = (ib + i) * 64 + lane; gv[i] = *(const u32x4*)(Og + (long)(q >> 4) * LDO + (q & 15) * 8); }
#pragma unroll
    for (int i = 0; i < 4; ++i) { const int q = (ib + i) * 64 + lane; const u32x4 ov = *(const u32x4*)(stg + (q >> 4) * 128 + (q & 15) * 8); const u32x4 g = gv[i]; u32x4 w;
      w.x = cvtpk(bf_lo(ov.x) * bf_lo(g.x), bf_hi(ov.x) * bf_hi(g.x)); w.y = cvtpk(bf_lo(ov.y) * bf_lo(g.y), bf_hi(ov.y) * bf_hi(g.y));
      w.z = cvtpk(bf_lo(ov.z) * bf_lo(g.z), bf_hi(ov.z) * bf_hi(g.z)); w.w = cvtpk(bf_lo(ov.w) * bf_lo(g.w), bf_hi(ov.w) * bf_hi(g.w));
      *(u32x4*)(Og + (long)(q >> 4) * LDO + (q & 15) * 8) = w; }
  }
#undef SLOAD
#undef SWRITE
#undef SWAIT
#undef RESC
}
}
constexpr int DM = 2048, DEPTH = 4, NPASS = 2, TPMAX = 32768, NIN = 13120, NINP = 13312, NWAVES = 8;
constexpr int T_PROMPT = 32768, T_SAMPLE = 16384;
constexpr float RMS_EPS = 1e-6f;
constexpr int KS_ADA = 32;
constexpr int NSTEP_PRO = 2, NSTEP_IT = 8, NSTEPS = NSTEP_PRO + DEPTH * NPASS * NSTEP_IT;
constexpr size_t MiB = 1u << 20;
constexpr size_t WS_CTL = 0, CTL_ZERO_BYTES = 1 * MiB;
constexpr size_t WS_PTRS = 512 * 1024;
constexpr size_t WS_MOD = 1 * MiB;
constexpr size_t WS_ROPE = 3 * MiB;
constexpr size_t WS_TB = 4 * MiB;
constexpr size_t WS_MODP = 5 * MiB;
constexpr size_t WS_RS = 54 * MiB;
constexpr size_t WS_WIN_T = 64 * MiB;
constexpr size_t WS_WQ_T = 55 * MiB;
constexpr size_t WS_WKV_T = 278 * MiB;
constexpr size_t WS_WBR_T = 282 * MiB;
constexpr size_t WS_WOUT_T = 330 * MiB;
constexpr size_t WS_H = 362 * MiB;
constexpr size_t WS_CQKV = 490 * MiB;
constexpr size_t WS_QM = 554 * MiB;
constexpr size_t WS_KF = 650 * MiB;
constexpr size_t WS_VM = 746 * MiB;
constexpr size_t WS_AX = 810 * MiB;
constexpr size_t WS_WINB = 906 * MiB;
constexpr size_t WS_G = 1002 * MiB;
constexpr size_t WS_MG = 1194 * MiB;
constexpr size_t WS_END = 1578 * MiB;
static_assert(WS_WIN_T + (size_t)4 * NINP * DM * 2 <= WS_WKV_T - 6 * MiB && WS_RS + (size_t)TPMAX * 16 <= WS_WQ_T && WS_WQ_T + (size_t)4 * 2048 * 512 * 2 <= WS_WIN_T && WS_MODP + (size_t)KS_ADA * 4 * 16 * 6144 * 4 <= WS_WIN_T && WS_MG + (size_t)TPMAX * 6144 * 2 <= WS_END && WS_H + (size_t)TPMAX * 2048 * 2 <= WS_CQKV, "d_ws map");
constexpr int RING_OFF = 0, RING_BYTES = 131072;
constexpr int LDSCTL_OFF = RING_BYTES;
constexpr int LDS_BYTES = 147456;
static_assert(att::lds_bytes(192) <= RING_BYTES, "attention LDS");

#define LDS_WAIT() asm volatile("s_waitcnt lgkmcnt(0)" ::: "memory")
#define VM_WAIT() asm volatile("s_waitcnt vmcnt(0)" ::: "memory")

#define XB_TMO      128
#define XB_XCNT(j)  (256  + 64 * (j))
#define XB_XSUB(j)  (1280 + 64 * (j))
#define XB_XGEN(j)  (2304 + 64 * (j))
#define XB_TOP      3328
#define XB_TOPGEN   3392
#define XCD_BAR_WORDS 3456
#define XB_SPIN_CAP (1u << 22)

__device__ __forceinline__ unsigned xb_ld(unsigned* p)              { return __hip_atomic_load(p, __ATOMIC_RELAXED, __HIP_MEMORY_SCOPE_AGENT); }
__device__ __forceinline__ unsigned xb_add(unsigned* p, unsigned v) { return __hip_atomic_fetch_add(p, v, __ATOMIC_RELAXED, __HIP_MEMORY_SCOPE_AGENT); }
__device__ __forceinline__ unsigned xb_xcc_id() { return (unsigned)__builtin_amdgcn_s_getreg((3 << 11) | 20) & 0xFu; }
#define XB_SPIN(cond, bar) do { unsigned _sp = 0; while (cond) { __builtin_amdgcn_s_sleep(1); \
    if ((++_sp & 255u) == 0u) { if (xb_ld(&(bar)[XB_TMO])) break; if (_sp > XB_SPIN_CAP) { atomicAdd(&(bar)[XB_TMO], 1u); break; } } } } while (0)

struct XcdBarrier {
    unsigned* bar; unsigned x;
    volatile LAS unsigned* st;
};
__device__ __forceinline__ XcdBarrier xcd_barrier_post(unsigned* bar, volatile LAS unsigned* st) {
    XcdBarrier b; b.bar = bar; b.x = xb_xcc_id(); b.st = st;
    if (threadIdx.x == 0) (void)xb_add(&bar[XB_XCNT(b.x)], 1u);
    return b;
}
__device__ __forceinline__ void xcd_barrier_complete(unsigned* bar, unsigned x, unsigned& nloc, unsigned& nx) {
    const unsigned G = gridDim.x * gridDim.y * gridDim.z;
    unsigned sum, cnt, mine, sp = 0u;
    for (;;) {
        sum = 0u; cnt = 0u; mine = 0u;
#pragma unroll
        for (unsigned j = 0; j < 16; ++j) { const unsigned c = xb_ld(&bar[XB_XCNT(j)]); sum += c; cnt += (c > 0u) ? 1u : 0u; }
        mine = xb_ld(&bar[XB_XCNT(x)]);
        if (sum == G) break;
        __builtin_amdgcn_s_sleep(1);
        if ((++sp & 255u) == 0u) { if (xb_ld(&bar[XB_TMO])) break; if (sp > XB_SPIN_CAP) { atomicAdd(&bar[XB_TMO], 1u); break; } }
    }
    nloc = mine > 0u ? mine : 1u; nx = cnt > 0u ? cnt : 1u;
}
__device__ __forceinline__ void xcd_barrier(const XcdBarrier& b) {
    asm volatile("s_waitcnt vmcnt(0)" ::: "memory");
    __syncthreads();
    if (threadIdx.x == 0) {
        unsigned* bar = b.bar;
        __builtin_amdgcn_s_waitcnt(0);
        unsigned nloc = b.st[0], nx = b.st[1];
        if (nloc == 0u) { xcd_barrier_complete(bar, b.x, nloc, nx); b.st[0] = nloc; b.st[1] = nx; }
        const unsigned old = xb_add(&bar[XB_XSUB(b.x)], 1u);
        const unsigned gen = old / nloc;
        if (old + 1u == (gen + 1u) * nloc) {
            __builtin_amdgcn_fence(__ATOMIC_RELEASE, "agent");
            asm volatile("s_waitcnt vmcnt(0)" ::: "memory");
            const unsigned og = xb_add(&bar[XB_TOP], 1u);
            const unsigned tg = og / nx;
            if (og + 1u == (tg + 1u) * nx) xb_add(&bar[XB_TOPGEN], 1u);
            else XB_SPIN(xb_ld(&bar[XB_TOPGEN]) == tg, bar);
            __builtin_amdgcn_fence(__ATOMIC_ACQUIRE, "agent");
            xb_add(&bar[XB_XGEN(b.x)], 1u);
            asm volatile("s_waitcnt vmcnt(0)" ::: "memory");
        } else {
            XB_SPIN(xb_ld(&bar[XB_XGEN(b.x)]) == gen, bar);
            __builtin_amdgcn_fence(__ATOMIC_ACQUIRE, "agent");
            asm volatile("s_waitcnt vmcnt(0)" ::: "memory");
        }
    }
    __syncthreads();
}

template <int CTRL> __device__ __forceinline__ float dpp_f(float v) { return __builtin_bit_cast(float, __builtin_amdgcn_update_dpp(0, __builtin_bit_cast(int, v), CTRL, 0xf, 0xf, true)); }
__device__ __forceinline__ float sum16(float v) {
    v += dpp_f<0xB1>(v); v += dpp_f<0x4E>(v); v += dpp_f<0x141>(v); v += dpp_f<0x140>(v); return v;
}
__device__ __forceinline__ float wave_sum(float v) {
    v = sum16(v);
    const int b = __builtin_bit_cast(int, v);
    return (__builtin_bit_cast(float, __builtin_amdgcn_readlane(b, 0)) + __builtin_bit_cast(float, __builtin_amdgcn_readlane(b, 16)))
         + (__builtin_bit_cast(float, __builtin_amdgcn_readlane(b, 32)) + __builtin_bit_cast(float, __builtin_amdgcn_readlane(b, 48)));
}
__device__ __forceinline__ float wave_maxabs(const float* g, int n, int lane) {
    float v = 0.f;
    for (int i = lane; i < n; i += 64) v = fmaxf(v, fabsf(g[i]));
    v = fmaxf(v, dpp_f<0xB1>(v)); v = fmaxf(v, dpp_f<0x4E>(v)); v = fmaxf(v, dpp_f<0x141>(v)); v = fmaxf(v, dpp_f<0x140>(v));
    const int b = __builtin_bit_cast(int, v);
    return fmaxf(fmaxf(__builtin_bit_cast(float, __builtin_amdgcn_readlane(b, 0)), __builtin_bit_cast(float, __builtin_amdgcn_readlane(b, 16))),
                 fmaxf(__builtin_bit_cast(float, __builtin_amdgcn_readlane(b, 32)), __builtin_bit_cast(float, __builtin_amdgcn_readlane(b, 48))));
}
__device__ __forceinline__ void tr_item(const float* W, int N, int k0, int n0, bf16_t* dst, int ldd, LAS float* scr, int lane, int perm = -1, const float* gk = nullptr) {
#pragma unroll 8
    for (int i = 0; i < 32; ++i) { const int kk = 2 * i + (lane >> 5); scr[kk * 33 + (lane & 31)] = W[(size_t)(k0 + kk) * N + n0 + (lane & 31)] * (gk ? gk[k0 + kk] : 1.0f); }
    LDS_WAIT(); asm volatile("" ::: "memory");
    const int c = lane & 7;
#pragma unroll
    for (int j = 0; j < 4; ++j) { const int ns = (lane >> 3) + 8 * j, n = perm < 0 ? ns : 8 * (ns >> 2) + (ns & 3) + perm; const LAS float* s = scr + (8 * c) * 33 + ns;
        u32x4 o; o.x = cvt_pk_bf16(s[0 * 33], s[1 * 33]); o.y = cvt_pk_bf16(s[2 * 33], s[3 * 33]); o.z = cvt_pk_bf16(s[4 * 33], s[5 * 33]); o.w = cvt_pk_bf16(s[6 * 33], s[7 * 33]);
        *(u32x4*)(dst + (size_t)n * ldd + 8 * c) = o; }
    LDS_WAIT(); asm volatile("" ::: "memory");
}
__device__ __forceinline__ void sincos_acc(float ang, float& co, float& si) {
    const double a = (double)ang; const double k = __builtin_rint(a * 0.63661977236758134308);
    const double r = (a - k * 1.5707963267948966192) - k * 6.123233995736766e-17, r2 = r * r;
    const double s = r * (1.0 + r2 * (-1.0 / 6 + r2 * (1.0 / 120 + r2 * (-1.0 / 5040 + r2 * (1.0 / 362880 + r2 * (-1.0 / 39916800 + r2 * (1.0 / 6227020800.0)))))));
    const double c = 1.0 + r2 * (-0.5 + r2 * (1.0 / 24 + r2 * (-1.0 / 720 + r2 * (1.0 / 40320 + r2 * (-1.0 / 3628800 + r2 * (1.0 / 479001600.0 + r2 * (-1.0 / 87178291200.0)))))));
    const int q = (int)(long long)k & 3;
    const double cc = (q == 0) ? c : (q == 1) ? -s : (q == 2) ? -c : s;
    const double ss = (q == 0) ? s : (q == 1) ? c : (q == 2) ? -s : -c;
    co = (float)cc; si = (float)ss;
}
__device__ const float ROPE_FREQ[32] = {1.f, 0.749894261f, 0.562341332f, 0.421696514f, 0.316227764f, 0.237137377f, 0.177827939f, 0.133352131f, 0.100000001f, 0.0749894157f, 0.0562341325f,
    0.0421696529f, 0.0316227749f, 0.0237137377f, 0.0177827943f, 0.0133352149f, 0.00999999978f, 0.00749894185f, 0.00562341325f, 0.00421696482f, 0.00316227763f, 0.00237137359f, 0.00177827943f,
    0.00133352145f, 0.00100000005f, 0.000749894243f, 0.000562341302f, 0.000421696517f, 0.000316227757f, 0.00023713737f, 0.00017782794f, 0.00013335215f};

struct Frame {
    LAS unsigned char* lds; unsigned char* ws;
    int tid, lane, wave, vcu, G;
    const float* const* in;
};
__device__ __forceinline__ void step_prologue(const float* const (&in)[24], unsigned char* ws, LAS unsigned char* lds, int tid, int lane, int wave, int vcu, int G) {
    LAS float* scr = (LAS float*)(lds + RING_OFF + wave * 16384);
    const int gw = vcu * NWAVES + wave, NGW = G * NWAVES;
    const int gt = (vcu * NWAVES + wave) * 64 + lane, NT = G * NWAVES * 64;
    bf16_t* WIN_T = (bf16_t*)(ws + WS_WIN_T); bf16_t* WQ_T = (bf16_t*)(ws + WS_WQ_T); bf16_t* WKV_T = (bf16_t*)(ws + WS_WKV_T);
    bf16_t* WBR_T = (bf16_t*)(ws + WS_WBR_T); bf16_t* WOUT_T = (bf16_t*)(ws + WS_WOUT_T);
    {
        const float* cP = in[2]; const float* cS = in[3]; const float* w_ada = in[5]; float* modp = (float*)(ws + WS_MODP);
        for (int u = gw; u < DEPTH * 48 * KS_ADA; u += NGW) {
            const int ks = u % KS_ADA, cc = (u / KS_ADA) % 48, l = u / (KS_ADA * 48);
#pragma unroll 1
            for (int b = 0; b < 16; ++b) scr[b * 64 + lane] = (b < 8 ? cP + (size_t)b * DM : cS + (size_t)(b - 8) * DM)[ks * 64 + lane];
            LDS_WAIT(); asm volatile("" ::: "memory");
            f32x2 acc[16];
#pragma unroll
            for (int b = 0; b < 16; ++b) acc[b] = (f32x2){0.f, 0.f};
            const float* wp = w_ada + ((size_t)l * DM + ks * 64) * 6144 + cc * 128 + lane * 2;
#pragma unroll 1
            for (int k4 = 0; k4 < 16; ++k4) {
                f32x2 w[4];
#pragma unroll
                for (int q = 0; q < 4; ++q) w[q] = *(const f32x2*)(wp + (size_t)(k4 * 4 + q) * 6144);
#pragma unroll
                for (int b = 0; b < 16; ++b) { const f32x4 cv = *(const LAS f32x4*)(scr + b * 64 + k4 * 4);
                    acc[b] += w[0] * cv[0]; acc[b] += w[1] * cv[1]; acc[b] += w[2] * cv[2]; acc[b] += w[3] * cv[3]; }
            }
#pragma unroll
            for (int b = 0; b < 16; ++b) *(f32x2*)(modp + ((size_t)(ks * DEPTH + l) * 16 + b) * 6144 + cc * 128 + lane * 2) = acc[b];
            LDS_WAIT(); asm volatile("" ::: "memory");
        }
    }
    {
        constexpr int I_IN = (DM / 64) * (NIN / 32), I_Q = (512 / 64) * (1536 / 32), I_KV = (256 / 64) * (2048 / 32), I_BR = (1024 / 64) * (2048 / 32), I_OUT = (DM / 64) * (DM / 32);
        constexpr int I_L = I_IN + I_Q + I_KV + 3 * I_BR + I_OUT;
        for (int it = gw; it < DEPTH * I_L; it += NGW) {
            const int l = it / I_L; int r = it % I_L;
            if (r < I_IN) { const int nblk = NIN / 32, kb = r / nblk, nb = r % nblk, n0 = nb * 32; int dn = n0 + (n0 >= 832 ? 192 : 0), perm = -1;
                if (dn >= 2048 && dn < 2048 + 1280) { perm = (dn & 32) ? 4 : 0; dn &= ~63; }
                tr_item(in[7] + (size_t)l * DM * NIN, NIN, kb * 64, n0, WIN_T + ((size_t)l * NINP + dn) * DM + kb * 64, DM, scr, lane, perm); continue; }
            r -= I_IN;
            if (r < I_Q) { const int nblk = 1536 / 32, kb = r / nblk, nb = r % nblk, n0 = nb * 32, hq = n0 / 192, d0 = n0 % 192;
                const int dn = hq * 256 + (d0 < 128 ? d0 : 128), perm = d0 < 128 ? -1 : (d0 == 128 ? 0 : 4);
                tr_item(in[9] + (size_t)l * 512 * 1536, 1536, kb * 64, n0, WQ_T + ((size_t)l * 2048 + dn) * 512 + kb * 64, 512, scr, lane, perm, in[8] + (size_t)l * 512); continue; }
            r -= I_Q;
            if (r < I_KV) { const int nblk = 2048 / 32, kb = r / nblk, nb = r % nblk, n0 = nb * 32, hh = n0 >> 8, wi = n0 & 255, dn = wi < 128 ? hh * 128 + wi : 1024 + hh * 128 + (wi - 128);
                tr_item(in[11] + (size_t)l * 256 * 2048, 2048, kb * 64, n0, WKV_T + ((size_t)l * 2048 + dn) * 256 + kb * 64, 256, scr, lane, -1, in[10] + (size_t)l * 256); continue; }
            r -= I_KV;
            if (r < 3 * I_BR) { const int br = r / I_BR, rr = r % I_BR, nblk = 2048 / 32, kb = rr / nblk, nb = rr % nblk;
                const float* src = (br == 0 ? in[20] : br == 1 ? in[21] : in[22]) + (size_t)l * 1024 * 2048;
                tr_item(src, 2048, kb * 64, nb * 32, WBR_T + ((size_t)l * 2048 + nb * 32) * 3072 + br * 1024 + kb * 64, 3072, scr, lane); continue; }
            r -= 3 * I_BR;
            { const int nblk = DM / 32, kb = r / nblk, nb = r % nblk;
                tr_item(in[23] + (size_t)l * DM * DM, DM, kb * 64, nb * 32, WOUT_T + ((size_t)l * DM + nb * 32) * DM + kb * 64, DM, scr, lane); }
        }
    }
    for (int e = gt; e < DEPTH * 192 * (DM / 8); e += NT) { const int l = e / (192 * (DM / 8)), r = e % (192 * (DM / 8));
        *(u32x4*)(WIN_T + ((size_t)l * NINP + 832) * DM + (size_t)r * 8) = (u32x4){0u, 0u, 0u, 0u}; }
    for (int e = gt; e < DEPTH * 8 * 64 * (512 / 8); e += NT) { const int hh = e / (64 * 64), r = e % (64 * 64);
        *(u32x4*)(WQ_T + ((size_t)hh * 256 + 192) * 512 + (size_t)r * 8) = (u32x4){0u, 0u, 0u, 0u}; }
    { f32x2* rope = (f32x2*)(ws + WS_ROPE);
      for (int e = gt; e < 4096 * 32; e += NT) { const float ang = (float)(e >> 5) * ROPE_FREQ[e & 31]; float c, s; sincos_acc(ang, c, s); rope[e] = (f32x2){c, s}; } }
    { float* tb = (float*)(ws + WS_TB); const float* rel_bias = in[19];
      for (int e = gt; e < 8 * 768; e += NT) { const int h = e / 768, rel = (e % 768) - 383, n = rel < 0 ? -rel : rel; float v = -1e30f;
          if (n <= 128) { int bk = rel > 0 ? 16 : 0;
              if (n < 8) bk += n; else bk += 8 + (n >= 12) + (n >= 16) + (n >= 23) + (n >= 32) + (n >= 46) + (n >= 64) + (n >= 91);
              v = rel_bias[bk * 8 + h] * 1.4426950408889634f; }
          tb[e] = v; } }
}
__device__ __forceinline__ void step_modreduce(const float* b_ada, unsigned char* ws, int gt, int NT) {
    const float* modp = (const float*)(ws + WS_MODP); float* mod = (float*)(ws + WS_MOD);
    for (int e = gt; e < DEPTH * 16 * 6144; e += NT) { const int l = e / (16 * 6144), j = e % 6144; float s = b_ada[l * 6144 + j];
#pragma unroll 8
        for (int ks = 0; ks < KS_ADA; ++ks) s += modp[(size_t)ks * (DEPTH * 16 * 6144) + e];
        mod[e] = s; }
}
__device__ __forceinline__ void step_norm(const float* x, bf16_t* H, const float* ln_g, const float* mod_l, int bbase, int S, int TP, int gw, int NGW, int lane) {
    for (int ch = gw; ch < TP / 8; ch += NGW) {
        const float* mb = mod_l + (size_t)(bbase + (ch * 8) / S) * 6144;
        f32x4 gs[8], sh[8];
#pragma unroll
        for (int j = 0; j < 8; ++j) { const int c = (64 * j + lane) * 4; const f32x4 g = *(const f32x4*)(ln_g + c), sc = *(const f32x4*)(mb + 2048 + c); gs[j] = g * (sc + 1.0f); sh[j] = *(const f32x4*)(mb + c); }
        for (int rr = 0; rr < 8; rr += 2) { const size_t row = (size_t)ch * 8 + rr;
            const f32x4* xr = (const f32x4*)(x + row * DM) + lane; f32x4 v[8], w[8]; float ss = 0.f, st = 0.f;
#pragma unroll
            for (int j = 0; j < 8; ++j) { v[j] = xr[64 * j]; w[j] = xr[64 * j + DM / 4]; }
#pragma unroll
            for (int j = 0; j < 8; ++j) { ss += (v[j].x * v[j].x + v[j].y * v[j].y) + (v[j].z * v[j].z + v[j].w * v[j].w); st += (w[j].x * w[j].x + w[j].y * w[j].y) + (w[j].z * w[j].z + w[j].w * w[j].w); }
            const float rstd = 1.0f / sqrtf(wave_sum(ss) * (1.0f / DM) + RMS_EPS), rstt = 1.0f / sqrtf(wave_sum(st) * (1.0f / DM) + RMS_EPS);
            u32x2* o8 = (u32x2*)(H + row * DM) + lane;
#pragma unroll
            for (int j = 0; j < 8; ++j) { const f32x4 y = v[j] * rstd * gs[j] + sh[j], z = w[j] * rstt * gs[j] + sh[j];
                o8[64 * j] = (u32x2){cvt_pk_bf16(y.x, y.y), cvt_pk_bf16(y.z, y.w)}; o8[64 * j + DM / 4] = (u32x2){cvt_pk_bf16(z.x, z.y), cvt_pk_bf16(z.z, z.w)}; }
        }
    }
}
__device__ __forceinline__ void head128_load(const bf16_t* base, int j, unsigned (&w)[4]) {
#pragma unroll
    for (int q = 0; q < 4; ++q) w[q] = *(const unsigned*)(base + 32 * q + 2 * j);
}
__device__ __forceinline__ void head128_finish(bf16_t* base, const unsigned (&w)[4], const float* gain, bool do_rope, const f32x4 ca, const f32x4 cb, int j, const float oscale) {
    float v[8];
#pragma unroll
    for (int q = 0; q < 4; ++q) { v[2 * q] = bf_lo(w[q]); v[2 * q + 1] = bf_hi(w[q]); }
    float ss = 0.f;
#pragma unroll
    for (int e = 0; e < 8; ++e) ss += v[e] * v[e];
    const float rstd = oscale / sqrtf(sum16(ss) * (1.0f / 128) + RMS_EPS);
#pragma unroll
    for (int q = 0; q < 4; ++q) { const f32x2 g = *(const f32x2*)(gain + 32 * q + 2 * j); v[2 * q] *= rstd * g.x; v[2 * q + 1] *= rstd * g.y; }
    if (do_rope) {
        const float a0 = v[0], a1 = v[1], a2 = v[2], a3 = v[3], b0 = v[4], b1 = v[5], b2 = v[6], b3 = v[7];
        v[0] = a0 * ca.x - a2 * ca.y; v[1] = a1 * ca.z - a3 * ca.w; v[2] = a2 * ca.x + a0 * ca.y; v[3] = a3 * ca.z + a1 * ca.w;
        v[4] = b0 * cb.x - b2 * cb.y; v[5] = b1 * cb.z - b3 * cb.w; v[6] = b2 * cb.x + b0 * cb.y; v[7] = b3 * cb.z + b1 * cb.w;
    }
#pragma unroll
    for (int q = 0; q < 4; ++q) *(unsigned*)(base + 32 * q + 2 * j) = cvt_pk_bf16(v[2 * q], v[2 * q + 1]);
}
struct P1Row { u32x4 wq; u32x2 wk; };
__device__ __forceinline__ void p1_load(P1Row& R, const bf16_t* CQKV, const bf16_t* AXb, const bf16_t* WINb, const f32x2* rope, size_t row, int s, int lane) {
    const int j = lane & 15, grp = lane >> 4;
    R.wq = *(const u32x4*)(CQKV + row * 1024 + lane * 8); R.wk = *(const u32x2*)(CQKV + row * 1024 + 512 + lane * 4);
}
__device__ __forceinline__ void p1_finish(const P1Row& R, bf16_t* CQKV, bf16_t* AXb, bf16_t* WINb, const float* q_a_norm, const float* kv_a_norm, const float* ax_qn, const float* ax_kn,
                                          const float* win_qn, const float* win_kn, size_t row, int lane) {
    const int j = lane & 15, grp = lane >> 4;
    { float v[8] = {bf_lo(R.wq.x), bf_hi(R.wq.x), bf_lo(R.wq.y), bf_hi(R.wq.y), bf_lo(R.wq.z), bf_hi(R.wq.z), bf_lo(R.wq.w), bf_hi(R.wq.w)};
      float ss = 0.f;
#pragma unroll
      for (int e = 0; e < 8; ++e) ss += v[e] * v[e];
      const float rstd = 1.0f / sqrtf(wave_sum(ss) * (1.0f / 512) + RMS_EPS);
      const f32x4 g0 = *(const f32x4*)(q_a_norm + lane * 8), g1 = *(const f32x4*)(q_a_norm + lane * 8 + 4);
      u32x4 o; o.x = cvt_pk_bf16(v[0] * rstd * g0.x, v[1] * rstd * g0.y); o.y = cvt_pk_bf16(v[2] * rstd * g0.z, v[3] * rstd * g0.w);
      o.z = cvt_pk_bf16(v[4] * rstd * g1.x, v[5] * rstd * g1.y); o.w = cvt_pk_bf16(v[6] * rstd * g1.z, v[7] * rstd * g1.w); *(u32x4*)(CQKV + row * 1024 + lane * 8) = o; }
    { float v[4] = {bf_lo(R.wk.x), bf_hi(R.wk.x), bf_lo(R.wk.y), bf_hi(R.wk.y)};
      const float ss = (v[0] * v[0] + v[1] * v[1]) + (v[2] * v[2] + v[3] * v[3]);
      const float rstd = 1.0f / sqrtf(wave_sum(ss) * (1.0f / 256) + RMS_EPS);
      const f32x4 g = *(const f32x4*)(kv_a_norm + lane * 4);
      *(u32x2*)(CQKV + row * 1024 + 512 + lane * 4) = (u32x2){cvt_pk_bf16(v[0] * rstd * g.x, v[1] * rstd * g.y), cvt_pk_bf16(v[2] * rstd * g.z, v[3] * rstd * g.w)}; }
}
__device__ __forceinline__ void step_prep1(bf16_t* CQKV, bf16_t* AXb, bf16_t* WINb, const float* q_a_norm, const float* kv_a_norm, const float* ax_qn, const float* ax_kn,
                                           const float* win_qn, const float* win_kn, const f32x2* rope, int S, int TP, int gw, int NGW, int lane) {
    for (int ch = gw; ch < TP / 8; ch += NGW)
        for (int rr = 0; rr < 8; rr += 2) { const size_t row = (size_t)ch * 8 + rr; const int s = (int)(row % (size_t)S);
            P1Row A, B; p1_load(A, CQKV, AXb, WINb, rope, row, s, lane); p1_load(B, CQKV, AXb, WINb, rope, row + 1, s + 1, lane);
            p1_finish(A, CQKV, AXb, WINb, q_a_norm, kv_a_norm, ax_qn, ax_kn, win_qn, win_kn, row, lane);
            p1_finish(B, CQKV, AXb, WINb, q_a_norm, kv_a_norm, ax_qn, ax_kn, win_qn, win_kn, row + 1, lane); }
}
struct P2Row { u32x4 wn[4]; unsigned r0[4], r1[4]; f32x4 cs; };
__device__ __forceinline__ void p2_load(P2Row& R, const bf16_t* QM, const bf16_t* KF, const bf16_t* CQKV, const f32x2* rope, size_t row, int s, int lane) {
    const int j = lane & 15, grp = lane >> 4;
    const unsigned kr0 = *(const unsigned*)(CQKV + row * 1024 + 768 + 2 * j), kr1 = *(const unsigned*)(CQKV + row * 1024 + 800 + 2 * j);
#pragma unroll
    for (int it = 0; it < 4; ++it) { const int h = (it & 1) * 4 + grp; const bool isq = it < 2; const bf16_t* hb = (isq ? QM : KF) + row * 1536 + h * 192;
        R.wn[it] = *(const u32x4*)(hb + 8 * j);
        if (isq) { R.r0[it] = *(const unsigned*)(hb + 128 + 2 * j); R.r1[it] = *(const unsigned*)(hb + 160 + 2 * j); } else { R.r0[it] = kr0; R.r1[it] = kr1; } }
    R.cs = *(const f32x4*)(rope + (size_t)s * 32 + 2 * j);
}
__device__ __forceinline__ void p2_finish(const P2Row& R, bf16_t* QM, bf16_t* KF, const float* mla_qn, const float* mla_kn, size_t row, int lane) {
    const int j = lane & 15, grp = lane >> 4; const f32x4 cs = R.cs;
#pragma unroll
    for (int it = 0; it < 4; ++it) { const int h = (it & 1) * 4 + grp; const bool isq = it < 2; const float* gain = isq ? mla_qn : mla_kn; bf16_t* base = (isq ? QM : KF) + row * 1536 + h * 192;
        float v[8] = {bf_lo(R.wn[it].x), bf_hi(R.wn[it].x), bf_lo(R.wn[it].y), bf_hi(R.wn[it].y), bf_lo(R.wn[it].z), bf_hi(R.wn[it].z), bf_lo(R.wn[it].w), bf_hi(R.wn[it].w)};
        float x0 = bf_lo(R.r0[it]), x1 = bf_hi(R.r0[it]), y0 = bf_lo(R.r1[it]), y1 = bf_hi(R.r1[it]);
        float ss = (x0 * x0 + x1 * x1) + (y0 * y0 + y1 * y1);
#pragma unroll
        for (int e = 0; e < 8; ++e) ss += v[e] * v[e];
        const float rstd = (isq ? 0.072168783648703220f * 1.4426950408889634f : 1.0f) / sqrtf(sum16(ss) * (1.0f / 192) + RMS_EPS);
        const f32x4 g0 = *(const f32x4*)(gain + 8 * j), g1 = *(const f32x4*)(gain + 8 * j + 4); const f32x2 gx = *(const f32x2*)(gain + 128 + 2 * j), gy = *(const f32x2*)(gain + 160 + 2 * j);
        u32x4 o; o.x = cvt_pk_bf16(v[0] * rstd * g0.x, v[1] * rstd * g0.y); o.y = cvt_pk_bf16(v[2] * rstd * g0.z, v[3] * rstd * g0.w);
        o.z = cvt_pk_bf16(v[4] * rstd * g1.x, v[5] * rstd * g1.y); o.w = cvt_pk_bf16(v[6] * rstd * g1.z, v[7] * rstd * g1.w);
        x0 *= rstd * gx.x; x1 *= rstd * gx.y; y0 *= rstd * gy.x; y1 *= rstd * gy.y;
        *(u32x4*)(base + 8 * j) = o;
        *(unsigned*)(base + 128 + 2 * j) = cvt_pk_bf16(x0 * cs.x - y0 * cs.y, x1 * cs.z - y1 * cs.w);
        *(unsigned*)(base + 160 + 2 * j) = cvt_pk_bf16(y0 * cs.x + x0 * cs.y, y1 * cs.z + x1 * cs.w); }
}
__device__ __forceinline__ void step_prep2(bf16_t* QM, bf16_t* KF, const bf16_t* CQKV, const float* mla_qn, const float* mla_kn, const f32x2* rope, int S, int TP, int gw, int NGW, int lane) {
    for (int ch = gw; ch < TP / 8; ch += NGW)
        for (int rr = 0; rr < 8; rr += 2) { const size_t row = (size_t)ch * 8 + rr; const int s = (int)(row % (size_t)S);
            P2Row A, B; p2_load(A, QM, KF, CQKV, rope, row, s, lane); p2_load(B, QM, KF, CQKV, rope, row + 1, s + 1, lane);
            p2_finish(A, QM, KF, mla_qn, mla_kn, row, lane); p2_finish(B, QM, KF, mla_qn, mla_kn, row + 1, lane); }
}
struct Args { const float* in[24]; float* out; unsigned char* ws; int step_lo, step_hi, li, pad; };
__global__ void __launch_bounds__(NWAVES * 64, 2) fwd(Args args) {
    extern __shared__ __attribute__((aligned(16))) unsigned char lds_raw[];
    LAS unsigned char* lds = (LAS unsigned char*)lds_raw;
    const int G = gridDim.x, bx = blockIdx.x, vcu = (G % 8 == 0) ? (bx % 8) * (G / 8) + bx / 8 : bx;
    const int NGW = G * NWAVES, NTH = NGW * 64;
    { const int tid = threadIdx.x; if (tid < 64) ((LAS unsigned*)(lds + LDSCTL_OFF))[tid] = 0u; }
    __syncthreads();
    const int lo = args.step_lo, hi = args.step_hi;
    XcdBarrier bar; bar.bar = (unsigned*)(args.ws + WS_CTL) + args.li * XCD_BAR_WORDS; bar.x = 0; bar.st = (volatile LAS unsigned*)(lds + LDSCTL_OFF) + 8;
    if (hi - lo > 1) bar = xcd_barrier_post((unsigned*)(args.ws + WS_CTL) + args.li * XCD_BAR_WORDS, (volatile LAS unsigned*)(lds + LDSCTL_OFF) + 8);
#ifndef PH_MASK
#define PH_MASK 0x3ff
#endif
#define PH(k) (((PH_MASK) >> (k)) & 1)
#define PHASE_IDS() int tid_ = threadIdx.x; asm volatile("" : "+v"(tid_)); const int tid = tid_, lane = tid & 63, wave = __builtin_amdgcn_readfirstlane(tid >> 6), gw = vcu * NWAVES + wave, gt = gw * 64 + lane; (void)gt; (void)gw; (void)lane
#define GAS __attribute__((address_space(1)))
#define GP(T, p) ((T*)(p))
#define TABP(k) GP(const float, tab[k])
#define PHASE_PTRS() PHASE_IDS(); size_t wz_ = 0; asm volatile("" : "+s"(wz_)); unsigned char* ws = args.ws + wz_; const float* const* tab = (const float* const*)(ws + WS_PTRS); \
    bf16_t* WIN_T = GP(bf16_t, ws + WS_WIN_T); bf16_t* WQ_T = GP(bf16_t, ws + WS_WQ_T); bf16_t* WKV_T = GP(bf16_t, ws + WS_WKV_T); \
    bf16_t* WBR_T = GP(bf16_t, ws + WS_WBR_T); bf16_t* WOUT_T = GP(bf16_t, ws + WS_WOUT_T); \
    bf16_t* Hb = GP(bf16_t, ws + WS_H); bf16_t* CQKV = GP(bf16_t, ws + WS_CQKV); bf16_t* QM = GP(bf16_t, ws + WS_QM); bf16_t* KF = GP(bf16_t, ws + WS_KF); bf16_t* VM = GP(bf16_t, ws + WS_VM); \
    bf16_t* AXb = GP(bf16_t, ws + WS_AX); bf16_t* WINb = GP(bf16_t, ws + WS_WINB); bf16_t* Gb = GP(bf16_t, ws + WS_G); bf16_t* MG = GP(bf16_t, ws + WS_MG); \
    const float* mod_l = GP(const float, ws + WS_MOD) + (size_t)l * 16 * 6144; const f32x2* rope = GP(const f32x2, ws + WS_ROPE); const float* tb = GP(const float, ws + WS_TB); \
    (void)tab; (void)WIN_T; (void)WQ_T; (void)WKV_T; (void)WBR_T; (void)WOUT_T; (void)Hb; (void)CQKV; (void)QM; (void)KF; (void)VM; (void)AXb; (void)WINb; (void)Gb; (void)MG; (void)mod_l; (void)rope; (void)tb
#ifndef MK_TPROBE
#define MK_TPROBE -1
#endif
#ifndef MK_TSCALE
#define MK_TSCALE 4.0f
#endif
#define TP_BEGIN(k) do { if (MK_TPROBE == (k)) tp0 = __builtin_amdgcn_s_memrealtime(); } while (0)
#define TP_END(k) do { if (MK_TPROBE == (k)) tpacc += __builtin_amdgcn_s_memrealtime() - tp0; } while (0)
#define IN(s) (lo <= (s) && (s) < hi)
#define SEAM(s) do { if (IN(s) && IN((s) + 1)) xcd_barrier(bar); } while (0)

    unsigned long long tp0 = 0, tpacc = 0; (void)tp0; (void)tpacc;
    TP_BEGIN(8);
    if (PH(0) && IN(0)) { PHASE_IDS(); if (bx == 0 && tid == 0) { const float** tw = (const float**)(args.ws + WS_PTRS);
#pragma unroll
            for (int i = 0; i < 24; ++i) tw[i] = args.in[i];
            tw[24] = (const float*)args.out; }
        step_prologue(args.in, args.ws, lds, tid, lane, wave, vcu, G); }
    SEAM(0);
    if (PH(1) && IN(1)) { PHASE_IDS(); step_modreduce(args.in[6], args.ws, gt, NTH); }
    SEAM(1);
    TP_END(8);

    int it_lo = (lo - NSTEP_PRO) / NSTEP_IT; if (lo < NSTEP_PRO) it_lo = 0;
    int it_hi = (hi - NSTEP_PRO + NSTEP_IT - 1) / NSTEP_IT; if (hi <= NSTEP_PRO) it_hi = 0; if (it_hi > DEPTH * NPASS) it_hi = DEPTH * NPASS;
    for (int it = it_lo; it < it_hi; ++it) {
        const int l = it / NPASS, p = it % NPASS, s0 = NSTEP_PRO + it * NSTEP_IT;
        const int S = p == 0 ? 4096 : 2048, bbase = p == 0 ? 0 : 8, TP = p == 0 ? 32768 : 16384;
        const size_t row0 = p == 0 ? 0 : 32768;

        TP_BEGIN(0);
        if (PH(2) && IN(s0 + 0)) { PHASE_PTRS(); const float* xin = ((l == 0) ? (p == 0 ? args.in[0] : args.in[1]) : args.out + row0 * DM) + wz_; float* xout = args.out + row0 * DM + wz_; (void)xout; step_norm(xin, Hb, TABP(4) + (size_t)l * DM, mod_l, bbase, S, TP, gw, NGW, lane); }
        TP_BEGIN(20);
        SEAM(s0 + 0);
        TP_END(20);
        TP_END(0);
        TP_BEGIN(1);
        if (PH(3) && IN(s0 + 1)) { PHASE_PTRS();
            pg8::Gemm g{Hb, WIN_T + (size_t)l * NINP * DM, TP, NINP, DM, DM, DM}; pg8::StaticOrder So; So.init(TP, NINP, G, bx);
            EpiInProj E{CQKV, Gb, AXb, WINb, MG, tab, l * 128, rope, S, (PG8_LAS float*)(lds + LDSCTL_OFF + 1024), (float*)(ws + WS_RS)};
            pg8::gemm_phase<EpiInProj, pg8::StaticOrder, true, true>(lds + RING_OFF, g, So, E);
        }
        TP_BEGIN(21);
        SEAM(s0 + 1);
        TP_END(21);
        TP_END(1);
        TP_BEGIN(2);
        TP_END(22);
        TP_END(2);
        TP_BEGIN(3);
        if (PH(5) && IN(s0 + 3)) { PHASE_PTRS();
            { pg8::Gemm g{CQKV, WQ_T + (size_t)l * 2048 * 512, TP, 2048, 512, 1024, 512}; pg8::StaticOrder So; So.init(TP, 2048, G, bx);
              EpiQUp E{QM, (const float*)(ws + WS_RS), TABP(12) + (size_t)l * 192, rope, S, (PG8_LAS float*)(lds + LDSCTL_OFF + 1024)};
              pg8::gemm_phase<EpiQUp, pg8::StaticOrder, true, true>(lds + RING_OFF, g, So, E); }
            { pg8::Gemm g{CQKV + 512, WKV_T + (size_t)l * 2048 * 256, TP, 2048, 256, 1024, 256}; pg8::StaticOrder So; So.init(TP, 2048, G, G - 1 - bx);
              EpiKV E{KF, VM, (const float*)(ws + WS_RS), CQKV, TABP(13) + (size_t)l * 192, rope, S, (PG8_LAS float*)(lds + LDSCTL_OFF + 1024)};
              pg8::gemm_phase<EpiKV, pg8::StaticOrder, true, true>(lds + RING_OFF, g, So, E); }
        }
        TP_BEGIN(23);
        SEAM(s0 + 3);
        TP_END(23);
        TP_END(3);
        TP_BEGIN(4);
        TP_END(24);
        TP_END(4);
        TP_BEGIN(5);
        if (PH(7) && IN(s0 + 5)) { PHASE_PTRS();
            const int nqb = S / 256, nper = TP / 256; char* al = (char*)lds_raw + RING_OFF; const long dbgoff = 0; (void)dbgoff;
#define UNIF_F(x) __builtin_bit_cast(float, __builtin_amdgcn_readfirstlane(__builtin_bit_cast(int, (float)(x))))
            const float mneg_mla = UNIF_F(-1.02f * 13.856406f * 1.4426950408889634f * wave_maxabs(TABP(12) + (size_t)l * 192, 192, lane) * wave_maxabs(TABP(13) + (size_t)l * 192, 192, lane));
            const float mneg_ax = UNIF_F(-1.02f * 11.313708f * 1.4426950408889634f * wave_maxabs(TABP(14) + (size_t)l * 128, 128, lane) * wave_maxabs(TABP(15) + (size_t)l * 128, 128, lane));
#undef UNIF_F
            const bool mla_small = mneg_mla > -100.f;
            const unsigned myx = xb_xcc_id() & 7u; unsigned* qbase = (unsigned*)(ws + WS_CTL) + 4096 + (size_t)it * (3 * 8 * 64);
            volatile LAS int* tick = (volatile LAS int*)(lds + LDSCTL_OFF) + 16;
#define Q_RAW(cls, r_) do { r_ = -1; while (qi < 8) { const unsigned x_ = (myx + (unsigned)qi) & 7u; \
                const unsigned k_ = __hip_atomic_fetch_add(qbase + ((cls) * 8 + x_) * 64, 1u, __ATOMIC_RELAXED, __HIP_MEMORY_SCOPE_AGENT); if ((int)k_ < nper) { r_ = (int)((x_ << 16) | k_); break; } ++qi; } } while (0)
#define Q_FIRST(cls, r) do { __syncthreads(); if (tid == 0) { int r_; Q_RAW(cls, r_); tick[0] = r_; } __syncthreads(); r = tick[0]; par = 1; } while (0)
#define Q_NEXT_ISSUE(cls) do { nxt = -1; if (tid == 0) { Q_RAW(cls, nxt); } } while (0)
#define Q_NEXT_TAKE(r) do { if (tid == 0) tick[par] = nxt; __syncthreads(); r = tick[par]; par ^= 1; } while (0)
            TP_BEGIN(10);
            { int qi = 0, r, nxt, par;
              Q_FIRST(0, r);
              while (r >= 0) { Q_NEXT_ISSUE(0); const int h = r >> 16, k = r & 0xffff, b = k / nqb, qb = k % nqb; const size_t t0 = (size_t)b * S, tq = t0 + (size_t)qb * 256;
                if (mla_small) att::attn_unit<192, 1, 1536, 1536, 1024, 3072, false, 2>(QM + tq * 1536 + h * 192, KF + t0 * 1536 + h * 192, VM + t0 * 1024 + h * 128, Gb + tq * 3072 + h * 128,
                                                                                        S / 64, 0.f, 0.f, tb, 0, al);
                else att::attn_unit<192, 1, 1536, 1536, 1024, 3072, false, 3>(QM + tq * 1536 + h * 192, KF + t0 * 1536 + h * 192, VM + t0 * 1024 + h * 128, Gb + tq * 3072 + h * 128,
                                                                             S / 64, mneg_mla, 0.f, tb, 0, al);
                Q_NEXT_TAKE(r); } }
            TP_END(10); TP_BEGIN(11);
            { int qi = 0, r, nxt, par;
              Q_FIRST(1, r);
              while (r >= 0) { Q_NEXT_ISSUE(1); const int x = r >> 16, k = r & 0xffff, g = x + 8 * (k / (4 * nqb)), w = k % (4 * nqb), b = g >> 1, h = (g & 1) * 4 + w / nqb, qb = w % nqb;
                const size_t t0 = (size_t)b * S, tq = t0 + (size_t)qb * 256;
                att::attn_unit<128, 2, 1536, 1536, 1536, 3072, false, 1>(AXb + tq * 1536 + h * 128, AXb + t0 * 1536 + 1024 + (h >> 2) * 128, AXb + t0 * 1536 + 1280 + (h >> 2) * 128,
                                                                     Gb + tq * 3072 + 1024 + h * 128, S / 64, mneg_ax, 0.f, tb, 0, al);
                Q_NEXT_TAKE(r); } }
            TP_END(11); TP_BEGIN(12);
            const float* sink = TABP(18) + l * 8;
            { int qi = 0, r, nxt, par;
              Q_FIRST(2, r);
              while (r >= 0) { Q_NEXT_ISSUE(2); const int x = r >> 16, k = r & 0xffff, g = x + 8 * (k / (4 * nqb)), w = k % (4 * nqb), b = g >> 1, h = (g & 1) * 4 + w / nqb, qb = w % nqb;
                const size_t t0 = (size_t)b * S, tq = t0 + (size_t)qb * 256;
                const int q0 = qb * 256, ks = q0 >= 128 ? q0 - 128 : 0, ke = q0 + 384 <= S ? q0 + 384 : S; const size_t tk = t0 + ks;
                att::attn_unit<128, 1, 1536, 1536, 1536, 3072, true>(WINb + tq * 1536 + h * 128, WINb + tk * 1536 + 1024 + (h >> 2) * 128, WINb + tk * 1536 + 1280 + (h >> 2) * 128,
                                                                    Gb + tq * 3072 + 2048 + h * 128, (ke - ks) / 64, sink[h] * 1.4426950408889634f, 1.f, tb + h * 768, ks - q0 + 383, al);
                Q_NEXT_TAKE(r); } }
#undef Q_RAW
#undef Q_FIRST
#undef Q_NEXT_ISSUE
#undef Q_NEXT_TAKE
            __syncthreads(); TP_END(12); TP_BEGIN(13);
        }
        SEAM(s0 + 5);
        TP_END(13);
        TP_END(5);
        TP_BEGIN(6);
        if (PH(8) && IN(s0 + 6)) { PHASE_PTRS();
            pg8::Gemm g{Gb, WBR_T + (size_t)l * DM * 3072, TP, DM, 3072, 3072, 3072}; pg8::StaticOrder So; So.init(TP, DM, G, bx);
            EpiBranchFused E{MG, Hb};
            pg8::gemm_phase<EpiBranchFused, pg8::StaticOrder, true, true>(lds + RING_OFF, g, So, E);
        }
        TP_BEGIN(26);
        SEAM(s0 + 6);
        TP_END(26);
        TP_END(6);
        TP_BEGIN(7);
        if (PH(9) && IN(s0 + 7)) { PHASE_PTRS(); const float* xin = ((l == 0) ? (p == 0 ? args.in[0] : args.in[1]) : args.out + row0 * DM) + wz_; float* xout = args.out + row0 * DM + wz_; (void)xout;
            pg8::Gemm g{Hb, WOUT_T + (size_t)l * DM * DM, TP, DM, DM, DM, DM}; pg8::StaticOrder So; So.init(TP, DM, G, bx);
            EpiOut E{xin, xout, mod_l + 4096, bbase, S};
            pg8::gemm_phase<EpiOut, pg8::StaticOrder, true, true>(lds + RING_OFF, g, So, E);
        }
        TP_BEGIN(27);
        SEAM(s0 + 7);
        TP_END(27);
        TP_END(7);
    }
    if (MK_TPROBE >= 0 && hi == NSTEPS) { xcd_barrier(bar);
        if (bx == 0 && threadIdx.x == 0) args.out[0] += (float)tpacc * 1e-5f * MK_TSCALE; }
#undef IN
#undef SEAM
}

extern "C" void kernel_launch(void* const* d_in, const int* in_sizes, int n_in, void* d_out, int out_size, void* d_ws, size_t ws_size, hipStream_t stream) {
    static int grid = 0;
    if (grid == 0) {
        if (n_in != 24 || in_sizes[0] != T_PROMPT * DM || in_sizes[1] != T_SAMPLE * DM || out_size != (T_PROMPT + T_SAMPLE) * DM || ws_size < WS_END) {
            fprintf(stderr, "kernel_launch: shape mismatch (n_in %d, in0 %d, in1 %d, out %d, ws %zu, need ws >= %zu); nothing launched\n", n_in, n_in > 0 ? in_sizes[0] : -1, n_in > 1 ? in_sizes[1] : -1, out_size, ws_size, (size_t)WS_END);
            grid = -1; return; }
        int dev = 0, cus = 0, per_cu = 0;
        if (hipGetDevice(&dev) != hipSuccess || hipDeviceGetAttribute(&cus, hipDeviceAttributeMultiprocessorCount, dev) != hipSuccess) { fprintf(stderr, "kernel_launch: device query failed\n"); grid = -1; return; }
        if (hipFuncSetAttribute((const void*)fwd, hipFuncAttributeMaxDynamicSharedMemorySize, LDS_BYTES) != hipSuccess) { fprintf(stderr, "kernel_launch: hipFuncSetAttribute failed\n"); grid = -1; return; }
        if (hipOccupancyMaxActiveBlocksPerMultiprocessor(&per_cu, (const void*)fwd, NWAVES * 64, LDS_BYTES) != hipSuccess || per_cu < 1)
            fprintf(stderr, "kernel_launch: note: occupancy query reports %d workgroups per CU\n", per_cu);
        (void)hipGetLastError();
        grid = cus;
    }
    if (grid < 0) return;
    if (hipMemsetAsync((char*)d_ws + WS_CTL, 0, CTL_ZERO_BYTES, stream) != hipSuccess) { fprintf(stderr, "kernel_launch: hipMemsetAsync failed\n"); return; }
    Args a{};
    for (int i = 0; i < 24; ++i) a.in[i] = (const float*)d_in[i];
    a.out = (float*)d_out; a.ws = (unsigned char*)d_ws; a.li = 0; a.pad = 0;
#if MK_ONE_LAUNCH
    a.step_lo = 0; a.step_hi = NSTEPS;
    hipLaunchKernelGGL(fwd, dim3(grid), dim3(NWAVES * 64), LDS_BYTES, stream, a);
#else
    for (int s = 0; s < NSTEPS; ++s) { a.step_lo = s; a.step_hi = s + 1;
        hipLaunchKernelGGL(fwd, dim3(grid), dim3(NWAVES * 64), LDS_BYTES, stream, a); }
#endif
    const hipError_t le = hipPeekAtLastError();
    if (le != hipSuccess) fprintf(stderr, "kernel_launch: launch failed: %s\n", hipGetErrorName(le));
}
```

```cpp
#include <hip/hip_runtime.h>
#include <cstdio>
#include <cstdint>

#ifndef MK_ONE_LAUNCH
#define MK_ONE_LAUNCH 1
#endif

#define LAS __attribute__((address_space(3)))
typedef unsigned short bf16_t;
typedef short bf16x8 __attribute__((ext_vector_type(8)));
typedef short s16x4 __attribute__((ext_vector_type(4)));
typedef float f32x2 __attribute__((ext_vector_type(2)));
typedef float f32x4 __attribute__((ext_vector_type(4)));
typedef float f32x16 __attribute__((ext_vector_type(16)));
typedef unsigned u32x2 __attribute__((ext_vector_type(2)));
typedef unsigned u32x4 __attribute__((ext_vector_type(4)));

__device__ __forceinline__ unsigned cvt_pk_bf16(float lo, float hi) { unsigned r; asm volatile("v_cvt_pk_bf16_f32 %0, %1, %2" : "=v"(r) : "v"(lo), "v"(hi)); return r; }
__device__ __forceinline__ float bf_lo(unsigned w) { return __builtin_bit_cast(float, w << 16); }
__device__ __forceinline__ float bf_hi(unsigned w) { return __builtin_bit_cast(float, w & 0xffff0000u); }
__device__ __forceinline__ float bf2f(bf16_t x) { return __builtin_bit_cast(float, (unsigned)x << 16); }
__device__ __forceinline__ bf16_t f2bf(float f) { return (bf16_t)(cvt_pk_bf16(f, 0.f) & 0xffffu); }
__device__ __forceinline__ float sigmoid_f(float v) { return __builtin_amdgcn_rcpf(1.0f + __builtin_amdgcn_exp2f(-1.4426950408889634f * v)); }
__device__ __forceinline__ float silu_f(float v) { return v * sigmoid_f(v); }

namespace pg8 {
#define PG8_LAS __attribute__((address_space(3)))
constexpr int BM = 256, BK = 64, HALF = 128, HTB = HALF * BK * 2  , STAGE_BYTES = 8 * HTB, NXCD = 8, WGM = 8;
__host__ __device__ __forceinline__ int lds_byte(int r, int c) { const int st = (r >> 4) * 2 + (c >> 5), rr = r & 15, cc = c & 31, ob = rr * 64 + cc * 2; return st * 1024 + (ob ^ (((ob >> 9) & 1) << 5)); }
__host__ __device__ __forceinline__ void stage_rc(int b, int& R, int& C) { const int st = b / 1024, sb = b % 1024, swz = sb ^ (((sb >> 9) & 1) << 5); R = (st >> 1) * 16 + swz / 64; C = (st & 1) * 32 + (swz % 64) / 2; }
__host__ __device__ __forceinline__ int perm32(int rho) { const int n = rho >> 4, i = rho & 15; return 8 * (i >> 2) + 4 * n + (i & 3); }

struct Unit { int pm, pn; };
struct Gemm { const bf16_t* A; const bf16_t* Bt; int M, N, K, lda, ldb; };

struct StaticOrder {
    int nM, nN, nwg, G, c, wgm;
    __host__ __device__ void init(int M, int N, int G_, int c_, int wgm_ = 4) { nM = M / BM; nN = N / BM; nwg = nM * nN; G = G_; c = c_; wgm = wgm_; }
    __host__ __device__ bool next(int i, Unit& u) const {
        const long L = (long)i * G + c; if (L >= nwg) return false;
        int wgid = (int)L; { const int q = nwg / NXCD, r = nwg % NXCD, xcd = wgid % NXCD, off = wgid / NXCD; wgid = (xcd < r ? xcd * (q + 1) : r * (q + 1) + (xcd - r) * q) + off; }
        const int nig = wgm * nN, gid = wgid / nig, fm = gid * wgm, gsz = (nM - fm) < wgm ? (nM - fm) : wgm;
        u.pm = fm + ((wgid % nig) % gsz); u.pn = (wgid % nig) / gsz; return true;
    }
};
template <class Epi, class Sched, bool ALIGN_EPI = false, bool SP2 = false>
__device__ __forceinline__ void gemm_phase(PG8_LAS unsigned char* lds, const Gemm g, const Sched& S, const Epi& E) {
    int tid_ = threadIdx.x; asm volatile("" : "+v"(tid_));
    const int tid = tid_, wid = __builtin_amdgcn_readfirstlane(tid >> 6), lane = tid & 63, wr = wid >> 2, wc = wid & 3, fr = lane & 15, fq = lane >> 4;
    int K_ = g.K; asm volatile("" : "+s"(K_));
    const int K = K_, nt = K / BK;
    unsigned voffA[2], voffB[2];
#pragma unroll
    for (int i = 0; i < 2; ++i) { int R, C; stage_rc(tid * 16 + i * 8192, R, C); const int Rb = Epi::PERM ? ((R & ~31) + perm32(R & 31)) : R;
        voffA[i] = (unsigned)(R * g.lda + C) * 2u; voffB[i] = (unsigned)(Rb * g.ldb + C) * 2u; }
    const size_t kstep = (size_t)(BK * 2);
    const size_t hstepA = (size_t)HALF * g.lda * 2, hstepB = (size_t)HALF * g.ldb * 2;
    const size_t tstepA = 2 * hstepA, tstepB = 2 * hstepB;
    const unsigned ldsw = (unsigned)wid * 1024u;
    const int aoff = lds_byte(wr * 64 + fr, fq * 8), boff = lds_byte(wc * 32 + fr, fq * 8);
#define PG8_SA(b, h) (((b) * 2 + (h)) * HTB)
#define PG8_SB(b, h) ((4 + (b) * 2 + (h)) * HTB)
#define PG8_STAGE(bufoff, gbase, voff) do { _Pragma("unroll") for (int _i = 0; _i < 2; ++_i) \
        __builtin_amdgcn_global_load_lds((const unsigned*)((const char*)(gbase) + (voff)[_i]), (PG8_LAS unsigned*)(lds + (bufoff) + ldsw + _i * 8192), 16, 0, 0); } while (0)
#define PG8_LDA(dst, b, h) do { _Pragma("unroll") for (int m = 0; m < 4; ++m) _Pragma("unroll") for (int k = 0; k < 2; ++k) dst[m][k] = *(const PG8_LAS bf16x8*)(lds + PG8_SA(b, h) + aoff + m * 2048 + k * 1024); } while (0)
#define PG8_LDB(dst, b, h) do { _Pragma("unroll") for (int n = 0; n < 2; ++n) _Pragma("unroll") for (int k = 0; k < 2; ++k) dst[n][k] = *(const PG8_LAS bf16x8*)(lds + PG8_SB(b, h) + boff + n * 2048 + k * 1024); } while (0)
#define PG8_MMA(ai, bj, At, Bt) do { __builtin_amdgcn_s_setprio(1); _Pragma("unroll") for (int m = 0; m < 4; ++m) _Pragma("unroll") for (int n = 0; n < 2; ++n) _Pragma("unroll") for (int k = 0; k < 2; ++k) \
        acc[ai][bj][m][n] = __builtin_amdgcn_mfma_f32_16x16x32_bf16(Bt[n][k], At[m][k], acc[ai][bj][m][n], 0, 0, 0); __builtin_amdgcn_s_setprio(0); } while (0)
#define PG8_WAIT_V(n) asm volatile("s_waitcnt vmcnt(" #n ")" ::: "memory")
#define PG8_WAIT_L(n) asm volatile("s_waitcnt lgkmcnt(" #n ")" ::: "memory")
#define PG8_BAR __builtin_amdgcn_s_barrier()
#define PG8_SCHED __builtin_amdgcn_sched_barrier(0)
    Unit cur, nxt; int ui = 0;
    if (!S.next(0, cur)) return;
    f32x4 acc[2][2][4][2];
#pragma unroll
    for (int a = 0; a < 2; ++a)
#pragma unroll
        for (int b = 0; b < 2; ++b)
#pragma unroll
            for (int m = 0; m < 4; ++m)
#pragma unroll
                for (int n = 0; n < 2; ++n) acc[a][b][m][n] = (f32x4){0.f, 0.f, 0.f, 0.f};
    bf16x8 At[4][2], B0[2][2], B1[2][2];
    const char* cA = (const char*)g.A + (size_t)cur.pm * tstepA; const char* cB = (const char*)g.Bt + (size_t)cur.pn * tstepB;

    if constexpr (SP2) {
        PG8_STAGE(PG8_SB(0, 0), cB, voffB); PG8_STAGE(PG8_SB(0, 1), cB + hstepB, voffB); PG8_STAGE(PG8_SA(0, 0), cA, voffA); PG8_STAGE(PG8_SA(0, 1), cA + hstepA, voffA);
        if (wr == 1) PG8_BAR;
        PG8_WAIT_V(2); PG8_BAR;
        PG8_STAGE(PG8_SB(1, 0), cB + kstep, voffB); PG8_STAGE(PG8_SA(1, 0), cA + kstep, voffA); PG8_STAGE(PG8_SB(1, 1), cB + hstepB + kstep, voffB);
        PG8_WAIT_V(6); PG8_BAR;
    } else {
        PG8_STAGE(PG8_SB(0, 0), cB, voffB); PG8_STAGE(PG8_SA(0, 0), cA, voffA); PG8_STAGE(PG8_SB(0, 1), cB + hstepB, voffB); PG8_STAGE(PG8_SA(0, 1), cA + hstepA, voffA);
        if (wr == 1) PG8_BAR;
        PG8_WAIT_V(4); PG8_BAR;
        PG8_STAGE(PG8_SB(1, 0), cB + kstep, voffB); PG8_STAGE(PG8_SA(1, 0), cA + kstep, voffA); PG8_STAGE(PG8_SB(1, 1), cB + hstepB + kstep, voffB);
        PG8_WAIT_V(6); PG8_BAR;
    }
    for (;;) {
        const bool has_next = S.next(ui + 1, nxt);
        const char* nA = has_next ? (const char*)g.A + (size_t)nxt.pm * tstepA : cA; const char* nB = has_next ? (const char*)g.Bt + (size_t)nxt.pn * tstepB : cB;
        for (int t = 0; t < nt; t += 2) {
            if constexpr (Epi::HAS_MID) { if (t == Epi::MID1 || t == Epi::MID2) E.mid(acc, cur, t, wr, wc, fr, fq); }
            const bool last = (t == nt - 2);
            const char* a1 = cA + (size_t)(t + 1) * kstep;
            const char* a2 = last ? nA : cA + (size_t)(t + 2) * kstep; const char* b2 = last ? nB : cB + (size_t)(t + 2) * kstep;
            const char* a3 = a2 + kstep; const char* b3 = b2 + kstep;

            if constexpr (SP2) {
            PG8_LDB(B0, 0, 0); PG8_LDB(B1, 0, 1); PG8_SCHED; PG8_LDA(At, 0, 0); PG8_STAGE(PG8_SA(1, 1), a1 + hstepA, voffA);
            PG8_WAIT_V(8); PG8_WAIT_L(0); PG8_BAR; PG8_MMA(0, 0, At, B0); PG8_MMA(0, 1, At, B1); PG8_BAR; PG8_SCHED;
            PG8_LDA(At, 0, 1); PG8_STAGE(PG8_SB(0, 0), b2, voffB); PG8_STAGE(PG8_SB(0, 1), b2 + hstepB, voffB); PG8_STAGE(PG8_SA(0, 0), a2, voffA);
            PG8_WAIT_V(8); PG8_WAIT_L(0); PG8_BAR; PG8_MMA(1, 0, At, B0); PG8_MMA(1, 1, At, B1); PG8_BAR; PG8_SCHED;
            PG8_LDB(B0, 1, 0); PG8_LDB(B1, 1, 1); PG8_SCHED; PG8_LDA(At, 1, 0); PG8_STAGE(PG8_SA(0, 1), a2 + hstepA, voffA);
            PG8_WAIT_V(8); PG8_WAIT_L(0); PG8_BAR; PG8_MMA(0, 0, At, B0); PG8_MMA(0, 1, At, B1); PG8_BAR; PG8_SCHED;
            PG8_LDA(At, 1, 1); PG8_STAGE(PG8_SB(1, 0), b3, voffB); PG8_STAGE(PG8_SB(1, 1), b3 + hstepB, voffB); PG8_STAGE(PG8_SA(1, 0), a3, voffA);
            PG8_WAIT_V(8); PG8_WAIT_L(0); PG8_BAR; PG8_MMA(1, 0, At, B0); PG8_MMA(1, 1, At, B1); PG8_BAR; PG8_SCHED;
            } else {
            PG8_LDB(B0, 0, 0); PG8_SCHED; PG8_LDA(At, 0, 0); PG8_STAGE(PG8_SA(1, 1), a1 + hstepA, voffA);
            PG8_WAIT_L(8); PG8_BAR; PG8_WAIT_L(0); PG8_MMA(0, 0, At, B0); PG8_BAR; PG8_SCHED;
            PG8_LDB(B1, 0, 1); PG8_STAGE(PG8_SB(0, 0), b2, voffB);
            PG8_BAR; PG8_WAIT_L(0); PG8_MMA(0, 1, At, B1); PG8_BAR;
            PG8_LDA(At, 0, 1); PG8_STAGE(PG8_SA(0, 0), a2, voffA);
            PG8_BAR; PG8_WAIT_L(0); PG8_MMA(1, 0, At, B0); PG8_BAR; PG8_SCHED;
            PG8_STAGE(PG8_SB(0, 1), b2 + hstepB, voffB);
            PG8_WAIT_V(6); PG8_BAR; PG8_MMA(1, 1, At, B1); PG8_BAR;
            PG8_LDB(B0, 1, 0); PG8_SCHED; PG8_LDA(At, 1, 0); PG8_STAGE(PG8_SA(0, 1), a2 + hstepA, voffA);
            PG8_WAIT_L(8); PG8_BAR; PG8_WAIT_L(0); PG8_MMA(0, 0, At, B0); PG8_BAR; PG8_SCHED;
            PG8_LDB(B1, 1, 1); PG8_STAGE(PG8_SB(1, 0), b3, voffB);
            PG8_BAR; PG8_WAIT_L(0); PG8_MMA(0, 1, At, B1); PG8_BAR;
            PG8_LDA(At, 1, 1); PG8_STAGE(PG8_SA(1, 0), a3, voffA);
            PG8_BAR; PG8_WAIT_L(0); PG8_MMA(1, 0, At, B0); PG8_BAR; PG8_SCHED;
            PG8_STAGE(PG8_SB(1, 1), b3 + hstepB, voffB);
            PG8_WAIT_V(6); PG8_BAR; PG8_MMA(1, 1, At, B1); PG8_BAR;
            }
        }
        if constexpr (ALIGN_EPI) { if (wr == 0) PG8_BAR; }
        E(acc, cur, wr, wc, fr, fq);
        if (!has_next) break;
#pragma unroll
        for (int a = 0; a < 2; ++a)
#pragma unroll
            for (int b = 0; b < 2; ++b)
#pragma unroll
                for (int m = 0; m < 4; ++m)
#pragma unroll
                    for (int n = 0; n < 2; ++n) acc[a][b][m][n] = (f32x4){0.f, 0.f, 0.f, 0.f};
        cur = nxt; cA = nA; cB = nB; ++ui;
        if constexpr (ALIGN_EPI) { if (wr == 1) PG8_BAR; }
    }
    PG8_WAIT_V(0);
    if constexpr (!ALIGN_EPI) { if (wr == 0) PG8_BAR; }
    PG8_BAR;
#undef PG8_SA
#undef PG8_SB
#undef PG8_STAGE
#undef PG8_LDA
#undef PG8_LDB
#undef PG8_MMA
#undef PG8_WAIT_V
#undef PG8_WAIT_L
#undef PG8_BAR
#undef PG8_SCHED
}
}

template <int ACT> __device__ __forceinline__ u32x4 act_pack8(f32x4 v0, f32x4 v1) {
    if (ACT == 1) {
#pragma unroll
        for (int j = 0; j < 4; ++j) { v0[j] = silu_f(v0[j]); v1[j] = silu_f(v1[j]); } }
    if (ACT == 2) {
#pragma unroll
        for (int j = 0; j < 4; ++j) { v0[j] = sigmoid_f(v0[j]); v1[j] = sigmoid_f(v1[j]); } }
    u32x4 w; w.x = cvt_pk_bf16(v0[0], v0[1]); w.y = cvt_pk_bf16(v0[2], v0[3]); w.z = cvt_pk_bf16(v1[0], v1[1]); w.w = cvt_pk_bf16(v1[2], v1[3]); return w;
}
template <int ACT> __device__ __forceinline__ void store_tile_bf16(const f32x4 (&acc)[2][2][4][2], bf16_t* p00  , bf16_t* p01  , int ldc) {
#pragma unroll
    for (int ai = 0; ai < 2; ++ai)
#pragma unroll
        for (int m = 0; m < 4; ++m) { const size_t ro = (size_t)(ai * 128 + m * 16) * ldc;
            *(u32x4*)(p00 + ro) = act_pack8<ACT>(acc[ai][0][m][0], acc[ai][0][m][1]);
            *(u32x4*)(p01 + ro) = act_pack8<ACT>(acc[ai][1][m][0], acc[ai][1][m][1]); }
}
struct EpiInProj {
    static constexpr bool PERM = true, HAS_MID = false; static constexpr int MID1 = -1, MID2 = -1;
    bf16_t *CQKV, *G, *AXb, *WINb, *MG; const float* const* tab; int lofs; const f32x2* rope; int S; PG8_LAS float* Pt; float* RS;
    __device__ __forceinline__ void operator()(const f32x4 (&acc)[2][2][4][2], const pg8::Unit& u, int wr, int wc, int fr, int fq) const {
        const int pn = u.pn; bf16_t* base; int ldc, colt, act;
        if (pn < 4)       { base = CQKV; ldc = 1024; colt = pn * 256;               act = 0; }
        else if (pn < 8)  { base = G;    ldc = 3072; colt = (pn - 4) * 256;         act = 1; }
        else if (pn < 14) { base = AXb;  ldc = 1536; colt = (pn - 8) * 256;         act = 0; }
        else if (pn < 18) { base = G;    ldc = 3072; colt = 1024 + (pn - 14) * 256; act = 1; }
        else if (pn < 24) { base = WINb; ldc = 1536; colt = (pn - 18) * 256;        act = 0; }
        else if (pn < 28) { base = G;    ldc = 3072; colt = 2048 + (pn - 24) * 256; act = 1; }
        else              { base = MG;   ldc = 6144; colt = (pn - 28) * 256;        act = 2; }
        bf16_t* p0 = base + (size_t)(u.pm * 256 + wr * 64 + fr) * ldc + colt + wc * 32 + 8 * fq;
        if (pn < 4) {
            float ss[2][4];
#pragma unroll
            for (int ai = 0; ai < 2; ++ai)
#pragma unroll
                for (int m = 0; m < 4; ++m) { float q = 0.f;
#pragma unroll
                    for (int bj = 0; bj < 2; ++bj) { const f32x4 a = acc[ai][bj][m][0], b = acc[ai][bj][m][1];
                        q += (a[0] * a[0] + a[1] * a[1]) + (a[2] * a[2] + a[3] * a[3]) + (b[0] * b[0] + b[1] * b[1]) + (b[2] * b[2] + b[3] * b[3]); }
                    q += __shfl_xor(q, 16); q += __shfl_xor(q, 32); ss[ai][m] = q; }
            if (fq == 0) {
#pragma unroll
                for (int ai = 0; ai < 2; ++ai)
#pragma unroll
                    for (int m = 0; m < 4; ++m) Pt[(ai * 128 + wr * 64 + m * 16 + fr) * 8 + wc] = ss[ai][m]; }
            asm volatile("s_waitcnt lgkmcnt(0)" ::: "memory"); __builtin_amdgcn_s_barrier(); asm volatile("" ::: "memory");
            if (wc == 0 && fq == 0) {
#pragma unroll
                for (int ai = 0; ai < 2; ++ai)
#pragma unroll
                    for (int m = 0; m < 4; ++m) { const int rt = ai * 128 + wr * 64 + m * 16 + fr; const f32x4 t = *(const PG8_LAS f32x4*)(Pt + rt * 8);
                        RS[(size_t)(u.pm * 256 + rt) * 4 + pn] = (t[0] + t[1]) + (t[2] + t[3]); } }
        }
        const bool isax = pn >= 8 && pn < 13;
        if (isax || (pn >= 18 && pn < 23)) {
            float ss[2][4][2];
#pragma unroll
            for (int ai = 0; ai < 2; ++ai)
#pragma unroll
                for (int m = 0; m < 4; ++m)
#pragma unroll
                    for (int bj = 0; bj < 2; ++bj) { const f32x4 a = acc[ai][bj][m][0], b = acc[ai][bj][m][1];
                        float q = (a[0] * a[0] + a[1] * a[1]) + (a[2] * a[2] + a[3] * a[3]) + (b[0] * b[0] + b[1] * b[1]) + (b[2] * b[2] + b[3] * b[3]);
                        q += __shfl_xor(q, 16); q += __shfl_xor(q, 32);
                        ss[ai][m][bj] = q; }
            if (fq == 0) {
#pragma unroll
                for (int ai = 0; ai < 2; ++ai)
#pragma unroll
                    for (int m = 0; m < 4; ++m)
#pragma unroll
                        for (int bj = 0; bj < 2; ++bj) Pt[(ai * 128 + wr * 64 + m * 16 + fr) * 8 + bj * 4 + wc] = ss[ai][m][bj]; }
            asm volatile("s_waitcnt lgkmcnt(0)" ::: "memory"); __builtin_amdgcn_s_barrier(); asm volatile("" ::: "memory");
            const int half = wc >> 1, f4 = ((wc & 1) * 4 + fq) * 4;
            const float* gv = tab[(isax ? 14 : 16) + ((pn == 12 || pn == 22) ? 1 : 0)] + lofs + (isax ? half * 64 + f4 : wc * 32 + 8 * fq);
            const float osc = (isax && pn < 12) ? 0.088388347648318440f * 1.4426950408889634f : 1.0f;
            const f32x4 g0 = *(const f32x4*)gv * osc, g1 = *(const f32x4*)(gv + (isax ? 32 : 4)) * osc;
#pragma unroll
            for (int ai = 0; ai < 2; ++ai) { f32x4 ca[4], cb[4];
#pragma unroll
                for (int m = 0; m < 4; ++m) { ca[m] = (f32x4){1.f, 0.f, 1.f, 0.f}; cb[m] = ca[m];
                    if (isax) { const int sq = (u.pm * 256 + ai * 128 + wr * 64 + m * 16 + fr) & (S - 1), pos = half ? (sq & 63) : (sq >> 6);
                        ca[m] = *(const f32x4*)(rope + (size_t)pos * 32 + f4); cb[m] = *(const f32x4*)(rope + (size_t)pos * 32 + f4 + 2); } }
#pragma unroll
                for (int m = 0; m < 4; ++m) { bf16_t* rp = p0 + (size_t)(ai * 128 + m * 16) * ldc; const f32x4 c01 = ca[m], c23 = cb[m];
#pragma unroll
                    for (int bj = 0; bj < 2; ++bj) { const f32x4 t = *(const PG8_LAS f32x4*)(Pt + (ai * 128 + wr * 64 + m * 16 + fr) * 8 + bj * 4);
                        const float rstd = __builtin_amdgcn_rsqf(((t[0] + t[1]) + (t[2] + t[3])) * (1.0f / 128) + 1e-6f);
                        const f32x4 x1 = acc[ai][bj][m][0] * rstd * g0, x2 = acc[ai][bj][m][1] * rstd * g1;
                        const f32x4 cs = {c01[0], c01[2], c23[0], c23[2]}, sn = {c01[1], c01[3], c23[1], c23[3]};
                        const f32x4 v0 = x1 * cs - x2 * sn, v1 = x2 * cs + x1 * sn;
                        u32x4 w; w.x = cvt_pk_bf16(v0[0], v0[1]); w.y = cvt_pk_bf16(v0[2], v0[3]); w.z = cvt_pk_bf16(v1[0], v1[1]); w.w = cvt_pk_bf16(v1[2], v1[3]);
                        *(u32x4*)(rp + bj * 128) = w; } } }
            return;
        }
        if (act == 0) {
#pragma unroll
            for (int ai = 0; ai < 2; ++ai)
#pragma unroll
                for (int m = 0; m < 4; ++m) { bf16_t* rp = p0 + (size_t)(ai * 128 + m * 16) * ldc;
#pragma unroll
                    for (int bj = 0; bj < 2; ++bj) { const f32x4 v0 = acc[ai][bj][m][0], v1 = acc[ai][bj][m][1];
                        u32x4 w; w.x = cvt_pk_bf16(v0[0], v0[1]); w.y = cvt_pk_bf16(v0[2], v0[3]); w.z = cvt_pk_bf16(v1[0], v1[1]); w.w = cvt_pk_bf16(v1[2], v1[3]);
                        *(u32x4*)(rp + bj * 128) = w; } }
            return;
        }
        const float ka = (act == 2) ? 0.f : 1.f, kb = (act == 2) ? 1.f : 0.f;
#pragma unroll
        for (int ai = 0; ai < 2; ++ai)
#pragma unroll
            for (int m = 0; m < 4; ++m) { bf16_t* rp = p0 + (size_t)(ai * 128 + m * 16) * ldc;
#pragma unroll
                for (int bj = 0; bj < 2; ++bj) { f32x4 v0 = acc[ai][bj][m][0], v1 = acc[ai][bj][m][1];
                    f32x4 e0 = v0 * -1.4426950408889634f, e1 = v1 * -1.4426950408889634f;
#pragma unroll
                    for (int j = 0; j < 4; ++j) { e0[j] = __builtin_amdgcn_exp2f(e0[j]); e1[j] = __builtin_amdgcn_exp2f(e1[j]); }
                    e0 = e0 + 1.0f; e1 = e1 + 1.0f;
#pragma unroll
                    for (int j = 0; j < 4; ++j) { e0[j] = __builtin_amdgcn_rcpf(e0[j]); e1[j] = __builtin_amdgcn_rcpf(e1[j]); }
                    v0 = (v0 * ka + kb) * e0; v1 = (v1 * ka + kb) * e1;
                    u32x4 w; w.x = cvt_pk_bf16(v0[0], v0[1]); w.y = cvt_pk_bf16(v0[2], v0[3]); w.z = cvt_pk_bf16(v1[0], v1[1]); w.w = cvt_pk_bf16(v1[2], v1[3]);
                    *(u32x4*)(rp + bj * 128) = w; } }
    }
};
struct EpiPlain {
    static constexpr bool PERM = true, HAS_MID = false; static constexpr int MID1 = -1, MID2 = -1;
    bf16_t* O; int ldc;
    __device__ __forceinline__ void operator()(const f32x4 (&acc)[2][2][4][2], const pg8::Unit& u, int wr, int wc, int fr, int fq) const {
        bf16_t* p0 = O + (size_t)(u.pm * 256 + wr * 64 + fr) * ldc + u.pn * 256 + wc * 32 + 8 * fq;
        store_tile_bf16<0>(acc, p0, p0 + 128, ldc);
    }
};
template <int MODE> __device__ __forceinline__ void store_tile_rowscaled(const f32x4 (&acc)[2][2][4][2], bf16_t* p00, bf16_t* p01, int ldc, const float* rs  ) {
#pragma unroll
    for (int ai = 0; ai < 2; ++ai) { f32x4 t[4];
#pragma unroll
        for (int m = 0; m < 4; ++m) t[m] = *(const f32x4*)(rs + (size_t)(ai * 128 + m * 16) * 4);
#pragma unroll
        for (int m = 0; m < 4; ++m) { const size_t ro = (size_t)(ai * 128 + m * 16) * ldc;
            const float rstd = MODE == 0 ? __builtin_amdgcn_rsqf((t[m][0] + t[m][1]) * (1.0f / 512) + 1e-6f) : __builtin_amdgcn_rsqf(t[m][2] * (1.0f / 256) + 1e-6f);
            *(u32x4*)(p00 + ro) = act_pack8<0>(acc[ai][0][m][0] * rstd, acc[ai][0][m][1] * rstd);
            *(u32x4*)(p01 + ro) = act_pack8<0>(acc[ai][1][m][0] * rstd, acc[ai][1][m][1] * rstd); } }
}
#define ROW_SS8(q, A, B) const float q = ((A)[0] * (A)[0] + (A)[1] * (A)[1]) + ((A)[2] * (A)[2] + (A)[3] * (A)[3]) + ((B)[0] * (B)[0] + (B)[1] * (B)[1]) + ((B)[2] * (B)[2] + (B)[3] * (B)[3])
struct EpiQUp {
    static constexpr bool PERM = true, HAS_MID = false; static constexpr int MID1 = -1, MID2 = -1;
    bf16_t* O; const float* RS; const float* gain  ; const f32x2* rope; int S; PG8_LAS float* Pt;
    __device__ __forceinline__ void operator()(const f32x4 (&acc)[2][2][4][2], const pg8::Unit& u, int wr, int wc, int fr, int fq) const {
        const int row = u.pm * 256 + wr * 64 + fr, cn = wc * 32 + 8 * fq;
        float ss[2][4];
#pragma unroll
        for (int ai = 0; ai < 2; ++ai)
#pragma unroll
            for (int m = 0; m < 4; ++m) { ROW_SS8(q0, acc[ai][0][m][0], acc[ai][0][m][1]); ROW_SS8(q1, acc[ai][1][m][0], acc[ai][1][m][1]); float q = q0 + q1;
                q += __shfl_xor(q, 16); q += __shfl_xor(q, 32); ss[ai][m] = q; }
        if (fq == 0) {
#pragma unroll
            for (int ai = 0; ai < 2; ++ai)
#pragma unroll
                for (int m = 0; m < 4; ++m) Pt[(ai * 128 + wr * 64 + m * 16 + fr) * 8 + wc] = ss[ai][m]; }
        asm volatile("s_waitcnt lgkmcnt(0)" ::: "memory"); __builtin_amdgcn_s_barrier(); asm volatile("" ::: "memory");
        const float osc = 0.072168783648703220f * 1.4426950408889634f;
        const int f4 = ((wc & 1) * 4 + fq) * 4;
        const f32x4 gn0 = *(const f32x4*)(gain + cn) * osc, gn1 = *(const f32x4*)(gain + cn + 4) * osc, gr0 = *(const f32x4*)(gain + 128 + f4) * osc, gr1 = *(const f32x4*)(gain + 160 + f4) * osc;
        bf16_t* p0 = O + (size_t)row * 1536 + u.pn * 192 + cn;
#pragma unroll
        for (int ai = 0; ai < 2; ++ai) { f32x4 t[4], ca[4], cb[4];
#pragma unroll
            for (int m = 0; m < 4; ++m) { t[m] = *(const f32x4*)(RS + (size_t)(row + ai * 128 + m * 16) * 4);
                const int sq = (row + ai * 128 + m * 16) & (S - 1); ca[m] = *(const f32x4*)(rope + (size_t)sq * 32 + f4); cb[m] = *(const f32x4*)(rope + (size_t)sq * 32 + f4 + 2); }
#pragma unroll
            for (int m = 0; m < 4; ++m) { const int rt = ai * 128 + wr * 64 + m * 16 + fr; const f32x4 pp = *(const PG8_LAS f32x4*)(Pt + rt * 8);
                const float rc = __builtin_amdgcn_rsqf((t[m][0] + t[m][1]) * (1.0f / 512) + 1e-6f);
                const float sc = rc * __builtin_amdgcn_rsqf(rc * rc * ((pp[0] + pp[1]) + (pp[2] + pp[3])) * (1.0f / 192) + 1e-6f);
                bf16_t* rp = p0 + (size_t)(ai * 128 + m * 16) * 1536;
                *(u32x4*)rp = act_pack8<0>(acc[ai][0][m][0] * sc * gn0, acc[ai][0][m][1] * sc * gn1);
                if (wc < 2) { const f32x4 c01 = ca[m], c23 = cb[m];
                    const f32x4 cs = {c01[0], c01[2], c23[0], c23[2]}, sn = {c01[1], c01[3], c23[1], c23[3]};
                    const f32x4 x1 = acc[ai][1][m][0] * sc * gr0, x2 = acc[ai][1][m][1] * sc * gr1;
                    *(u32x4*)(rp + 128) = act_pack8<0>(x1 * cs - x2 * sn, x2 * cs + x1 * sn); } } }
    }
};
struct EpiKV {
    static constexpr bool PERM = true, HAS_MID = false; static constexpr int MID1 = -1, MID2 = -1;
    bf16_t *KF, *VM; const float* RS; const bf16_t* CQKV; const float* gain  ; const f32x2* rope; int S; PG8_LAS float* Pt;
    __device__ __forceinline__ void operator()(const f32x4 (&acc)[2][2][4][2], const pg8::Unit& u, int wr, int wc, int fr, int fq) const {
        const int row = u.pm * 256 + wr * 64 + fr, cn = wc * 32 + 8 * fq;
        if (u.pn >= 4) { bf16_t* p0 = VM + (u.pn - 4) * 256 + (size_t)row * 1024 + cn; store_tile_rowscaled<1>(acc, p0, p0 + 128, 1024, RS + (size_t)row * 4); return; }
        float ss[2][4][2];
#pragma unroll
        for (int ai = 0; ai < 2; ++ai)
#pragma unroll
            for (int m = 0; m < 4; ++m)
#pragma unroll
                for (int bj = 0; bj < 2; ++bj) { ROW_SS8(q0, acc[ai][bj][m][0], acc[ai][bj][m][1]); float q = q0; q += __shfl_xor(q, 16); q += __shfl_xor(q, 32); ss[ai][m][bj] = q; }
        if (fq == 0) {
#pragma unroll
            for (int ai = 0; ai < 2; ++ai)
#pragma unroll
                for (int m = 0; m < 4; ++m)
#pragma unroll
                    for (int bj = 0; bj < 2; ++bj) Pt[(ai * 128 + wr * 64 + m * 16 + fr) * 8 + bj * 4 + wc] = ss[ai][m][bj]; }
        asm volatile("s_waitcnt lgkmcnt(0)" ::: "memory"); __builtin_amdgcn_s_barrier(); asm volatile("" ::: "memory");
        const int idx = wc * 4 + fq;
        const f32x4 g0 = *(const f32x4*)(gain + cn), g1 = *(const f32x4*)(gain + cn + 4); const f32x2 gx = *(const f32x2*)(gain + 128 + 2 * idx), gy = *(const f32x2*)(gain + 160 + 2 * idx);
        bf16_t* p0 = KF + (size_t)row * 1536 + (u.pn * 2) * 192 + cn;
        bf16_t* pr = KF + (size_t)row * 1536 + (u.pn * 2) * 192 + 128 + 8 * (idx >> 1) + 2 * (idx & 1);
#pragma unroll
        for (int ai = 0; ai < 2; ++ai) { f32x4 t[4]; unsigned k0[4], k1[4]; f32x4 cs[4];
#pragma unroll
            for (int m = 0; m < 4; ++m) { const size_t r = (size_t)(row + ai * 128 + m * 16); t[m] = *(const f32x4*)(RS + r * 4);
                k0[m] = *(const unsigned*)(CQKV + r * 1024 + 768 + 2 * idx); k1[m] = *(const unsigned*)(CQKV + r * 1024 + 800 + 2 * idx);
                cs[m] = *(const f32x4*)(rope + (size_t)((int)r & (S - 1)) * 32 + 2 * idx); }
#pragma unroll
            for (int m = 0; m < 4; ++m) { const int rt = ai * 128 + wr * 64 + m * 16 + fr;
                const float rc = __builtin_amdgcn_rsqf(t[m][2] * (1.0f / 256) + 1e-6f);
                const float x0 = bf_lo(k0[m]), x1 = bf_hi(k0[m]), y0 = bf_lo(k1[m]), y1 = bf_hi(k1[m]);
#pragma unroll
                for (int bj = 0; bj < 2; ++bj) { const f32x4 pp = *(const PG8_LAS f32x4*)(Pt + rt * 8 + bj * 4);
                    const float rk = __builtin_amdgcn_rsqf((rc * rc * ((pp[0] + pp[1]) + (pp[2] + pp[3])) + t[m][3]) * (1.0f / 192) + 1e-6f), sc = rc * rk;
                    const size_t ro = (size_t)(ai * 128 + m * 16) * 1536 + bj * 192;
                    *(u32x4*)(p0 + ro) = act_pack8<0>(acc[ai][bj][m][0] * sc * g0, acc[ai][bj][m][1] * sc * g1);
                    const float a0 = x0 * rk * gx.x, a1 = x1 * rk * gx.y, b0 = y0 * rk * gy.x, b1 = y1 * rk * gy.y;
                    *(unsigned*)(pr + ro) = cvt_pk_bf16(a0 * cs[m][0] - b0 * cs[m][1], a1 * cs[m][2] - b1 * cs[m][3]);
                    *(unsigned*)(pr + ro + 4) = cvt_pk_bf16(b0 * cs[m][0] + a0 * cs[m][1], b1 * cs[m][2] + a1 * cs[m][3]); } } }
    }
};
struct EpiBranchFused {
    static constexpr bool PERM = true, HAS_MID = true; static constexpr int MID1 = 16, MID2 = 32;
    const bf16_t* MG; bf16_t* YB;
    __device__ __forceinline__ void mid(f32x4 (&acc)[2][2][4][2], const pg8::Unit& u, int t, int wr, int wc, int fr, int fq) const {
        const int b = (t == MID1) ? 0 : 1; const bf16_t* g0 = MG + (size_t)(u.pm * 256 + wr * 64 + fr) * 6144 + b * 2048 + u.pn * 256 + wc * 32 + 8 * fq;
#pragma unroll
        for (int ai = 0; ai < 2; ++ai) {
            u32x4 a[4][2], d[4][2];
#pragma unroll
            for (int m = 0; m < 4; ++m)
#pragma unroll
                for (int bj = 0; bj < 2; ++bj) { const bf16_t* gp = g0 + (size_t)(ai * 128 + m * 16) * 6144 + bj * 128; a[m][bj] = *(const u32x4*)gp; d[m][bj] = *(const u32x4*)(gp + 2048); }
#define RAT(x, y) ((x) * __builtin_amdgcn_rcpf(fmaxf((y), 1e-20f)))
#pragma unroll
            for (int m = 0; m < 4; ++m)
#pragma unroll
                for (int bj = 0; bj < 2; ++bj) { const u32x4 A = a[m][bj], D = d[m][bj];
                    acc[ai][bj][m][0][0] *= RAT(bf_lo(A.x), bf_lo(D.x)); acc[ai][bj][m][0][1] *= RAT(bf_hi(A.x), bf_hi(D.x)); acc[ai][bj][m][0][2] *= RAT(bf_lo(A.y), bf_lo(D.y)); acc[ai][bj][m][0][3] *= RAT(bf_hi(A.y), bf_hi(D.y));
                    acc[ai][bj][m][1][0] *= RAT(bf_lo(A.z), bf_lo(D.z)); acc[ai][bj][m][1][1] *= RAT(bf_hi(A.z), bf_hi(D.z)); acc[ai][bj][m][1][2] *= RAT(bf_lo(A.w), bf_lo(D.w)); acc[ai][bj][m][1][3] *= RAT(bf_hi(A.w), bf_hi(D.w)); }
#undef RAT
            __builtin_amdgcn_sched_barrier(0); }
    }
    __device__ __forceinline__ void operator()(const f32x4 (&acc)[2][2][4][2], const pg8::Unit& u, int wr, int wc, int fr, int fq) const {
        const int row0 = u.pm * 256 + wr * 64 + fr, col0 = u.pn * 256 + wc * 32 + 8 * fq;
#pragma unroll
        for (int ai = 0; ai < 2; ++ai) {
            u32x4 gwv[4][2];
#pragma unroll
            for (int m = 0; m < 4; ++m)
#pragma unroll
                for (int bj = 0; bj < 2; ++bj) gwv[m][bj] = *(const u32x4*)(MG + (size_t)(row0 + ai * 128 + m * 16) * 6144 + 2 * 2048 + col0 + bj * 128);
#pragma unroll
            for (int m = 0; m < 4; ++m)
#pragma unroll
                for (int bj = 0; bj < 2; ++bj) { const size_t r = (size_t)(row0 + ai * 128 + m * 16); const int c = col0 + bj * 128; const u32x4 gw = gwv[m][bj];
                    f32x4 v0 = acc[ai][bj][m][0], v1 = acc[ai][bj][m][1];
                    v0[0] *= bf_lo(gw.x); v0[1] *= bf_hi(gw.x); v0[2] *= bf_lo(gw.y); v0[3] *= bf_hi(gw.y);
                    v1[0] *= bf_lo(gw.z); v1[1] *= bf_hi(gw.z); v1[2] *= bf_lo(gw.w); v1[3] *= bf_hi(gw.w);
                    u32x4 w; w.x = cvt_pk_bf16(v0[0], v0[1]); w.y = cvt_pk_bf16(v0[2], v0[3]); w.z = cvt_pk_bf16(v1[0], v1[1]); w.w = cvt_pk_bf16(v1[2], v1[3]); *(u32x4*)(YB + r * 2048 + c) = w; }
            __builtin_amdgcn_sched_barrier(0); }
    }
};
struct EpiOut {
    static constexpr bool PERM = false, HAS_MID = false; static constexpr int MID1 = -1, MID2 = -1;
    const float* X; float* O; const float* gate0  ; int bbase, S;
    __device__ __forceinline__ void operator()(const f32x4 (&acc)[2][2][4][2], const pg8::Unit& u, int wr, int wc, int fr, int fq) const {
        const int row0 = u.pm * 256 + wr * 64 + fr, col0 = u.pn * 256 + wc * 32 + 4 * fq;
        const float* gp = gate0 + (size_t)(bbase + (u.pm * 256) / S) * 6144 + col0;
        f32x4 gv[2][2];
#pragma unroll
        for (int bj = 0; bj < 2; ++bj)
#pragma unroll
            for (int n = 0; n < 2; ++n) gv[bj][n] = *(const f32x4*)(gp + bj * 128 + n * 16);
#pragma unroll
        for (int ai = 0; ai < 2; ++ai) {
            f32x4 xv[4][2][2];
#pragma unroll
            for (int m = 0; m < 4; ++m)
#pragma unroll
                for (int bj = 0; bj < 2; ++bj)
#pragma unroll
                    for (int n = 0; n < 2; ++n) xv[m][bj][n] = *(const f32x4*)(X + (size_t)(row0 + ai * 128 + m * 16) * 2048 + col0 + bj * 128 + n * 16);
#pragma unroll
            for (int m = 0; m < 4; ++m)
#pragma unroll
                for (int bj = 0; bj < 2; ++bj)
#pragma unroll
                    for (int n = 0; n < 2; ++n) *(f32x4*)(O + (size_t)(row0 + ai * 128 + m * 16) * 2048 + col0 + bj * 128 + n * 16) = xv[m][bj][n] + gv[bj][n] * acc[ai][bj][m][n];
            __builtin_amdgcn_sched_barrier(0); }
    }
};
namespace att {
constexpr int NW = 8, QBLK = 32, KVBLK = 64;
constexpr float THR = 8.f;
constexpr size_t SHM_V = KVBLK * 128 * 2;
#define KSWZ(row, colB) ((row) * 256 + ((colB) ^ (((row) & 15) << 4)))
#define KSWZ192(row, colB) ((row) * 384 + ((colB) ^ ((((row) >> 1) & 7) << 4)))
#define SBAR() __builtin_amdgcn_sched_barrier(0)
__device__ __forceinline__ int crow(int r, int hi) { return (r & 3) + 8 * (r >> 2) + 4 * hi; }
__device__ __forceinline__ unsigned cvtpk(float lo, float hi) { unsigned r; asm volatile("v_cvt_pk_bf16_f32 %0, %1, %2" : "=v"(r) : "v"(lo), "v"(hi)); return r; }
__device__ __forceinline__ bf16x8 ld8(const bf16_t* p) { return *reinterpret_cast<const bf16x8*>(p); }

template <bool WIN, int PRESC = 0> __device__ __forceinline__ void partialSM(f32x16& p0, f32x16& p1, float& m_reg, float& mn, float& alpha, const float C, const float* tl) {
  if constexpr (!WIN && (PRESC == 1 || PRESC == 2)) {
    alpha = 1.f; mn = 0.f;
#pragma unroll
    for (int r = 0; r < 16; ++r) p0[r] = __builtin_amdgcn_exp2f(p0[r]);
    return;
  }
  if constexpr (!WIN) {
    const float mneg = m_reg;
    alpha = 1.f; mn = 0.f; const float Cq = (PRESC == 3) ? 1.0f : C;
#pragma unroll
    for (int r = 0; r < 16; ++r) { p0[r] = __builtin_amdgcn_exp2f(fmaf(p0[r], Cq, mneg)); p1[r] = fmaf(p1[r], Cq, mneg); }
    return;
  }
  if constexpr (WIN) {
#pragma unroll
    for (int r = 0; r < 16; ++r) { p0[r] = fmaf(p0[r], C, tl[(r & 3) + 8 * (r >> 2)]); p1[r] = fmaf(p1[r], C, tl[32 + (r & 3) + 8 * (r >> 2)]); }
  }
  float pmax = p0[0];
#pragma unroll
  for (int r = 1; r < 16; ++r) pmax = fmaxf(pmax, p0[r]);
#pragma unroll
  for (int r = 0; r < 16; ++r) pmax = fmaxf(pmax, p1[r]);
  { auto rr = __builtin_amdgcn_permlane32_swap(__float_as_uint(pmax), __float_as_uint(pmax), false, false);
    pmax = fmaxf(__uint_as_float(rr[0]), __uint_as_float(rr[1])); }
  if constexpr (WIN) {
    if (__builtin_expect(__all(pmax - m_reg <= THR * 1.4426950408889634f), 1)) { mn = m_reg; alpha = 1.f; }
    else { mn = fmaxf(m_reg, pmax); alpha = __builtin_amdgcn_exp2f(m_reg - mn); m_reg = mn; }
#pragma unroll
    for (int r = 0; r < 16; ++r) { p0[r] -= mn; p1[r] -= mn; }
  } else {
    if (__builtin_expect(__all((pmax - m_reg) * C <= THR * 1.4426950408889634f), 1)) { mn = m_reg; alpha = 1.f; }
    else { mn = fmaxf(m_reg, pmax); alpha = __builtin_amdgcn_exp2f((m_reg - mn) * C); m_reg = mn; }
    const float mnC = -mn * C;
#pragma unroll
    for (int r = 0; r < 16; ++r) { p0[r] = fmaf(p0[r], C, mnC); p1[r] = fmaf(p1[r], C, mnC); }
  }
#pragma unroll
  for (int r = 0; r < 16; ++r) p0[r] = __builtin_amdgcn_exp2f(p0[r]);
}
__device__ __forceinline__ void finishSM(f32x16& p0, f32x16& p1, float alpha, float& l_reg, bf16x8& pa0, bf16x8& pa1, bf16x8& pa2, bf16x8& pa3) {
#pragma unroll
  for (int r = 0; r < 16; ++r) p1[r] = __builtin_amdgcn_exp2f(p1[r]);
  float ps = 0;
#pragma unroll
  for (int r = 0; r < 16; ++r) ps += p0[r];
#pragma unroll
  for (int r = 0; r < 16; ++r) ps += p1[r];
  { auto rr = __builtin_amdgcn_permlane32_swap(__float_as_uint(ps), __float_as_uint(ps), false, false);
    ps = __uint_as_float(rr[0]) + __uint_as_float(rr[1]); }
  l_reg = l_reg * alpha + ps;
#define PK4(P, BASE, OUT) do { unsigned a0 = cvtpk(P[BASE + 0], P[BASE + 1]), a1 = cvtpk(P[BASE + 2], P[BASE + 3]);   \
    unsigned b0 = cvtpk(P[BASE + 4], P[BASE + 5]), b1 = cvtpk(P[BASE + 6], P[BASE + 7]);                              \
    auto r0 = __builtin_amdgcn_permlane32_swap(a0, b0, false, false); auto r1 = __builtin_amdgcn_permlane32_swap(a1, b1, false, false); \
    u32x4 w = {r0[0], r1[0], r0[1], r1[1]}; OUT = *reinterpret_cast<bf16x8*>(&w); } while (0)
  PK4(p0, 0, pa0); PK4(p0, 8, pa1); PK4(p1, 0, pa2); PK4(p1, 8, pa3);
#undef PK4
}
template <int DK> __device__ __forceinline__ void qkt(f32x16& p0, f32x16& p1, const char* Ks, const bf16x8* qr, int r32, int hi, const float init = 0.f) {
#pragma unroll
  for (int r = 0; r < 16; ++r) { p0[r] = init; p1[r] = init; }
#pragma unroll
  for (int d0 = 0; d0 < DK / 16; ++d0) { const int cb = (d0 * 16 + hi * 8) * 2;
    const bf16x8 b0 = *reinterpret_cast<const bf16x8*>(Ks + (DK == 128 ? KSWZ(r32, cb) : KSWZ192(r32, cb)));
    const bf16x8 b1 = *reinterpret_cast<const bf16x8*>(Ks + (DK == 128 ? KSWZ(32 + r32, cb) : KSWZ192(32 + r32, cb)));
    p0 = __builtin_amdgcn_mfma_f32_32x32x16_bf16(b0, qr[d0], p0, 0, 0, 0);
    p1 = __builtin_amdgcn_mfma_f32_32x32x16_bf16(b1, qr[d0], p1, 0, 0, 0); }
}
__device__ __forceinline__ int v_st(int k, int c) { const int kk = (k & ~0xC) | ((k & 4) << 1) | ((k & 8) >> 1); return ((kk >> 3) * 4 + (c >> 5)) * 512 + ((kk & 7) * 32 + (c & 31)) * 2; }
__device__ __forceinline__ int v_rd_base(int lane) { return ((lane & 3) << 3) | (((lane >> 2) & 3) << 6) | (((lane >> 4) & 1) << 5) | (((lane >> 5) & 1) << 8); }
constexpr int v_rd_off(int d0, int ks, int half) { return d0 * 512 + ks * 4096 + half * 2048; }
template <int OFF> __device__ __forceinline__ s16x4 tr_read(int vb) {
  s16x4 r; asm volatile("ds_read_b64_tr_b16 %0, %1 offset:%2" : "=&v"(r) : "v"(vb), "i"(OFF) : "memory"); return r;
}
template <int D0> __device__ __forceinline__ void pv_one(f32x16& od, int vb, bf16x8 pa0, bf16x8 pa1, bf16x8 pa2, bf16x8 pa3) {
  const s16x4 l0 = tr_read<v_rd_off(D0, 0, 0)>(vb), h0 = tr_read<v_rd_off(D0, 0, 1)>(vb), l1 = tr_read<v_rd_off(D0, 1, 0)>(vb), h1 = tr_read<v_rd_off(D0, 1, 1)>(vb);
  const s16x4 l2 = tr_read<v_rd_off(D0, 2, 0)>(vb), h2 = tr_read<v_rd_off(D0, 2, 1)>(vb), l3 = tr_read<v_rd_off(D0, 3, 0)>(vb), h3 = tr_read<v_rd_off(D0, 3, 1)>(vb);
  asm volatile("s_waitcnt lgkmcnt(0)" ::: "memory"); SBAR();
#define PK(L, H) (bf16x8){L[0], L[1], L[2], L[3], H[0], H[1], H[2], H[3]}
  od = __builtin_amdgcn_mfma_f32_32x32x16_bf16(pa0, PK(l0, h0), od, 0, 0, 0);
  od = __builtin_amdgcn_mfma_f32_32x32x16_bf16(pa1, PK(l1, h1), od, 0, 0, 0);
  od = __builtin_amdgcn_mfma_f32_32x32x16_bf16(pa2, PK(l2, h2), od, 0, 0, 0);
  od = __builtin_amdgcn_mfma_f32_32x32x16_bf16(pa3, PK(l3, h3), od, 0, 0, 0);
#undef PK
}
__device__ __forceinline__ void pv_d0(f32x16* o, int vb, bf16x8 pa0, bf16x8 pa1, bf16x8 pa2, bf16x8 pa3) {
  pv_one<0>(o[0], vb, pa0, pa1, pa2, pa3); pv_one<1>(o[1], vb, pa0, pa1, pa2, pa3); pv_one<2>(o[2], vb, pa0, pa1, pa2, pa3); pv_one<3>(o[3], vb, pa0, pa1, pa2, pa3);
}
constexpr size_t lds_bytes(int DK) { return 2 * SHM_V + 2 * (size_t)KVBLK * DK * 2 + NW * 64 * 4 + 768 * 4; }

template <int DK, int SD, int LDQ, int LDK, int LDV, int LDO, bool WIN, int PRESC = 0>
__device__ __forceinline__ void attn_unit(const bf16_t* __restrict__ Qb, const bf16_t* __restrict__ Kh, const bf16_t* __restrict__ Vh, bf16_t* __restrict__ Ob,
                                          const int NT, const float m_init, const float l_init, const float* __restrict__ tbg, const int tb0, char* lds) {
  constexpr int ND = DK / 16;
  constexpr size_t SHM_K = (size_t)KVBLK * DK * 2;
  constexpr float SCALE = (DK == 128) ? 0.088388347648318440f : 0.072168783648703220f;
  constexpr float C = SCALE * 1.4426950408889634f;
  int tid_ = threadIdx.x; asm volatile("" : "+v"(tid_));
  const int tid = tid_, wid = tid >> 6, lane = tid & 63, r32 = lane & 31, hi = lane >> 5;
  char* V_lds = lds; char* K_lds = lds + 2 * SHM_V;
  float* ws = (float*)(lds + 2 * SHM_V + 2 * SHM_K) + wid * 64; float* li_l = ws; float* al_l = ws + 32;
  float* tbl = (float*)(lds + 2 * SHM_V + 2 * SHM_K + NW * 64 * 4);
  const float* tlw = tbl + (tb0 - wid * 32 - r32 + 4 * hi);
  float m_reg = m_init, l_reg = l_init; f32x16 o[4] = {}; bf16x8 qr[ND];
  const bf16_t* Qw = Qb + (long)(wid * QBLK + r32) * LDQ + hi * 8;
#pragma unroll
  for (int d0 = 0; d0 < ND; ++d0) qr[d0] = ld8(Qw + d0 * 16);
  const int sr = tid >> 4, sc = (tid & 15) * 8, vst0 = v_st(sr, sc), vst1 = v_st(32 + sr, sc);
  const int kr0 = tid >> 3, kc0 = tid & 7;
  const int vb0 = (int)(uintptr_t)V_lds + v_rd_base(lane);
  struct Slot { bf16x8 vs0, vs1, ks0, ks1, ks2; } sr_[SD];
#define SLOAD(i, k0) do { sr_[i].vs0 = ld8(&Vh[(long)((k0) + sr) * LDV + sc]); sr_[i].vs1 = ld8(&Vh[(long)((k0) + 32 + sr) * LDV + sc]); \
    if constexpr (DK == 128) { sr_[i].ks0 = ld8(&Kh[(long)((k0) + sr) * LDK + sc]); sr_[i].ks1 = ld8(&Kh[(long)((k0) + 32 + sr) * LDK + sc]); } \
    else { const bf16_t* kp_ = &Kh[(long)((k0) + kr0) * LDK + kc0 * 8]; sr_[i].ks0 = ld8(kp_); sr_[i].ks1 = ld8(kp_ + 64); sr_[i].ks2 = ld8(kp_ + 128); } } while (0)
#define SWRITE(b, i) do { *(bf16x8*)(V_lds + (b) * SHM_V + vst0) = sr_[i].vs0; *(bf16x8*)(V_lds + (b) * SHM_V + vst1) = sr_[i].vs1; \
    if constexpr (DK == 128) { const int kc = sc * 2; *(bf16x8*)(K_lds + (b) * SHM_K + KSWZ(sr, kc)) = sr_[i].ks0; *(bf16x8*)(K_lds + (b) * SHM_K + KSWZ(32 + sr, kc)) = sr_[i].ks1; } \
    else { char* kw_ = K_lds + (b) * SHM_K + KSWZ192(kr0, kc0 * 16); *(bf16x8*)kw_ = sr_[i].ks0; *(bf16x8*)(kw_ + 128) = sr_[i].ks1; *(bf16x8*)(kw_ + 256) = sr_[i].ks2; } } while (0)
#define SWAIT() do { if constexpr (SD == 2) { if constexpr (DK == 128) asm volatile("s_waitcnt vmcnt(4)" ::: "memory"); else asm volatile("s_waitcnt vmcnt(5)" ::: "memory"); } \
    else asm volatile("s_waitcnt vmcnt(0)" ::: "memory"); } while (0)
#define RESC(a) do { if constexpr (WIN) if (__any((a) < 1.f)) { if (hi == 0) al_l[r32] = (a); asm volatile("s_waitcnt lgkmcnt(0)" ::: "memory"); \
    _Pragma("unroll") for (int d = 0; d < 4; ++d) _Pragma("unroll") for (int r = 0; r < 16; ++r) o[d][r] *= al_l[crow(r, hi)]; } } while (0)
  f32x16 pA0, pA1, pB0, pB1; float mnA, mnB, alA, alB; bf16x8 pa0, pa1, pa2, pa3;
  constexpr int SE = 0, SO = SD - 1;
  SLOAD(SE, 0);
  __syncthreads();
  if constexpr (WIN) { for (int i = tid; i < 768; i += 512) tbl[i] = tbg[i]; }
  asm volatile("s_waitcnt vmcnt(0)" ::: "memory"); SWRITE(0, SE); __syncthreads();
  qkt<DK>(pA0, pA1, K_lds, qr, r32, hi, (PRESC == 1) ? m_init : 0.f); partialSM<WIN, PRESC>(pA0, pA1, m_reg, mnA, alA, C, tlw);
  SLOAD(SO, KVBLK); if constexpr (SD == 2) { if (2 < NT) SLOAD(SE, 2 * KVBLK); }
  SWAIT(); SWRITE(1, SO); __syncthreads();
  for (int j = 1; j + 1 < NT; j += 2) {
    SBAR(); qkt<DK>(pB0, pB1, K_lds + SHM_K, qr, r32, hi, (PRESC == 1) ? m_init : 0.f);
    finishSM(pA0, pA1, alA, l_reg, pa0, pa1, pa2, pa3); SBAR();
    SLOAD(SO, (j + SD) * KVBLK); SBAR();
    pv_d0(o, vb0, pa0, pa1, pa2, pa3); partialSM<WIN, PRESC>(pB0, pB1, m_reg, mnB, alB, C, tlw + 64 * j);
    __syncthreads(); SWAIT(); SWRITE(0, SE);
    RESC(alB); __syncthreads();
    SBAR(); qkt<DK>(pA0, pA1, K_lds, qr, r32, hi, (PRESC == 1) ? m_init : 0.f);
    finishSM(pB0, pB1, alB, l_reg, pa0, pa1, pa2, pa3); SBAR();
    if (SD == 1 || j + 3 < NT) SLOAD(SE, (j + 1 + SD) * KVBLK); SBAR();
    pv_d0(o, vb0 + (int)SHM_V, pa0, pa1, pa2, pa3); partialSM<WIN, PRESC>(pA0, pA1, m_reg, mnA, alA, C, tlw + 64 * (j + 1));
    __syncthreads(); SWAIT(); SWRITE(1, SO);
    RESC(alA); __syncthreads();
  }
  SBAR(); qkt<DK>(pB0, pB1, K_lds + SHM_K, qr, r32, hi, (PRESC == 1) ? m_init : 0.f);
  finishSM(pA0, pA1, alA, l_reg, pa0, pa1, pa2, pa3); SBAR();
  pv_d0(o, vb0, pa0, pa1, pa2, pa3); partialSM<WIN, PRESC>(pB0, pB1, m_reg, mnB, alB, C, tlw + 64 * (NT - 1));
  __syncthreads(); RESC(alB);
  finishSM(pB0, pB1, alB, l_reg, pa0, pa1, pa2, pa3); SBAR();
  pv_d0(o, vb0 + (int)SHM_V, pa0, pa1, pa2, pa3);
  if (hi == 0) li_l[r32] = l_reg; asm volatile("s_waitcnt lgkmcnt(0)" ::: "memory");
  __syncthreads();
  const int widu = __builtin_amdgcn_readfirstlane(wid);
  bf16_t* stg = (bf16_t*)(lds + widu * 8192);
#pragma unroll
  for (int r = 0; r < 16; ++r) { const int orow = crow(r, hi); const float rl = __builtin_amdgcn_rcpf(li_l[orow]);
#pragma unroll
    for (int d0 = 0; d0 < 4; ++d0) stg[orow * 128 + d0 * 32 + r32] = f2bf(o[d0][r] * rl); }
  asm volatile("s_waitcnt lgkmcnt(0)" ::: "memory");
  bf16_t* Og = Ob + (long)(widu * QBLK) * LDO;
#pragma unroll
  for (int ib = 0; ib < 8; ib += 4) {
    u32x4 gv[4];
#pragma unroll
    for (int i = 0; i < 4; ++i) { const int q = (ib + i) * 64 + lane; gv[i] = *(const u32x4*)(Og + (long)(q >> 4) * LDO + (q & 15) * 8); }
#pragma unroll
    for (int i = 0; i < 4; ++i) { const int q = (ib + i) * 64 + lane; const u32x4 ov = *(const u32x4*)(stg + (q >> 4) * 128 + (q & 15) * 8); const u32x4 g = gv[i]; u32x4 w;
      w.x = cvtpk(bf_lo(ov.x) * bf_lo(g.x), bf_hi(ov.x) * bf_hi(g.x)); w.y = cvtpk(bf_lo(ov.y) * bf_lo(g.y), bf_hi(ov.y) * bf_hi(g.y));
      w.z = cvtpk(bf_lo(ov.z) * bf_lo(g.z), bf_hi(ov.z) * bf_hi(g.z)); w.w = cvtpk(bf_lo(ov.w) * bf_lo(g.w), bf_hi(ov.w) * bf_hi(g.w));
      *(u32x4*)(Og + (long)(q >> 4) * LDO + (q & 15) * 8) = w; }
  }
#undef SLOAD
#undef SWRITE
#undef SWAIT
#undef RESC
}
}
constexpr int DM = 2048, DEPTH = 4, NPASS = 2, TPMAX = 32768, NIN = 13120, NINP = 13312, NWAVES = 8;
constexpr int T_PROMPT = 32768, T_SAMPLE = 16384;
constexpr float RMS_EPS = 1e-6f;
constexpr int KS_ADA = 32;
constexpr int NSTEP_PRO = 2, NSTEP_IT = 8, NSTEPS = NSTEP_PRO + DEPTH * NPASS * NSTEP_IT;
constexpr size_t MiB = 1u << 20;
constexpr size_t WS_CTL = 0, CTL_ZERO_BYTES = 1 * MiB;
constexpr size_t WS_PTRS = 512 * 1024;
constexpr size_t WS_MOD = 1 * MiB;
constexpr size_t WS_ROPE = 3 * MiB;
constexpr size_t WS_TB = 4 * MiB;
constexpr size_t WS_MODP = 5 * MiB;
constexpr size_t WS_RS = 54 * MiB;
constexpr size_t WS_WIN_T = 64 * MiB;
constexpr size_t WS_WQ_T = 55 * MiB;
constexpr size_t WS_WKV_T = 278 * MiB;
constexpr size_t WS_WBR_T = 282 * MiB;
constexpr size_t WS_WOUT_T = 330 * MiB;
constexpr size_t WS_H = 362 * MiB;
constexpr size_t WS_CQKV = 490 * MiB;
constexpr size_t WS_QM = 554 * MiB;
constexpr size_t WS_KF = 650 * MiB;
constexpr size_t WS_VM = 746 * MiB;
constexpr size_t WS_AX = 810 * MiB;
constexpr size_t WS_WINB = 906 * MiB;
constexpr size_t WS_G = 1002 * MiB;
constexpr size_t WS_MG = 1194 * MiB;
constexpr size_t WS_END = 1578 * MiB;
static_assert(WS_WIN_T + (size_t)4 * NINP * DM * 2 <= WS_WKV_T - 6 * MiB && WS_RS + (size_t)TPMAX * 16 <= WS_WQ_T && WS_WQ_T + (size_t)4 * 2048 * 512 * 2 <= WS_WIN_T && WS_MODP + (size_t)KS_ADA * 4 * 16 * 6144 * 4 <= WS_WIN_T && WS_MG + (size_t)TPMAX * 6144 * 2 <= WS_END && WS_H + (size_t)TPMAX * 2048 * 2 <= WS_CQKV, "d_ws map");
constexpr int RING_OFF = 0, RING_BYTES = 131072;
constexpr int LDSCTL_OFF = RING_BYTES;
constexpr int LDS_BYTES = 147456;
static_assert(att::lds_bytes(192) <= RING_BYTES, "attention LDS");

#define LDS_WAIT() asm volatile("s_waitcnt lgkmcnt(0)" ::: "memory")
#define VM_WAIT() asm volatile("s_waitcnt vmcnt(0)" ::: "memory")

#define XB_TMO      128
#define XB_XCNT(j)  (256  + 64 * (j))
#define XB_XSUB(j)  (1280 + 64 * (j))
#define XB_XGEN(j)  (2304 + 64 * (j))
#define XB_TOP      3328
#define XB_TOPGEN   3392
#define XCD_BAR_WORDS 3456
#define XB_SPIN_CAP (1u << 22)

__device__ __forceinline__ unsigned xb_ld(unsigned* p)              { return __hip_atomic_load(p, __ATOMIC_RELAXED, __HIP_MEMORY_SCOPE_AGENT); }
__device__ __forceinline__ unsigned xb_add(unsigned* p, unsigned v) { return __hip_atomic_fetch_add(p, v, __ATOMIC_RELAXED, __HIP_MEMORY_SCOPE_AGENT); }
__device__ __forceinline__ unsigned xb_xcc_id() { return (unsigned)__builtin_amdgcn_s_getreg((3 << 11) | 20) & 0xFu; }
#define XB_SPIN(cond, bar) do { unsigned _sp = 0; while (cond) { __builtin_amdgcn_s_sleep(1); \
    if ((++_sp & 255u) == 0u) { if (xb_ld(&(bar)[XB_TMO])) break; if (_sp > XB_SPIN_CAP) { atomicAdd(&(bar)[XB_TMO], 1u); break; } } } } while (0)

struct XcdBarrier {
    unsigned* bar; unsigned x;
    volatile LAS unsigned* st;
};
__device__ __forceinline__ XcdBarrier xcd_barrier_post(unsigned* bar, volatile LAS unsigned* st) {
    XcdBarrier b; b.bar = bar; b.x = xb_xcc_id(); b.st = st;
    if (threadIdx.x == 0) (void)xb_add(&bar[XB_XCNT(b.x)], 1u);
    return b;
}
__device__ __forceinline__ void xcd_barrier_complete(unsigned* bar, unsigned x, unsigned& nloc, unsigned& nx) {
    const unsigned G = gridDim.x * gridDim.y * gridDim.z;
    unsigned sum, cnt, mine, sp = 0u;
    for (;;) {
        sum = 0u; cnt = 0u; mine = 0u;
#pragma unroll
        for (unsigned j = 0; j < 16; ++j) { const unsigned c = xb_ld(&bar[XB_XCNT(j)]); sum += c; cnt += (c > 0u) ? 1u : 0u; }
        mine = xb_ld(&bar[XB_XCNT(x)]);
        if (sum == G) break;
        __builtin_amdgcn_s_sleep(1);
        if ((++sp & 255u) == 0u) { if (xb_ld(&bar[XB_TMO])) break; if (sp > XB_SPIN_CAP) { atomicAdd(&bar[XB_TMO], 1u); break; } }
    }
    nloc = mine > 0u ? mine : 1u; nx = cnt > 0u ? cnt : 1u;
}
__device__ __forceinline__ void xcd_barrier(const XcdBarrier& b) {
    asm volatile("s_waitcnt vmcnt(0)" ::: "memory");
    __syncthreads();
    if (threadIdx.x == 0) {
        unsigned* bar = b.bar;
        __builtin_amdgcn_s_waitcnt(0);
        unsigned nloc = b.st[0], nx = b.st[1];
        if (nloc == 0u) { xcd_barrier_complete(bar, b.x, nloc, nx); b.st[0] = nloc; b.st[1] = nx; }
        const unsigned old = xb_add(&bar[XB_XSUB(b.x)], 1u);
        const unsigned gen = old / nloc;
        if (old + 1u == (gen + 1u) * nloc) {
            __builtin_amdgcn_fence(__ATOMIC_RELEASE, "agent");
            asm volatile("s_waitcnt vmcnt(0)" ::: "memory");
            const unsigned og = xb_add(&bar[XB_TOP], 1u);
            const unsigned tg = og / nx;
            if (og + 1u == (tg + 1u) * nx) xb_add(&bar[XB_TOPGEN], 1u);
            else XB_SPIN(xb_ld(&bar[XB_TOPGEN]) == tg, bar);
            __builtin_amdgcn_fence(__ATOMIC_ACQUIRE, "agent");
            xb_add(&bar[XB_XGEN(b.x)], 1u);
            asm volatile("s_waitcnt vmcnt(0)" ::: "memory");
        } else {
            XB_SPIN(xb_ld(&bar[XB_XGEN(b.x)]) == gen, bar);
            __builtin_amdgcn_fence(__ATOMIC_ACQUIRE, "agent");
            asm volatile("s_waitcnt vmcnt(0)" ::: "memory");
        }
    }
    __syncthreads();
}

template <int CTRL> __device__ __forceinline__ float dpp_f(float v) { return __builtin_bit_cast(float, __builtin_amdgcn_update_dpp(0, __builtin_bit_cast(int, v), CTRL, 0xf, 0xf, true)); }
__device__ __forceinline__ float sum16(float v) {
    v += dpp_f<0xB1>(v); v += dpp_f<0x4E>(v); v += dpp_f<0x141>(v); v += dpp_f<0x140>(v); return v;
}
__device__ __forceinline__ float wave_sum(float v) {
    v = sum16(v);
    const int b = __builtin_bit_cast(int, v);
    return (__builtin_bit_cast(float, __builtin_amdgcn_readlane(b, 0)) + __builtin_bit_cast(float, __builtin_amdgcn_readlane(b, 16)))
         + (__builtin_bit_cast(float, __builtin_amdgcn_readlane(b, 32)) + __builtin_bit_cast(float, __builtin_amdgcn_readlane(b, 48)));
}
__device__ __forceinline__ float wave_maxabs(const float* g, int n, int lane) {
    float v = 0.f;
    for (int i = lane; i < n; i += 64) v = fmaxf(v, fabsf(g[i]));
    v = fmaxf(v, dpp_f<0xB1>(v)); v = fmaxf(v, dpp_f<0x4E>(v)); v = fmaxf(v, dpp_f<0x141>(v)); v = fmaxf(v, dpp_f<0x140>(v));
    const int b = __builtin_bit_cast(int, v);
    return fmaxf(fmaxf(__builtin_bit_cast(float, __builtin_amdgcn_readlane(b, 0)), __builtin_bit_cast(float, __builtin_amdgcn_readlane(b, 16))),
                 fmaxf(__builtin_bit_cast(float, __builtin_amdgcn_readlane(b, 32)), __builtin_bit_cast(float, __builtin_amdgcn_readlane(b, 48))));
}
__device__ __forceinline__ void tr_item(const float* W, int N, int k0, int n0, bf16_t* dst, int ldd, LAS float* scr, int lane, int perm = -1, const float* gk = nullptr) {
#pragma unroll 8
    for (int i = 0; i < 32; ++i) { const int kk = 2 * i + (lane >> 5); scr[kk * 33 + (lane & 31)] = W[(size_t)(k0 + kk) * N + n0 + (lane & 31)] * (gk ? gk[k0 + kk] : 1.0f); }
    LDS_WAIT(); asm volatile("" ::: "memory");
    const int c = lane & 7;
#pragma unroll
    for (int j = 0; j < 4; ++j) { const int ns = (lane >> 3) + 8 * j, n = perm < 0 ? ns : 8 * (ns >> 2) + (ns & 3) + perm; const LAS float* s = scr + (8 * c) * 33 + ns;
        u32x4 o; o.x = cvt_pk_bf16(s[0 * 33], s[1 * 33]); o.y = cvt_pk_bf16(s[2 * 33], s[3 * 33]); o.z = cvt_pk_bf16(s[4 * 33], s[5 * 33]); o.w = cvt_pk_bf16(s[6 * 33], s[7 * 33]);
        *(u32x4*)(dst + (size_t)n * ldd + 8 * c) = o; }
    LDS_WAIT(); asm volatile("" ::: "memory");
}
__device__ __forceinline__ void sincos_acc(float ang, float& co, float& si) {
    const double a = (double)ang; const double k = __builtin_rint(a * 0.63661977236758134308);
    const double r = (a - k * 1.5707963267948966192) - k * 6.123233995736766e-17, r2 = r * r;
    const double s = r * (1.0 + r2 * (-1.0 / 6 + r2 * (1.0 / 120 + r2 * (-1.0 / 5040 + r2 * (1.0 / 362880 + r2 * (-1.0 / 39916800 + r2 * (1.0 / 6227020800.0)))))));
    const double c = 1.0 + r2 * (-0.5 + r2 * (1.0 / 24 + r2 * (-1.0 / 720 + r2 * (1.0 / 40320 + r2 * (-1.0 / 3628800 + r2 * (1.0 / 479001600.0 + r2 * (-1.0 / 87178291200.0)))))));
    const int q = (int)(long long)k & 3;
    const double cc = (q == 0) ? c : (q == 1) ? -s : (q == 2) ? -c : s;
    const double ss = (q == 0) ? s : (q == 1) ? c : (q == 2) ? -s : -c;
    co = (float)cc; si = (float)ss;
}
__device__ const float ROPE_FREQ[32] = {1.f, 0.749894261f, 0.562341332f, 0.421696514f, 0.316227764f, 0.237137377f, 0.177827939f, 0.133352131f, 0.100000001f, 0.0749894157f, 0.0562341325f,
    0.0421696529f, 0.0316227749f, 0.0237137377f, 0.0177827943f, 0.0133352149f, 0.00999999978f, 0.00749894185f, 0.00562341325f, 0.00421696482f, 0.00316227763f, 0.00237137359f, 0.00177827943f,
    0.00133352145f, 0.00100000005f, 0.000749894243f, 0.000562341302f, 0.000421696517f, 0.000316227757f, 0.00023713737f, 0.00017782794f, 0.00013335215f};

struct Frame {
    LAS unsigned char* lds; unsigned char* ws;
    int tid, lane, wave, vcu, G;
    const float* const* in;
};
__device__ __forceinline__ void step_prologue(const float* const (&in)[24], unsigned char* ws, LAS unsigned char* lds, int tid, int lane, int wave, int vcu, int G) {
    LAS float* scr = (LAS float*)(lds + RING_OFF + wave * 16384);
    const int gw = vcu * NWAVES + wave, NGW = G * NWAVES;
    const int gt = (vcu * NWAVES + wave) * 64 + lane, NT = G * NWAVES * 64;
    bf16_t* WIN_T = (bf16_t*)(ws + WS_WIN_T); bf16_t* WQ_T = (bf16_t*)(ws + WS_WQ_T); bf16_t* WKV_T = (bf16_t*)(ws + WS_WKV_T);
    bf16_t* WBR_T = (bf16_t*)(ws + WS_WBR_T); bf16_t* WOUT_T = (bf16_t*)(ws + WS_WOUT_T);
    {
        const float* cP = in[2]; const float* cS = in[3]; const float* w_ada = in[5]; float* modp = (float*)(ws + WS_MODP);
        for (int u = gw; u < DEPTH * 48 * KS_ADA; u += NGW) {
            const int ks = u % KS_ADA, cc = (u / KS_ADA) % 48, l = u / (KS_ADA * 48);
#pragma unroll 1
            for (int b = 0; b < 16; ++b) scr[b * 64 + lane] = (b < 8 ? cP + (size_t)b * DM : cS + (size_t)(b - 8) * DM)[ks * 64 + lane];
            LDS_WAIT(); asm volatile("" ::: "memory");
            f32x2 acc[16];
#pragma unroll
            for (int b = 0; b < 16; ++b) acc[b] = (f32x2){0.f, 0.f};
            const float* wp = w_ada + ((size_t)l * DM + ks * 64) * 6144 + cc * 128 + lane * 2;
#pragma unroll 1
            for (int k4 = 0; k4 < 16; ++k4) {
                f32x2 w[4];
#pragma unroll
                for (int q = 0; q < 4; ++q) w[q] = *(const f32x2*)(wp + (size_t)(k4 * 4 + q) * 6144);
#pragma unroll
                for (int b = 0; b < 16; ++b) { const f32x4 cv = *(const LAS f32x4*)(scr + b * 64 + k4 * 4);
                    acc[b] += w[0] * cv[0]; acc[b] += w[1] * cv[1]; acc[b] += w[2] * cv[2]; acc[b] += w[3] * cv[3]; }
            }
#pragma unroll
            for (int b = 0; b < 16; ++b) *(f32x2*)(modp + ((size_t)(ks * DEPTH + l) * 16 + b) * 6144 + cc * 128 + lane * 2) = acc[b];
            LDS_WAIT(); asm volatile("" ::: "memory");
        }
    }
    {
        constexpr int I_IN = (DM / 64) * (NIN / 32), I_Q = (512 / 64) * (1536 / 32), I_KV = (256 / 64) * (2048 / 32), I_BR = (1024 / 64) * (2048 / 32), I_OUT = (DM / 64) * (DM / 32);
        constexpr int I_L = I_IN + I_Q + I_KV + 3 * I_BR + I_OUT;
        for (int it = gw; it < DEPTH * I_L; it += NGW) {
            const int l = it / I_L; int r = it % I_L;
            if (r < I_IN) { const int nblk = NIN / 32, kb = r / nblk, nb = r % nblk, n0 = nb * 32; int dn = n0 + (n0 >= 832 ? 192 : 0), perm = -1;
                if (dn >= 2048 && dn < 2048 + 1280) { perm = (dn & 32) ? 4 : 0; dn &= ~63; }
                tr_item(in[7] + (size_t)l * DM * NIN, NIN, kb * 64, n0, WIN_T + ((size_t)l * NINP + dn) * DM + kb * 64, DM, scr, lane, perm); continue; }
            r -= I_IN;
            if (r < I_Q) { const int nblk = 1536 / 32, kb = r / nblk, nb = r % nblk, n0 = nb * 32, hq = n0 / 192, d0 = n0 % 192;
                const int dn = hq * 256 + (d0 < 128 ? d0 : 128), perm = d0 < 128 ? -1 : (d0 == 128 ? 0 : 4);
                tr_item(in[9] + (size_t)l * 512 * 1536, 1536, kb * 64, n0, WQ_T + ((size_t)l * 2048 + dn) * 512 + kb * 64, 512, scr, lane, perm, in[8] + (size_t)l * 512); continue; }
            r -= I_Q;
            if (r < I_KV) { const int nblk = 2048 / 32, kb = r / nblk, nb = r % nblk, n0 = nb * 32, hh = n0 >> 8, wi = n0 & 255, dn = wi < 128 ? hh * 128 + wi : 1024 + hh * 128 + (wi - 128);
                tr_item(in[11] + (size_t)l * 256 * 2048, 2048, kb * 64, n0, WKV_T + ((size_t)l * 2048 + dn) * 256 + kb * 64, 256, scr, lane, -1, in[10] + (size_t)l * 256); continue; }
            r -= I_KV;
            if (r < 3 * I_BR) { const int br = r / I_BR, rr = r % I_BR, nblk = 2048 / 32, kb = rr / nblk, nb = rr % nblk;
                const float* src = (br == 0 ? in[20] : br == 1 ? in[21] : in[22]) + (size_t)l * 1024 * 2048;
                tr_item(src, 2048, kb * 64, nb * 32, WBR_T + ((size_t)l * 2048 + nb * 32) * 3072 + br * 1024 + kb * 64, 3072, scr, lane); continue; }
            r -= 3 * I_BR;
            { const int nblk = DM / 32, kb = r / nblk, nb = r % nblk;
                tr_item(in[23] + (size_t)l * DM * DM, DM, kb * 64, nb * 32, WOUT_T + ((size_t)l * DM + nb * 32) * DM + kb * 64, DM, scr, lane); }
        }
    }
    for (int e = gt; e < DEPTH * 192 * (DM / 8); e += NT) { const int l = e / (192 * (DM / 8)), r = e % (192 * (DM / 8));
        *(u32x4*)(WIN_T + ((size_t)l * NINP + 832) * DM + (size_t)r * 8) = (u32x4){0u, 0u, 0u, 0u}; }
    for (int e = gt; e < DEPTH * 8 * 64 * (512 / 8); e += NT) { const int hh = e / (64 * 64), r = e % (64 * 64);
        *(u32x4*)(WQ_T + ((size_t)hh * 256 + 192) * 512 + (size_t)r * 8) = (u32x4){0u, 0u, 0u, 0u}; }
    { f32x2* rope = (f32x2*)(ws + WS_ROPE);
      for (int e = gt; e < 4096 * 32; e += NT) { const float ang = (float)(e >> 5) * ROPE_FREQ[e & 31]; float c, s; sincos_acc(ang, c, s); rope[e] = (f32x2){c, s}; } }
    { float* tb = (float*)(ws + WS_TB); const float* rel_bias = in[19];
      for (int e = gt; e < 8 * 768; e += NT) { const int h = e / 768, rel = (e % 768) - 383, n = rel < 0 ? -rel : rel; float v = -1e30f;
          if (n <= 128) { int bk = rel > 0 ? 16 : 0;
              if (n < 8) bk += n; else bk += 8 + (n >= 12) + (n >= 16) + (n >= 23) + (n >= 32) + (n >= 46) + (n >= 64) + (n >= 91);
              v = rel_bias[bk * 8 + h] * 1.4426950408889634f; }
          tb[e] = v; } }
}
__device__ __forceinline__ void step_modreduce(const float* b_ada, unsigned char* ws, int gt, int NT) {
    const float* modp = (const float*)(ws + WS_MODP); float* mod = (float*)(ws + WS_MOD);
    for (int e = gt; e < DEPTH * 16 * 6144; e += NT) { const int l = e / (16 * 6144), j = e % 6144; float s = b_ada[l * 6144 + j];
#pragma unroll 8
        for (int ks = 0; ks < KS_ADA; ++ks) s += modp[(size_t)ks * (DEPTH * 16 * 6144) + e];
        mod[e] = s; }
}
__device__ __forceinline__ void step_norm(const float* x, bf16_t* H, const float* ln_g, const float* mod_l, int bbase, int S, int TP, int gw, int NGW, int lane) {
    for (int ch = gw; ch < TP / 8; ch += NGW) {
        const float* mb = mod_l + (size_t)(bbase + (ch * 8) / S) * 6144;
        f32x4 gs[8], sh[8];
#pragma unroll
        for (int j = 0; j < 8; ++j) { const int c = (64 * j + lane) * 4; const f32x4 g = *(const f32x4*)(ln_g + c), sc = *(const f32x4*)(mb + 2048 + c); gs[j] = g * (sc + 1.0f); sh[j] = *(const f32x4*)(mb + c); }
        for (int rr = 0; rr < 8; rr += 2) { const size_t row = (size_t)ch * 8 + rr;
            const f32x4* xr = (const f32x4*)(x + row * DM) + lane; f32x4 v[8], w[8]; float ss = 0.f, st = 0.f;
#pragma unroll
            for (int j = 0; j < 8; ++j) { v[j] = xr[64 * j]; w[j] = xr[64 * j + DM / 4]; }
#pragma unroll
            for (int j = 0; j < 8; ++j) { ss += (v[j].x * v[j].x + v[j].y * v[j].y) + (v[j].z * v[j].z + v[j].w * v[j].w); st += (w[j].x * w[j].x + w[j].y * w[j].y) + (w[j].z * w[j].z + w[j].w * w[j].w); }
            const float rstd = 1.0f / sqrtf(wave_sum(ss) * (1.0f / DM) + RMS_EPS), rstt = 1.0f / sqrtf(wave_sum(st) * (1.0f / DM) + RMS_EPS);
            u32x2* o8 = (u32x2*)(H + row * DM) + lane;
#pragma unroll
            for (int j = 0; j < 8; ++j) { const f32x4 y = v[j] * rstd * gs[j] + sh[j], z = w[j] * rstt * gs[j] + sh[j];
                o8[64 * j] = (u32x2){cvt_pk_bf16(y.x, y.y), cvt_pk_bf16(y.z, y.w)}; o8[64 * j + DM / 4] = (u32x2){cvt_pk_bf16(z.x, z.y), cvt_pk_bf16(z.z, z.w)}; }
        }
    }
}
__device__ __forceinline__ void head128_load(const bf16_t* base, int j, unsigned (&w)[4]) {
#pragma unroll
    for (int q = 0; q < 4; ++q) w[q] = *(const unsigned*)(base + 32 * q + 2 * j);
}
__device__ __forceinline__ void head128_finish(bf16_t* base, const unsigned (&w)[4], const float* gain, bool do_rope, const f32x4 ca, const f32x4 cb, int j, const float oscale) {
    float v[8];
#pragma unroll
    for (int q = 0; q < 4; ++q) { v[2 * q] = bf_lo(w[q]); v[2 * q + 1] = bf_hi(w[q]); }
    float ss = 0.f;
#pragma unroll
    for (int e = 0; e < 8; ++e) ss += v[e] * v[e];
    const float rstd = oscale / sqrtf(sum16(ss) * (1.0f / 128) + RMS_EPS);
#pragma unroll
    for (int q = 0; q < 4; ++q) { const f32x2 g = *(const f32x2*)(gain + 32 * q + 2 * j); v[2 * q] *= rstd * g.x; v[2 * q + 1] *= rstd * g.y; }
    if (do_rope) {
        const float a0 = v[0], a1 = v[1], a2 = v[2], a3 = v[3], b0 = v[4], b1 = v[5], b2 = v[6], b3 = v[7];
        v[0] = a0 * ca.x - a2 * ca.y; v[1] = a1 * ca.z - a3 * ca.w; v[2] = a2 * ca.x + a0 * ca.y; v[3] = a3 * ca.z + a1 * ca.w;
        v[4] = b0 * cb.x - b2 * cb.y; v[5] = b1 * cb.z - b3 * cb.w; v[6] = b2 * cb.x + b0 * cb.y; v[7] = b3 * cb.z + b1 * cb.w;
    }
#pragma unroll
    for (int q = 0; q < 4; ++q) *(unsigned*)(base + 32 * q + 2 * j) = cvt_pk_bf16(v[2 * q], v[2 * q + 1]);
}
struct P1Row { u32x4 wq; u32x2 wk; };
__device__ __forceinline__ void p1_load(P1Row& R, const bf16_t* CQKV, const bf16_t* AXb, const bf16_t* WINb, const f32x2* rope, size_t row, int s, int lane) {
    const int j = lane & 15, grp = lane >> 4;
    R.wq = *(const u32x4*)(CQKV + row * 1024 + lane * 8); R.wk = *(const u32x2*)(CQKV + row * 1024 + 512 + lane * 4);
}
__device__ __forceinline__ void p1_finish(const P1Row& R, bf16_t* CQKV, bf16_t* AXb, bf16_t* WINb, const float* q_a_norm, const float* kv_a_norm, const float* ax_qn, const float* ax_kn,
                                          const float* win_qn, const float* win_kn, size_t row, int lane) {
    const int j = lane & 15, grp = lane >> 4;
    { float v[8] = {bf_lo(R.wq.x), bf_hi(R.wq.x), bf_lo(R.wq.y), bf_hi(R.wq.y), bf_lo(R.wq.z), bf_hi(R.wq.z), bf_lo(R.wq.w), bf_hi(R.wq.w)};
      float ss = 0.f;
#pragma unroll
      for (int e = 0; e < 8; ++e) ss += v[e] * v[e];
      const float rstd = 1.0f / sqrtf(wave_sum(ss) * (1.0f / 512) + RMS_EPS);
      const f32x4 g0 = *(const f32x4*)(q_a_norm + lane * 8), g1 = *(const f32x4*)(q_a_norm + lane * 8 + 4);
      u32x4 o; o.x = cvt_pk_bf16(v[0] * rstd * g0.x, v[1] * rstd * g0.y); o.y = cvt_pk_bf16(v[2] * rstd * g0.z, v[3] * rstd * g0.w);
      o.z = cvt_pk_bf16(v[4] * rstd * g1.x, v[5] * rstd * g1.y); o.w = cvt_pk_bf16(v[6] * rstd * g1.z, v[7] * rstd * g1.w); *(u32x4*)(CQKV + row * 1024 + lane * 8) = o; }
    { float v[4] = {bf_lo(R.wk.x), bf_hi(R.wk.x), bf_lo(R.wk.y), bf_hi(R.wk.y)};
      const float ss = (v[0] * v[0] + v[1] * v[1]) + (v[2] * v[2] + v[3] * v[3]);
      const float rstd = 1.0f / sqrtf(wave_sum(ss) * (1.0f / 256) + RMS_EPS);
      const f32x4 g = *(const f32x4*)(kv_a_norm + lane * 4);
      *(u32x2*)(CQKV + row * 1024 + 512 + lane * 4) = (u32x2){cvt_pk_bf16(v[0] * rstd * g.x, v[1] * rstd * g.y), cvt_pk_bf16(v[2] * rstd * g.z, v[3] * rstd * g.w)}; }
}
__device__ __forceinline__ void step_prep1(bf16_t* CQKV, bf16_t* AXb, bf16_t* WINb, const float* q_a_norm, const float* kv_a_norm, const float* ax_qn, const float* ax_kn,
                                           const float* win_qn, const float* win_kn, const f32x2* rope, int S, int TP, int gw, int NGW, int lane) {
    for (int ch = gw; ch < TP / 8; ch += NGW)
        for (int rr = 0; rr < 8; rr += 2) { const size_t row = (size_t)ch * 8 + rr; const int s = (int)(row % (size_t)S);
            P1Row A, B; p1_load(A, CQKV, AXb, WINb, rope, row, s, lane); p1_load(B, CQKV, AXb, WINb, rope, row + 1, s + 1, lane);
            p1_finish(A, CQKV, AXb, WINb, q_a_norm, kv_a_norm, ax_qn, ax_kn, win_qn, win_kn, row, lane);
            p1_finish(B, CQKV, AXb, WINb, q_a_norm, kv_a_norm, ax_qn, ax_kn, win_qn, win_kn, row + 1, lane); }
}
struct P2Row { u32x4 wn[4]; unsigned r0[4], r1[4]; f32x4 cs; };
__device__ __forceinline__ void p2_load(P2Row& R, const bf16_t* QM, const bf16_t* KF, const bf16_t* CQKV, const f32x2* rope, size_t row, int s, int lane) {
    const int j = lane & 15, grp = lane >> 4;
    const unsigned kr0 = *(const unsigned*)(CQKV + row * 1024 + 768 + 2 * j), kr1 = *(const unsigned*)(CQKV + row * 1024 + 800 + 2 * j);
#pragma unroll
    for (int it = 0; it < 4; ++it) { const int h = (it & 1) * 4 + grp; const bool isq = it < 2; const bf16_t* hb = (isq ? QM : KF) + row * 1536 + h * 192;
        R.wn[it] = *(const u32x4*)(hb + 8 * j);
        if (isq) { R.r0[it] = *(const unsigned*)(hb + 128 + 2 * j); R.r1[it] = *(const unsigned*)(hb + 160 + 2 * j); } else { R.r0[it] = kr0; R.r1[it] = kr1; } }
    R.cs = *(const f32x4*)(rope + (size_t)s * 32 + 2 * j);
}
__device__ __forceinline__ void p2_finish(const P2Row& R, bf16_t* QM, bf16_t* KF, const float* mla_qn, const float* mla_kn, size_t row, int lane) {
    const int j = lane & 15, grp = lane >> 4; const f32x4 cs = R.cs;
#pragma unroll
    for (int it = 0; it < 4; ++it) { const int h = (it & 1) * 4 + grp; const bool isq = it < 2; const float* gain = isq ? mla_qn : mla_kn; bf16_t* base = (isq ? QM : KF) + row * 1536 + h * 192;
        float v[8] = {bf_lo(R.wn[it].x), bf_hi(R.wn[it].x), bf_lo(R.wn[it].y), bf_hi(R.wn[it].y), bf_lo(R.wn[it].z), bf_hi(R.wn[it].z), bf_lo(R.wn[it].w), bf_hi(R.wn[it].w)};
        float x0 = bf_lo(R.r0[it]), x1 = bf_hi(R.r0[it]), y0 = bf_lo(R.r1[it]), y1 = bf_hi(R.r1[it]);
        float ss = (x0 * x0 + x1 * x1) + (y0 * y0 + y1 * y1);
#pragma unroll
        for (int e = 0; e < 8; ++e) ss += v[e] * v[e];
        const float rstd = (isq ? 0.072168783648703220f * 1.4426950408889634f : 1.0f) / sqrtf(sum16(ss) * (1.0f / 192) + RMS_EPS);
        const f32x4 g0 = *(const f32x4*)(gain + 8 * j), g1 = *(const f32x4*)(gain + 8 * j + 4); const f32x2 gx = *(const f32x2*)(gain + 128 + 2 * j), gy = *(const f32x2*)(gain + 160 + 2 * j);
        u32x4 o; o.x = cvt_pk_bf16(v[0] * rstd * g0.x, v[1] * rstd * g0.y); o.y = cvt_pk_bf16(v[2] * rstd * g0.z, v[3] * rstd * g0.w);
        o.z = cvt_pk_bf16(v[4] * rstd * g1.x, v[5] * rstd * g1.y); o.w = cvt_pk_bf16(v[6] * rstd * g1.z, v[7] * rstd * g1.w);
        x0 *= rstd * gx.x; x1 *= rstd * gx.y; y0 *= rstd * gy.x; y1 *= rstd * gy.y;
        *(u32x4*)(base + 8 * j) = o;
        *(unsigned*)(base + 128 + 2 * j) = cvt_pk_bf16(x0 * cs.x - y0 * cs.y, x1 * cs.z - y1 * cs.w);
        *(unsigned*)(base + 160 + 2 * j) = cvt_pk_bf16(y0 * cs.x + x0 * cs.y, y1 * cs.z + x1 * cs.w); }
}
__device__ __forceinline__ void step_prep2(bf16_t* QM, bf16_t* KF, const bf16_t* CQKV, const float* mla_qn, const float* mla_kn, const f32x2* rope, int S, int TP, int gw, int NGW, int lane) {
    for (int ch = gw; ch < TP / 8; ch += NGW)
        for (int rr = 0; rr < 8; rr += 2) { const size_t row = (size_t)ch * 8 + rr; const int s = (int)(row % (size_t)S);
            P2Row A, B; p2_load(A, QM, KF, CQKV, rope, row, s, lane); p2_load(B, QM, KF, CQKV, rope, row + 1, s + 1, lane);
            p2_finish(A, QM, KF, mla_qn, mla_kn, row, lane); p2_finish(B, QM, KF, mla_qn, mla_kn, row + 1, lane); }
}
struct Args { const float* in[24]; float* out; unsigned char* ws; int step_lo, step_hi, li, pad; };
__global__ void __launch_bounds__(NWAVES * 64, 2) fwd(Args args) {
    extern __shared__ __attribute__((aligned(16))) unsigned char lds_raw[];
    LAS unsigned char* lds = (LAS unsigned char*)lds_raw;
    const int G = gridDim.x, bx = blockIdx.x, vcu = (G % 8 == 0) ? (bx % 8) * (G / 8) + bx / 8 : bx;
    const int NGW = G * NWAVES, NTH = NGW * 64;
    { const int tid = threadIdx.x; if (tid < 64) ((LAS unsigned*)(lds + LDSCTL_OFF))[tid] = 0u; }
    __syncthreads();
    const int lo = args.step_lo, hi = args.step_hi;
    XcdBarrier bar; bar.bar = (unsigned*)(args.ws + WS_CTL) + args.li * XCD_BAR_WORDS; bar.x = 0; bar.st = (volatile LAS unsigned*)(lds + LDSCTL_OFF) + 8;
    if (hi - lo > 1) bar = xcd_barrier_post((unsigned*)(args.ws + WS_CTL) + args.li * XCD_BAR_WORDS, (volatile LAS unsigned*)(lds + LDSCTL_OFF) + 8);
#ifndef PH_MASK
#define PH_MASK 0x3ff
#endif
#define PH(k) (((PH_MASK) >> (k)) & 1)
#define PHASE_IDS() int tid_ = threadIdx.x; asm volatile("" : "+v"(tid_)); const int tid = tid_, lane = tid & 63, wave = __builtin_amdgcn_readfirstlane(tid >> 6), gw = vcu * NWAVES + wave, gt = gw * 64 + lane; (void)gt; (void)gw; (void)lane
#define GAS __attribute__((address_space(1)))
#define GP(T, p) ((T*)(p))
#define TABP(k) GP(const float, tab[k])
#define PHASE_PTRS() PHASE_IDS(); size_t wz_ = 0; asm volatile("" : "+s"(wz_)); unsigned char* ws = args.ws + wz_; const float* const* tab = (const float* const*)(ws + WS_PTRS); \
    bf16_t* WIN_T = GP(bf16_t, ws + WS_WIN_T); bf16_t* WQ_T = GP(bf16_t, ws + WS_WQ_T); bf16_t* WKV_T = GP(bf16_t, ws + WS_WKV_T); \
    bf16_t* WBR_T = GP(bf16_t, ws + WS_WBR_T); bf16_t* WOUT_T = GP(bf16_t, ws + WS_WOUT_T); \
    bf16_t* Hb = GP(bf16_t, ws + WS_H); bf16_t* CQKV = GP(bf16_t, ws + WS_CQKV); bf16_t* QM = GP(bf16_t, ws + WS_QM); bf16_t* KF = GP(bf16_t, ws + WS_KF); bf16_t* VM = GP(bf16_t, ws + WS_VM); \
    bf16_t* AXb = GP(bf16_t, ws + WS_AX); bf16_t* WINb = GP(bf16_t, ws + WS_WINB); bf16_t* Gb = GP(bf16_t, ws + WS_G); bf16_t* MG = GP(bf16_t, ws + WS_MG); \
    const float* mod_l = GP(const float, ws + WS_MOD) + (size_t)l * 16 * 6144; const f32x2* rope = GP(const f32x2, ws + WS_ROPE); const float* tb = GP(const float, ws + WS_TB); \
    (void)tab; (void)WIN_T; (void)WQ_T; (void)WKV_T; (void)WBR_T; (void)WOUT_T; (void)Hb; (void)CQKV; (void)QM; (void)KF; (void)VM; (void)AXb; (void)WINb; (void)Gb; (void)MG; (void)mod_l; (void)rope; (void)tb
#ifndef MK_TPROBE
#define MK_TPROBE -1
#endif
#ifndef MK_TSCALE
#define MK_TSCALE 4.0f
#endif
#define TP_BEGIN(k) do { if (MK_TPROBE == (k)) tp0 = __builtin_amdgcn_s_memrealtime(); } while (0)
#define TP_END(k) do { if (MK_TPROBE == (k)) tpacc += __builtin_amdgcn_s_memrealtime() - tp0; } while (0)
#define IN(s) (lo <= (s) && (s) < hi)
#define SEAM(s) do { if (IN(s) && IN((s) + 1)) xcd_barrier(bar); } while (0)

    unsigned long long tp0 = 0, tpacc = 0; (void)tp0; (void)tpacc;
    TP_BEGIN(8);
    if (PH(0) && IN(0)) { PHASE_IDS(); if (bx == 0 && tid == 0) { const float** tw = (const float**)(args.ws + WS_PTRS);
#pragma unroll
            for (int i = 0; i < 24; ++i) tw[i] = args.in[i];
            tw[24] = (const float*)args.out; }
        step_prologue(args.in, args.ws, lds, tid, lane, wave, vcu, G); }
    SEAM(0);
    if (PH(1) && IN(1)) { PHASE_IDS(); step_modreduce(args.in[6], args.ws, gt, NTH); }
    SEAM(1);
    TP_END(8);

    int it_lo = (lo - NSTEP_PRO) / NSTEP_IT; if (lo < NSTEP_PRO) it_lo = 0;
    int it_hi = (hi - NSTEP_PRO + NSTEP_IT - 1) / NSTEP_IT; if (hi <= NSTEP_PRO) it_hi = 0; if (it_hi > DEPTH * NPASS) it_hi = DEPTH * NPASS;
    for (int it = it_lo; it < it_hi; ++it) {
        const int l = it / NPASS, p = it % NPASS, s0 = NSTEP_PRO + it * NSTEP_IT;
        const int S = p == 0 ? 4096 : 2048, bbase = p == 0 ? 0 : 8, TP = p == 0 ? 32768 : 16384;
        const size_t row0 = p == 0 ? 0 : 32768;

        TP_BEGIN(0);
        if (PH(2) && IN(s0 + 0)) { PHASE_PTRS(); const float* xin = ((l == 0) ? (p == 0 ? args.in[0] : args.in[1]) : args.out + row0 * DM) + wz_; float* xout = args.out + row0 * DM + wz_; (void)xout; step_norm(xin, Hb, TABP(4) + (size_t)l * DM, mod_l, bbase, S, TP, gw, NGW, lane); }
        TP_BEGIN(20);
        SEAM(s0 + 0);
        TP_END(20);
        TP_END(0);
        TP_BEGIN(1);
        if (PH(3) && IN(s0 + 1)) { PHASE_PTRS();
            pg8::Gemm g{Hb, WIN_T + (size_t)l * NINP * DM, TP, NINP, DM, DM, DM}; pg8::StaticOrder So; So.init(TP, NINP, G, bx);
            EpiInProj E{CQKV, Gb, AXb, WINb, MG, tab, l * 128, rope, S, (PG8_LAS float*)(lds + LDSCTL_OFF + 1024), (float*)(ws + WS_RS)};
            pg8::gemm_phase<EpiInProj, pg8::StaticOrder, true, true>(lds + RING_OFF, g, So, E);
        }
        TP_BEGIN(21);
        SEAM(s0 + 1);
        TP_END(21);
        TP_END(1);
        TP_BEGIN(2);
        TP_END(22);
        TP_END(2);
        TP_BEGIN(3);
        if (PH(5) && IN(s0 + 3)) { PHASE_PTRS();
            { pg8::Gemm g{CQKV, WQ_T + (size_t)l * 2048 * 512, TP, 2048, 512, 1024, 512}; pg8::StaticOrder So; So.init(TP, 2048, G, bx);
              EpiQUp E{QM, (const float*)(ws + WS_RS), TABP(12) + (size_t)l * 192, rope, S, (PG8_LAS float*)(lds + LDSCTL_OFF + 1024)};
              pg8::gemm_phase<EpiQUp, pg8::StaticOrder, true, true>(lds + RING_OFF, g, So, E); }
            { pg8::Gemm g{CQKV + 512, WKV_T + (size_t)l * 2048 * 256, TP, 2048, 256, 1024, 256}; pg8::StaticOrder So; So.init(TP, 2048, G, G - 1 - bx);
              EpiKV E{KF, VM, (const float*)(ws + WS_RS), CQKV, TABP(13) + (size_t)l * 192, rope, S, (PG8_LAS float*)(lds + LDSCTL_OFF + 1024)};
              pg8::gemm_phase<EpiKV, pg8::StaticOrder, true, true>(lds + RING_OFF, g, So, E); }
        }
        TP_BEGIN(23);
        SEAM(s0 + 3);
        TP_END(23);
        TP_END(3);
        TP_BEGIN(4);
        TP_END(24);
        TP_END(4);
        TP_BEGIN(5);
        if (PH(7) && IN(s0 + 5)) { PHASE_PTRS();
            const int nqb = S / 256, nper = TP / 256; char* al = (char*)lds_raw + RING_OFF; const long dbgoff = 0; (void)dbgoff;
#define UNIF_F(x) __builtin_bit_cast(float, __builtin_amdgcn_readfirstlane(__builtin_bit_cast(int, (float)(x))))
            const float mneg_mla = UNIF_F(-1.02f * 13.856406f * 1.4426950408889634f * wave_maxabs(TABP(12) + (size_t)l * 192, 192, lane) * wave_maxabs(TABP(13) + (size_t)l * 192, 192, lane));
            const float mneg_ax = UNIF_F(-1.02f * 11.313708f * 1.4426950408889634f * wave_maxabs(TABP(14) + (size_t)l * 128, 128, lane) * wave_maxabs(TABP(15) + (size_t)l * 128, 128, lane));
#undef UNIF_F
            const bool mla_small = mneg_mla > -100.f;
            const unsigned myx = xb_xcc_id() & 7u; unsigned* qbase = (unsigned*)(ws + WS_CTL) + 4096 + (size_t)it * (3 * 8 * 64);
            volatile LAS int* tick = (volatile LAS int*)(lds + LDSCTL_OFF) + 16;
#define Q_RAW(cls, r_) do { r_ = -1; while (qi < 8) { const unsigned x_ = (myx + (unsigned)qi) & 7u; \
                const unsigned k_ = __hip_atomic_fetch_add(qbase + ((cls) * 8 + x_) * 64, 1u, __ATOMIC_RELAXED, __HIP_MEMORY_SCOPE_AGENT); if ((int)k_ < nper) { r_ = (int)((x_ << 16) | k_); break; } ++qi; } } while (0)
#define Q_FIRST(cls, r) do { __syncthreads(); if (tid == 0) { int r_; Q_RAW(cls, r_); tick[0] = r_; } __syncthreads(); r = tick[0]; par = 1; } while (0)
#define Q_NEXT_ISSUE(cls) do { nxt = -1; if (tid == 0) { Q_RAW(cls, nxt); } } while (0)
#define Q_NEXT_TAKE(r) do { if (tid == 0) tick[par] = nxt; __syncthreads(); r = tick[par]; par ^= 1; } while (0)
            TP_BEGIN(10);
            { int qi = 0, r, nxt, par;
              Q_FIRST(0, r);
              while (r >= 0) { Q_NEXT_ISSUE(0); const int h = r >> 16, k = r & 0xffff, b = k / nqb, qb = k % nqb; const size_t t0 = (size_t)b * S, tq = t0 + (size_t)qb * 256;
                if (mla_small) att::attn_unit<192, 1, 1536, 1536, 1024, 3072, false, 2>(QM + tq * 1536 + h * 192, KF + t0 * 1536 + h * 192, VM + t0 * 1024 + h * 128, Gb + tq * 3072 + h * 128,
                                                                                        S / 64, 0.f, 0.f, tb, 0, al);
                else att::attn_unit<192, 1, 1536, 1536, 1024, 3072, false, 3>(QM + tq * 1536 + h * 192, KF + t0 * 1536 + h * 192, VM + t0 * 1024 + h * 128, Gb + tq * 3072 + h * 128,
                                                                             S / 64, mneg_mla, 0.f, tb, 0, al);
                Q_NEXT_TAKE(r); } }
            TP_END(10); TP_BEGIN(11);
            { int qi = 0, r, nxt, par;
              Q_FIRST(1, r);
              while (r >= 0) { Q_NEXT_ISSUE(1); const int x = r >> 16, k = r & 0xffff, g = x + 8 * (k / (4 * nqb)), w = k % (4 * nqb), b = g >> 1, h = (g & 1) * 4 + w / nqb, qb = w % nqb;
                const size_t t0 = (size_t)b * S, tq = t0 + (size_t)qb * 256;
                att::attn_unit<128, 2, 1536, 1536, 1536, 3072, false, 1>(AXb + tq * 1536 + h * 128, AXb + t0 * 1536 + 1024 + (h >> 2) * 128, AXb + t0 * 1536 + 1280 + (h >> 2) * 128,
                                                                     Gb + tq * 3072 + 1024 + h * 128, S / 64, mneg_ax, 0.f, tb, 0, al);
                Q_NEXT_TAKE(r); } }
            TP_END(11); TP_BEGIN(12);
            const float* sink = TABP(18) + l * 8;
            { int qi = 0, r, nxt, par;
              Q_FIRST(2, r);
              while (r >= 0) { Q_NEXT_ISSUE(2); const int x = r >> 16, k = r & 0xffff, g = x + 8 * (k / (4 * nqb)), w = k % (4 * nqb), b = g >> 1, h = (g & 1) * 4 + w / nqb, qb = w % nqb;
                const size_t t0 = (size_t)b * S, tq = t0 + (size_t)qb * 256;
                const int q0 = qb * 256, ks = q0 >= 128 ? q0 - 128 : 0, ke = q0 + 384 <= S ? q0 + 384 : S; const size_t tk = t0 + ks;
                att::attn_unit<128, 1, 1536, 1536, 1536, 3072, true>(WINb + tq * 1536 + h * 128, WINb + tk * 1536 + 1024 + (h >> 2) * 128, WINb + tk * 1536 + 1280 + (h >> 2) * 128,
                                                                    Gb + tq * 3072 + 2048 + h * 128, (ke - ks) / 64, sink[h] * 1.4426950408889634f, 1.f, tb + h * 768, ks - q0 + 383, al);
                Q_NEXT_TAKE(r); } }
#undef Q_RAW
#undef Q_FIRST
#undef Q_NEXT_ISSUE
#undef Q_NEXT_TAKE
            __syncthreads(); TP_END(12); TP_BEGIN(13);
        }
        SEAM(s0 + 5);
        TP_END(13);
        TP_END(5);
        TP_BEGIN(6);
        if (PH(8) && IN(s0 + 6)) { PHASE_PTRS();
            pg8::Gemm g{Gb, WBR_T + (size_t)l * DM * 3072, TP, DM, 3072, 3072, 3072}; pg8::StaticOrder So; So.init(TP, DM, G, bx);
            EpiBranchFused E{MG, Hb};
            pg8::gemm_phase<EpiBranchFused, pg8::StaticOrder, true, true>(lds + RING_OFF, g, So, E);
        }
        TP_BEGIN(26);
        SEAM(s0 + 6);
        TP_END(26);
        TP_END(6);
        TP_BEGIN(7);
        if (PH(9) && IN(s0 + 7)) { PHASE_PTRS(); const float* xin = ((l == 0) ? (p == 0 ? args.in[0] : args.in[1]) : args.out + row0 * DM) + wz_; float* xout = args.out + row0 * DM + wz_; (void)xout;
            pg8::Gemm g{Hb, WOUT_T + (size_t)l * DM * DM, TP, DM, DM, DM, DM}; pg8::StaticOrder So; So.init(TP, DM, G, bx);
            EpiOut E{xin, xout, mod_l + 4096, bbase, S};
            pg8::gemm_phase<EpiOut, pg8::StaticOrder, true, true>(lds + RING_OFF, g, So, E);
        }
        TP_BEGIN(27);
        SEAM(s0 + 7);
        TP_END(27);
        TP_END(7);
    }
    if (MK_TPROBE >= 0 && hi == NSTEPS) { xcd_barrier(bar);
        if (bx == 0 && threadIdx.x == 0) args.out[0] += (float)tpacc * 1e-5f * MK_TSCALE; }
#undef IN
#undef SEAM
}

extern "C" void kernel_launch(void* const* d_in, const int* in_sizes, int n_in, void* d_out, int out_size, void* d_ws, size_t ws_size, hipStream_t stream) {
    static int grid = 0;
    if (grid == 0) {
        if (n_in != 24 || in_sizes[0] != T_PROMPT * DM || in_sizes[1] != T_SAMPLE * DM || out_size != (T_PROMPT + T_SAMPLE) * DM || ws_size < WS_END) {
            fprintf(stderr, "kernel_launch: shape mismatch (n_in %d, in0 %d, in1 %d, out %d, ws %zu, need ws >= %zu); nothing launched\n", n_in, n_in > 0 ? in_sizes[0] : -1, n_in > 1 ? in_sizes[1] : -1, out_size, ws_size, (size_t)WS_END);
            grid = -1; return; }
        int dev = 0, cus = 0, per_cu = 0;
        if (hipGetDevice(&dev) != hipSuccess || hipDeviceGetAttribute(&cus, hipDeviceAttributeMultiprocessorCount, dev) != hipSuccess) { fprintf(stderr, "kernel_launch: device query failed\n"); grid = -1; return; }
        if (hipFuncSetAttribute((const void*)fwd, hipFuncAttributeMaxDynamicSharedMemorySize, LDS_BYTES) != hipSuccess) { fprintf(stderr, "kernel_launch: hipFuncSetAttribute failed\n"); grid = -1; return; }
        if (hipOccupancyMaxActiveBlocksPerMultiprocessor(&per_cu, (const void*)fwd, NWAVES * 64, LDS_BYTES) != hipSuccess || per_cu < 1)
            fprintf(stderr, "kernel_launch: note: occupancy query reports %d workgroups per CU\n", per_cu);
        (void)hipGetLastError();
        grid = cus;
    }
    if (grid < 0) return;
    if (hipMemsetAsync((char*)d_ws + WS_CTL, 0, CTL_ZERO_BYTES, stream) != hipSuccess) { fprintf(stderr, "kernel_launch: hipMemsetAsync failed\n"); return; }
    Args a{};
    for (int i = 0; i < 24; ++i) a.in[i] = (const float*)d_in[i];
    a.out = (float*)d_out; a.ws = (unsigned char*)d_ws; a.li = 0; a.pad = 0;
#if MK_ONE_LAUNCH
    a.step_lo = 0; a.step_hi = NSTEPS;
    hipLaunchKernelGGL(fwd, dim3(grid), dim3(NWAVES * 64), LDS_BYTES, stream, a);
#else
    for (int s = 0; s < NSTEPS; ++s) { a.step_lo = s; a.step_hi = s + 1;
        hipLaunchKernelGGL(fwd, dim3(grid), dim3(NWAVES * 64), LDS_BYTES, stream, a); }
#endif
    const hipError_t le = hipPeekAtLastError();
    if (le != hipSuccess) fprintf(stderr, "kernel_launch: launch failed: %s\n", hipGetErrorName(le));
}
```
